# Optimizing an MI355X kernel written in HIP

```python
import jax, jax.numpy as jnp
from jax import lax
import numpy as np

D_MODEL = 1024
BATCH = 2
SEQ = 8192
DEPTH = 2

HEAD_DIM = 64
MIX_W = D_MODEL // 2
N_BRANCH = 3
POOL_WINDOWS = (2, 4, 8, 16)
POOL_GROUPS = len(POOL_WINDOWS)
POOL_GC = MIX_W // POOL_GROUPS
NSA_HEADS = MIX_W // HEAD_DIM
NSA_KV_GROUPS = 2
NSA_HPG = NSA_HEADS // NSA_KV_GROUPS
CMP_LEN = 32
CMP_STRIDE = 16
CMP_HID = 4 * HEAD_DIM
SEL_LEN = 64
N_SEL = 16
WINDOW = 512
FOX_HEADS = MIX_W // HEAD_DIM
Q_BLOCK = 128
N_EXPERTS = 32
TOP_K = 4
D_FF = D_MODEL
SWIGLU_LIMIT = 7.0
SWIGLU_ALPHA = 1.702
MOE_BLOCK = 256
LN_EPS = 1e-5
NEG_INF = -1e30
SCALE = HEAD_DIM ** -0.5
ALPHA = (2 * DEPTH) ** 0.25
BETA = (8 * DEPTH) ** -0.25
FORGET_BIAS_LO = 1.0
FORGET_BIAS_HI = 6.0

SPLIT_SIZES = (
    MIX_W,
    NSA_HEADS * HEAD_DIM,
    N_BRANCH * 2 * NSA_KV_GROUPS * HEAD_DIM,
    N_BRANCH * NSA_HEADS,
    3 * FOX_HEADS * HEAD_DIM,
    FOX_HEADS,
    N_BRANCH * D_MODEL,
)
SPLIT_IDX = tuple(sum(SPLIT_SIZES[:i + 1]) for i in range(len(SPLIT_SIZES) - 1))
IN_WIDTH = sum(SPLIT_SIZES)
FOX_F_OFFSET = SPLIT_IDX[4]

kernel_name = 'hybrid_pool_nsa_fox_moe_deepnorm'


def layer_norm(x, g, b):
    xf = x.astype(jnp.float32)
    mu = jnp.mean(xf, axis=-1, keepdims=True)
    var = jnp.mean(jnp.square(xf - mu), axis=-1, keepdims=True)
    return ((xf - mu) * lax.rsqrt(var + LN_EPS) * g + b).astype(x.dtype)


def masked_softmax(s, mask):
    s = jnp.where(mask, s.astype(jnp.float32), NEG_INF)
    return jnp.where(mask, jax.nn.softmax(s, axis=-1), 0.0)


def pool_mixer(u, w, b, scale):
    B, T, _ = u.shape
    uf = u.astype(jnp.float32)
    cs = jnp.concatenate([jnp.zeros((B, 1, MIX_W), jnp.float32), jnp.cumsum(uf, axis=1)], axis=1)
    t_idx = jnp.arange(T)
    outs = []
    for gi, win in enumerate(POOL_WINDOWS):
        sl = slice(gi * POOL_GC, (gi + 1) * POOL_GC)
        c = cs[:, :, sl]
        lag = jnp.pad(c, ((0, 0), (win, 0), (0, 0)))[:, :T + 1]
        wsum = c[:, 1:] - lag[:, 1:]
        cnt = jnp.minimum(t_idx + 1, win).astype(jnp.float32)
        outs.append(wsum / cnt[:, None] - uf[:, :, sl])
    d = jnp.stack(outs, axis=2)
    y = jnp.einsum('btgc,gcd->btgd', d, w.astype(jnp.float32)) + b
    return (y.reshape(B, T, MIX_W) * scale).astype(u.dtype)


def compress_blocks(k, pos, w1, b1, w2, b2):
    B, T, G, HD = k.shape
    n_chunk = T // CMP_STRIDE
    r = CMP_LEN // CMP_STRIDE
    nc = n_chunk - r + 1
    ch = k.reshape(B, n_chunk, CMP_STRIDE, G, HD)
    blocks = jnp.concatenate([ch[:, j:j + nc] for j in range(r)], axis=2)
    blocks = blocks + pos[:, None, :]
    flat = blocks.transpose(0, 1, 3, 2, 4).reshape(B, nc, G, CMP_LEN * HD)
    h = jax.nn.gelu(flat @ w1 + b1)
    return h @ w2 + b2


def nsa_attention(q, kv, g, cmp_pos, cmp_w1, cmp_b1, cmp_w2, cmp_b2):
    B, T, _ = q.shape
    G, HPG, HD = NSA_KV_GROUPS, NSA_HPG, HEAD_DIM
    q = q.reshape(B, T, G, HPG, HD)
    kv = kv.reshape(B, T, N_BRANCH, 2, G, HD)
    gates = jax.nn.sigmoid(g.astype(jnp.float32)).astype(q.dtype).reshape(B, T, G, HPG, N_BRANCH)
    kc = compress_blocks(kv[:, :, 0, 0], cmp_pos[0], cmp_w1[0], cmp_b1[0], cmp_w2[0], cmp_b2[0])
    vc = compress_blocks(kv[:, :, 0, 1], cmp_pos[1], cmp_w1[1], cmp_b1[1], cmp_w2[1], cmp_b2[1])
    NC = kc.shape[1]
    NS = T // SEL_LEN
    n_sel = min(N_SEL, NS)
    k_sel = kv[:, :, 1, 0].reshape(B, NS, SEL_LEN, G, HD).transpose(0, 3, 1, 2, 4)
    v_sel = kv[:, :, 1, 1].reshape(B, NS, SEL_LEN, G, HD).transpose(0, 3, 1, 2, 4)
    pad = ((0, 0), (WINDOW, 0), (0, 0), (0, 0))
    k_win = jnp.pad(kv[:, :, 2, 0], pad)
    v_win = jnp.pad(kv[:, :, 2, 1], pad)
    cmp_start = jnp.arange(NC) * CMP_STRIDE
    cmp_end = cmp_start + CMP_LEN - 1
    sel_blk = jnp.arange(NS)
    sel_start = sel_blk * SEL_LEN
    overlap = ((cmp_start[:, None] < sel_start[None, :] + SEL_LEN)
               & (cmp_start[:, None] + CMP_LEN > sel_start[None, :])).astype(jnp.float32)
    bi = jnp.arange(B)[:, None, None, None]
    gi = jnp.arange(G)[None, :, None, None]
    in_blk = jnp.arange(SEL_LEN)
    win_off = jnp.arange(WINDOW + Q_BLOCK) - WINDOW

    def block(i):
        t0 = i * Q_BLOCK
        tq = t0 + jnp.arange(Q_BLOCK)
        qb = lax.dynamic_slice_in_dim(q, t0, Q_BLOCK, axis=1)
        gb = lax.dynamic_slice_in_dim(gates, t0, Q_BLOCK, axis=1)
        s = jnp.einsum('bqghd,bcgd->bgqhc', qb, kc) * SCALE
        m = (cmp_end[None, :] <= tq[:, None])[None, None, :, None, :]
        p_cmp = masked_softmax(s, m)
        o_cmp = jnp.einsum('bgqhc,bcgd->bqghd', p_cmp.astype(vc.dtype), vc)
        imp = jnp.einsum('bgqhc,cs->bgqs', p_cmp, overlap)
        cur = tq // SEL_LEN
        forced = (sel_blk[None, :] == 0) | (sel_blk[None, :] == cur[:, None]) | (sel_blk[None, :] == cur[:, None] - 1)
        future = sel_start[None, :] > tq[:, None]
        score = jnp.where(future, -1.0, jnp.where(forced, 1e6, imp))
        _, idx = lax.top_k(score, n_sel)
        ks = k_sel[bi, gi, idx].reshape(B, G, Q_BLOCK, n_sel * SEL_LEN, HD)
        vs = v_sel[bi, gi, idx].reshape(B, G, Q_BLOCK, n_sel * SEL_LEN, HD)
        kpos = (idx[..., None] * SEL_LEN + in_blk).reshape(B, G, Q_BLOCK, n_sel * SEL_LEN)
        s = jnp.einsum('bqghd,bgqkd->bgqhk', qb, ks) * SCALE
        m = (kpos <= tq[None, None, :, None])[:, :, :, None, :]
        p = masked_softmax(s, m)
        o_slc = jnp.einsum('bgqhk,bgqkd->bqghd', p.astype(vs.dtype), vs)
        kw = lax.dynamic_slice_in_dim(k_win, t0, WINDOW + Q_BLOCK, axis=1)
        vw = lax.dynamic_slice_in_dim(v_win, t0, WINDOW + Q_BLOCK, axis=1)
        wpos = t0 + win_off
        dist = tq[:, None] - wpos[None, :]
        m = ((dist >= 0) & (dist < WINDOW) & (wpos[None, :] >= 0))[None, None, :, None, :]
        s = jnp.einsum('bqghd,bkgd->bgqhk', qb, kw) * SCALE
        p = masked_softmax(s, m)
        o_win = jnp.einsum('bgqhk,bkgd->bqghd', p.astype(vw.dtype), vw)
        return gb[..., 0:1] * o_cmp + gb[..., 1:2] * o_slc + gb[..., 2:3] * o_win

    o = lax.map(block, jnp.arange(T // Q_BLOCK))
    return o.transpose(1, 0, 2, 3, 4, 5).reshape(B, T, NSA_HEADS * HD)


def forgetting_attention(qkv, f_logit):
    B, T, _ = qkv.shape
    qkv = qkv.reshape(B, T, 3, FOX_HEADS, HEAD_DIM)
    q, k, v = qkv[:, :, 0], qkv[:, :, 1], qkv[:, :, 2]
    log_f = jax.nn.log_sigmoid(f_logit.astype(jnp.float32))
    cum = jnp.cumsum(log_f, axis=1).transpose(0, 2, 1)
    kpos = jnp.arange(T)

    def block(i):
        t0 = i * Q_BLOCK
        tq = t0 + jnp.arange(Q_BLOCK)
        qb = lax.dynamic_slice_in_dim(q, t0, Q_BLOCK, axis=1)
        cq = lax.dynamic_slice_in_dim(cum, t0, Q_BLOCK, axis=2)
        s = (jnp.einsum('bqhd,bkhd->bhqk', qb, k).astype(jnp.float32) * SCALE
             + cq[..., None] - cum[:, :, None, :])
        m = (kpos[None, :] <= tq[:, None])[None, None]
        p = masked_softmax(s, m)
        return jnp.einsum('bhqk,bkhd->bqhd', p.astype(v.dtype), v)

    o = lax.map(block, jnp.arange(T // Q_BLOCK))
    return o.transpose(1, 0, 2, 3, 4).reshape(B, T, FOX_HEADS * HEAD_DIM)


def hybrid_mixer(x, w_in, b_in, pool_w, pool_b, pool_scale, cmp_pos, cmp_w1, cmp_b1, cmp_w2, cmp_b2, w_up, w_o):
    B, T, D = x.shape
    z = x @ w_in + b_in
    u_pool, q_nsa, kv_nsa, g_nsa, qkv_fox, f_fox, g_mrg = jnp.split(z, list(SPLIT_IDX), axis=-1)
    y_pool = pool_mixer(u_pool, pool_w, pool_b, pool_scale)
    y_nsa = nsa_attention(q_nsa, kv_nsa, g_nsa, cmp_pos, cmp_w1, cmp_b1, cmp_w2, cmp_b2)
    y_fox = forgetting_attention(qkv_fox, f_fox)
    ys = jnp.stack([y_pool, y_nsa, y_fox], axis=2)
    up = jnp.einsum('btnc,ncd->btnd', ys, w_up)
    gate = jax.nn.sigmoid(g_mrg.astype(jnp.float32)).astype(x.dtype).reshape(B, T, N_BRANCH, D)
    return jnp.sum(gate * up, axis=2) @ w_o


def moe_ffn(x, router_w, router_b, w1, b1, w2, b2):
    B, T, D = x.shape
    N = B * T
    NK = N * TOP_K
    xf = x.reshape(N, D)
    logits = (xf @ router_w + router_b).astype(jnp.float32)
    top_v, top_i = lax.top_k(logits, TOP_K)
    gates = jax.nn.softmax(top_v, axis=-1)
    e_flat = top_i.reshape(NK)
    g_flat = gates.reshape(NK)
    tok = jnp.arange(NK) // TOP_K
    order = jnp.argsort(e_flat)
    e_sorted = e_flat[order]
    counts = jnp.bincount(e_flat, length=N_EXPERTS)
    start = jnp.cumsum(counts) - counts
    padded = (counts + MOE_BLOCK - 1) // MOE_BLOCK * MOE_BLOCK
    pend = jnp.cumsum(padded)
    pstart = pend - padded
    dest = pstart[e_sorted] + (jnp.arange(NK) - start[e_sorted])
    P = ((NK + MOE_BLOCK - 1) // MOE_BLOCK + N_EXPERTS) * MOE_BLOCK
    n_blk = P // MOE_BLOCK
    buf_tok = jnp.full((P,), N, jnp.int32).at[dest].set(tok[order])
    buf_gate = jnp.zeros((P,), jnp.float32).at[dest].set(g_flat[order])
    blk_e = jnp.minimum(jnp.sum(jnp.arange(n_blk)[:, None] * MOE_BLOCK >= pend[None, :], axis=1), N_EXPERTS - 1)
    xpad = jnp.concatenate([xf, jnp.zeros((1, D), xf.dtype)], axis=0)
    xb = xpad[buf_tok].reshape(n_blk, MOE_BLOCK, D)

    def expert_block(args):
        xblk, e = args
        h = xblk @ w1[e] + b1[e]
        gate, upv = jnp.split(h, 2, axis=-1)
        gate = jnp.minimum(gate, SWIGLU_LIMIT)
        upv = jnp.clip(upv, -SWIGLU_LIMIT, SWIGLU_LIMIT)
        act = (upv + 1.0) * (gate * jax.nn.sigmoid(SWIGLU_ALPHA * gate))
        return act @ w2[e] + b2[e]

    yb = lax.map(expert_block, (xb, blk_e)).reshape(P, D)
    y = jax.ops.segment_sum(yb * buf_gate[:, None].astype(yb.dtype), buf_tok, num_segments=N + 1)[:N]
    return y.reshape(B, T, D)


def setup_inputs(seed: int = 0) -> dict:
    key = jax.random.key(seed)
    ks = jax.random.split(key, 24)
    L, D = DEPTH, D_MODEL

    def nrm(k, shape, scale):
        return jax.random.normal(k, shape, jnp.float32) * scale

    b_in = nrm(ks[2], (L, IN_WIDTH), 0.02)
    b_in = b_in.at[:, FOX_F_OFFSET:FOX_F_OFFSET + FOX_HEADS].add(
        jnp.linspace(FORGET_BIAS_LO, FORGET_BIAS_HI, FOX_HEADS))
    return {
        'x': nrm(ks[0], (BATCH, SEQ, D), 1.0),
        'w_in': nrm(ks[1], (L, D, IN_WIDTH), D ** -0.5),
        'b_in': b_in,
        'pool_w': nrm(ks[3], (L, POOL_GROUPS, POOL_GC, POOL_GC), POOL_GC ** -0.5),
        'pool_b': nrm(ks[4], (L, POOL_GROUPS, POOL_GC), 0.02),
        'pool_scale': 1.0 + nrm(ks[5], (L, MIX_W), 0.02),
        'cmp_pos': nrm(ks[6], (L, 2, CMP_LEN, HEAD_DIM), 0.02),
        'cmp_w1': nrm(ks[7], (L, 2, CMP_LEN * HEAD_DIM, CMP_HID), (CMP_LEN * HEAD_DIM) ** -0.5),
        'cmp_b1': nrm(ks[8], (L, 2, CMP_HID), 0.02),
        'cmp_w2': nrm(ks[9], (L, 2, CMP_HID, HEAD_DIM), CMP_HID ** -0.5),
        'cmp_b2': nrm(ks[10], (L, 2, HEAD_DIM), 0.02),
        'w_up': nrm(ks[11], (L, N_BRANCH, MIX_W, D), MIX_W ** -0.5),
        'w_o': nrm(ks[12], (L, D, D), BETA * D ** -0.5),
        'ln1_g': 1.0 + nrm(ks[13], (L, D), 0.02),
        'ln1_b': nrm(ks[14], (L, D), 0.02),
        'router_w': nrm(ks[15], (L, D, N_EXPERTS), D ** -0.5),
        'router_b': nrm(ks[16], (L, N_EXPERTS), 0.01),
        'moe_w1': nrm(ks[17], (L, N_EXPERTS, D, 2 * D_FF), D ** -0.5),
        'moe_b1': nrm(ks[18], (L, N_EXPERTS, 2 * D_FF), 0.02),
        'moe_w2': nrm(ks[19], (L, N_EXPERTS, D_FF, D), BETA * D_FF ** -0.5),
        'moe_b2': nrm(ks[20], (L, N_EXPERTS, D), 0.02),
        'ln2_g': 1.0 + nrm(ks[21], (L, D), 0.02),
        'ln2_b': nrm(ks[22], (L, D), 0.02),
    }


def reference(x, w_in, b_in, pool_w, pool_b, pool_scale, cmp_pos, cmp_w1, cmp_b1, cmp_w2, cmp_b2,
              w_up, w_o, ln1_g, ln1_b, router_w, router_b, moe_w1, moe_b1, moe_w2, moe_b2, ln2_g, ln2_b):
    for l in range(DEPTH):
        h = hybrid_mixer(x, w_in[l], b_in[l], pool_w[l], pool_b[l], pool_scale[l], cmp_pos[l],
                         cmp_w1[l], cmp_b1[l], cmp_w2[l], cmp_b2[l], w_up[l], w_o[l])
        x = layer_norm(ALPHA * x + h, ln1_g[l], ln1_b[l])
        h = moe_ffn(x, router_w[l], router_b[l], moe_w1[l], moe_b1[l], moe_w2[l], moe_b2[l])
        x = layer_norm(ALPHA * x + h, ln2_g[l], ln2_b[l])
    return x
```

```cpp
#include <hip/hip_runtime.h>
#include <hip/hip_cooperative_groups.h>
#include <cstdio>
#include <cstdint>
namespace cg = cooperative_groups;

constexpr int NTOK = 16384, SEQ = 8192, DM = 1024, NLAYER = 2;
constexpr int INW = 6432;
constexpr int ZP = 6400;
constexpr int NINP = 6656;
constexpr int NEXP = 32, PSLOTS = 73728, NBLK = 288;
constexpr float LN_EPS = 1e-5f;
constexpr float QSCALE = 0.125f * 1.4426950408889634f;
constexpr float LOG2E = 1.4426950408889634f;
constexpr float ALPHA = 1.4142135623730951f;
constexpr int ZC_POOL = 0, ZC_QN = 512, ZC_KVN = 1024, ZC_FOX = 1792, ZC_GM = 3328;

constexpr size_t MiB = 1u << 20;
constexpr size_t WS_CTL = 0;
constexpr size_t WS_BIAS = 1 * MiB;
constexpr size_t WS_WIN = 2 * MiB, WIN_L = 13 * MiB;
constexpr size_t WS_WUP = 28 * MiB, WUP_L = 3 * MiB;
constexpr size_t WS_WO = 34 * MiB, WO_L = 2 * MiB;
constexpr size_t WS_WC1 = 38 * MiB, WC1_L = 2 * MiB;
constexpr size_t WS_WM1 = 48 * MiB, WM1_L = 128 * MiB;
constexpr size_t WS_WM2 = 304 * MiB, WM2_L = 64 * MiB;
constexpr size_t WS_Z = 432 * MiB;
constexpr size_t WS_S32 = 640 * MiB;
constexpr size_t WS_CUM = 642 * MiB;
constexpr size_t WS_H1 = 643 * MiB;
constexpr size_t WS_KC = 645 * MiB;
constexpr size_t WS_SEL = 646 * MiB;
constexpr size_t WS_YS = 648 * MiB;
constexpr size_t WS_ONSA = 696 * MiB;
constexpr size_t WS_MSCR = 728 * MiB;
constexpr size_t WS_MRG = 792 * MiB;
constexpr size_t WS_V1 = 824 * MiB;
constexpr size_t WS_XB = 888 * MiB;
constexpr size_t WS_MOE = 920 * MiB;
constexpr size_t MOE_TOPI = 0, MOE_TOPG = 256 * 1024, MOE_TOKSLOT = 512 * 1024, MOE_HIST = 768 * 1024, MOE_BLK = 832 * 1024,
                 MOE_SLOTTOK = 1024 * 1024, MOE_SLOTG = 1536 * 1024;
constexpr size_t WS_XS = 924 * MiB;
constexpr size_t WS_ACT = 1068 * MiB;
constexpr size_t WS_YB = 1212 * MiB;
constexpr size_t WS_END = 1356 * MiB;

constexpr int NWAVES = 8, NTHREADS = 512;
constexpr int LDS_BYTES = 147456;

#define LAS __attribute__((address_space(3)))
typedef unsigned short bf16_t;
typedef short bf16x8 __attribute__((ext_vector_type(8)));
typedef float f32x4 __attribute__((ext_vector_type(4)));
typedef float f32x16 __attribute__((ext_vector_type(16)));
typedef unsigned u32x4 __attribute__((ext_vector_type(4)));
typedef unsigned u32x2 __attribute__((ext_vector_type(2)));
typedef float f32x2_t __attribute__((ext_vector_type(2)));
typedef __bf16 bf16x2_t __attribute__((ext_vector_type(2)));

__device__ __forceinline__ unsigned cvtpk(float lo, float hi) { f32x2_t v = {lo, hi}; bf16x2_t b = __builtin_convertvector(v, bf16x2_t); return __builtin_bit_cast(unsigned, b); }
__device__ __forceinline__ float bf2f(bf16_t v) { return __uint_as_float((unsigned)v << 16); }
__device__ __forceinline__ float bflo(unsigned w) { return __uint_as_float(w << 16); }
__device__ __forceinline__ float bfhi(unsigned w) { return __uint_as_float(w & 0xffff0000u); }
__device__ __forceinline__ float wave_sum(float v) {
#pragma unroll
    for (int o = 1; o < 64; o <<= 1) v += __shfl_xor(v, o);
    return v;
}
__device__ __forceinline__ float sigmoidf_(float x) { return 1.f / (1.f + __expf(-x)); }

struct Args {
    const float* in[23];
    float* out;
    unsigned char* ws;
    int ph_lo, ph_hi;
};
namespace pg8 {
constexpr int BM = 256, BK = 64, HALF = 128, HTB = HALF * BK * 2  , STAGE_BYTES = 8 * HTB;

__host__ __device__ __forceinline__ int lds_byte(int r, int c) { const int st = (r >> 4) * 2 + (c >> 5), rr = r & 15, cc = c & 31, ob = rr * 64 + cc * 2; return st * 1024 + (ob ^ (((ob >> 9) & 1) << 5)); }
__host__ __device__ __forceinline__ void stage_rc(int b, int& R, int& C) { const int st = b / 1024, sb = b % 1024, swz = sb ^ (((sb >> 9) & 1) << 5); R = (st >> 1) * 16 + swz / 64; C = (st & 1) * 32 + (swz % 64) / 2; }
__host__ __device__ __forceinline__ int perm32(int rho) { const int n = rho >> 4, i = rho & 15; return 8 * (i >> 2) + 4 * n + (i & 3); }

struct Unit { int pm, pn, aux; size_t aoff, boff; };
struct Gemm { const bf16_t* A; const bf16_t* Bt; int lda, ldb, K; int kstepA; };

template <class Epi, class Sched>
__device__ __forceinline__ void gemm_phase(LAS unsigned char* lds, const Gemm g, const Sched& S, const Epi& E) {
    const int tid = threadIdx.x, wid = __builtin_amdgcn_readfirstlane(tid >> 6), lane = tid & 63, wr = wid >> 2, wc = wid & 3, fr = lane & 15, fq = lane >> 4;
    const int K = g.K, nt = K / BK;
    unsigned voffA[2], voffB[2];
#pragma unroll
    for (int i = 0; i < 2; ++i) { int R, C; stage_rc(tid * 16 + i * 8192, R, C); const int Rb = (R & ~31) + perm32(R & 31);
        voffA[i] = (unsigned)(R * g.lda + C) * 2u; voffB[i] = (unsigned)(Rb * g.ldb + C) * 2u; }
    const size_t kstepA = (size_t)g.kstepA, kstepB = (size_t)(BK * 2);
    const size_t hstepA = (size_t)HALF * g.lda * 2, hstepB = (size_t)HALF * g.ldb * 2;
    const unsigned ldsw = (unsigned)wid * 1024u;
    const int aoff = lds_byte(wr * 64 + fr, fq * 8), boff = lds_byte(wc * 32 + fr, fq * 8);
#define PG8_SA(b, h) (((b) * 2 + (h)) * HTB)
#define PG8_SB(b, h) ((4 + (b) * 2 + (h)) * HTB)
#define PG8_STAGE(bufoff, gbase, voff) do { _Pragma("unroll") for (int _i = 0; _i < 2; ++_i) \
        __builtin_amdgcn_global_load_lds((const unsigned*)((const char*)(gbase) + (voff)[_i]), (LAS unsigned*)(lds + (bufoff) + ldsw + _i * 8192), 16, 0, 0); } while (0)
#define PG8_LDA(dst, b, h) do { _Pragma("unroll") for (int m = 0; m < 4; ++m) _Pragma("unroll") for (int k = 0; k < 2; ++k) dst[m][k] = *(const LAS bf16x8*)(lds + PG8_SA(b, h) + aoff + m * 2048 + k * 1024); } while (0)
#define PG8_LDB(dst, b, h) do { _Pragma("unroll") for (int n = 0; n < 2; ++n) _Pragma("unroll") for (int k = 0; k < 2; ++k) dst[n][k] = *(const LAS bf16x8*)(lds + PG8_SB(b, h) + boff + n * 2048 + k * 1024); } while (0)
#define PG8_MMA(ai, bj, At, Bt) do { __builtin_amdgcn_s_setprio(1); _Pragma("unroll") for (int m = 0; m < 4; ++m) _Pragma("unroll") for (int n = 0; n < 2; ++n) _Pragma("unroll") for (int k = 0; k < 2; ++k) \
        acc[ai][bj][m][n] = __builtin_amdgcn_mfma_f32_16x16x32_bf16(Bt[n][k], At[m][k], acc[ai][bj][m][n], 0, 0, 0); __builtin_amdgcn_s_setprio(0); } while (0)
#define PG8_WAIT_V(n) asm volatile("s_waitcnt vmcnt(" #n ")" ::: "memory")
#define PG8_WAIT_L(n) asm volatile("s_waitcnt lgkmcnt(" #n ")" ::: "memory")
#define PG8_BAR __builtin_amdgcn_s_barrier()
#define PG8_SCHED __builtin_amdgcn_sched_barrier(0)
    Unit cur, nxt; int ui = 0;
    if (!S.next(0, cur)) return;
    f32x4 acc[2][2][4][2];
#pragma unroll
    for (int a = 0; a < 2; ++a)
#pragma unroll
        for (int b = 0; b < 2; ++b)
#pragma unroll
            for (int m = 0; m < 4; ++m)
#pragma unroll
                for (int n = 0; n < 2; ++n) acc[a][b][m][n] = (f32x4){0.f, 0.f, 0.f, 0.f};
    bf16x8 At[4][2], B0[2][2], B1[2][2];
    const char* cA = (const char*)g.A + cur.aoff; const char* cB = (const char*)g.Bt + cur.boff;
    PG8_STAGE(PG8_SB(0, 0), cB, voffB); PG8_STAGE(PG8_SB(0, 1), cB + hstepB, voffB); PG8_STAGE(PG8_SA(0, 0), cA, voffA); PG8_STAGE(PG8_SA(0, 1), cA + hstepA, voffA);
    if (wr == 1) PG8_BAR;
    PG8_WAIT_V(2); PG8_BAR;
    PG8_STAGE(PG8_SB(1, 0), cB + kstepB, voffB); PG8_STAGE(PG8_SA(1, 0), cA + kstepA, voffA); PG8_STAGE(PG8_SB(1, 1), cB + hstepB + kstepB, voffB);
    PG8_WAIT_V(6); PG8_BAR;
    for (;;) {
        const bool has_next = S.next(ui + 1, nxt);
        const char* nA = has_next ? (const char*)g.A + nxt.aoff : cA; const char* nB = has_next ? (const char*)g.Bt + nxt.boff : cB;
        for (int t = 0; t < nt; t += 2) {
            const bool last = (t == nt - 2);
            const char* a1 = cA + (size_t)(t + 1) * kstepA;
            const char* a2 = last ? nA : cA + (size_t)(t + 2) * kstepA; const char* b2 = last ? nB : cB + (size_t)(t + 2) * kstepB;
            const char* a3 = a2 + kstepA; const char* b3 = b2 + kstepB;
            PG8_LDB(B0, 0, 0); PG8_LDB(B1, 0, 1); PG8_SCHED; PG8_LDA(At, 0, 0); PG8_STAGE(PG8_SA(1, 1), a1 + hstepA, voffA);
            PG8_WAIT_V(8); PG8_WAIT_L(0); PG8_BAR; PG8_MMA(0, 0, At, B0); PG8_MMA(0, 1, At, B1); PG8_BAR; PG8_SCHED;
            PG8_LDA(At, 0, 1); PG8_STAGE(PG8_SB(0, 0), b2, voffB); PG8_STAGE(PG8_SB(0, 1), b2 + hstepB, voffB); PG8_STAGE(PG8_SA(0, 0), a2, voffA);
            PG8_WAIT_V(8); PG8_WAIT_L(0); PG8_BAR; PG8_MMA(1, 0, At, B0); PG8_MMA(1, 1, At, B1); PG8_BAR; PG8_SCHED;
            PG8_LDB(B0, 1, 0); PG8_LDB(B1, 1, 1); PG8_SCHED; PG8_LDA(At, 1, 0); PG8_STAGE(PG8_SA(0, 1), a2 + hstepA, voffA);
            PG8_WAIT_V(8); PG8_WAIT_L(0); PG8_BAR; PG8_MMA(0, 0, At, B0); PG8_MMA(0, 1, At, B1); PG8_BAR; PG8_SCHED;
            PG8_LDA(At, 1, 1); PG8_STAGE(PG8_SB(1, 0), b3, voffB); PG8_STAGE(PG8_SB(1, 1), b3 + hstepB, voffB); PG8_STAGE(PG8_SA(1, 0), a3, voffA);
            PG8_WAIT_V(8); PG8_WAIT_L(0); PG8_BAR; PG8_MMA(1, 0, At, B0); PG8_MMA(1, 1, At, B1); PG8_BAR; PG8_SCHED;
        }
        if (wr == 0) PG8_BAR;
        E(acc, cur, wr, wc, fr, fq);
        if (!has_next) break;
#pragma unroll
        for (int a = 0; a < 2; ++a)
#pragma unroll
            for (int b = 0; b < 2; ++b)
#pragma unroll
                for (int m = 0; m < 4; ++m)
#pragma unroll
                    for (int n = 0; n < 2; ++n) acc[a][b][m][n] = (f32x4){0.f, 0.f, 0.f, 0.f};
        cur = nxt; cA = nA; cB = nB; ++ui;
        if (wr == 1) PG8_BAR;
    }
    PG8_WAIT_V(0);
    PG8_BAR;
#undef PG8_SA
#undef PG8_SB
#undef PG8_STAGE
#undef PG8_LDA
#undef PG8_LDB
#undef PG8_MMA
#undef PG8_WAIT_V
#undef PG8_WAIT_L
#undef PG8_BAR
#undef PG8_SCHED
}

struct TileOrder {
    int nM, nN, nwg, G, c;
    __device__ __forceinline__ void init(int nM_, int nN_, int G_, int c_) { nM = nM_; nN = nN_; nwg = nM * nN; G = G_; c = c_; }
    __device__ __forceinline__ bool tile(int i, int& pm, int& pn) const {
        const long L = (long)i * G + c; if (L >= nwg) return false;
        int wgid = (int)L; { const int q = nwg / 8, r = nwg % 8, xcd = wgid % 8, off = wgid / 8; wgid = (xcd < r ? xcd * (q + 1) : r * (q + 1) + (xcd - r) * q) + off; }
        const int nig = 8 * nN, gid = wgid / nig, fm = gid * 8, gsz = (nM - fm) < 8 ? (nM - fm) : 8;
        pm = fm + ((wgid % nig) % gsz); pn = (wgid % nig) / gsz; return true;
    }
};
}
using pg8::Unit;
typedef const f32x4 (&AccT)[2][2][4][2];

__device__ __forceinline__ float log_sigmoidf_(float x) { return fminf(x, 0.f) - log1pf(__expf(-fabsf(x))); }
__device__ __forceinline__ float gelu_tanhf_(float x) { const float y = 0.7978845608028654f * (x + 0.044715f * x * x * x); const float t = 1.f - 2.f / (__expf(2.f * y) + 1.f); return 0.5f * x * (1.f + t); }
__device__ __forceinline__ u32x4 pack8(const f32x4 a, const f32x4 b) { u32x4 w; w.x = cvtpk(a[0], a[1]); w.y = cvtpk(a[2], a[3]); w.z = cvtpk(b[0], b[1]); w.w = cvtpk(b[2], b[3]); return w; }

struct SchedInProj {
    pg8::TileOrder o;
    __device__ __forceinline__ bool next(int i, Unit& u) const { int pm, pn; if (!o.tile(i, pm, pn)) return false; u.pm = pm; u.pn = pn; u.aux = 0;
        u.aoff = (size_t)pm * 256 * DM * 2; u.boff = (size_t)pn * 256 * DM * 2; return true; }
};
struct EpiInProj {
    bf16_t* Z; float* S32; const float* bias;
    __device__ __forceinline__ void operator()(AccT acc, const Unit& u, int wr, int wc, int fr, int fq) const {
        const int pn = u.pn, row0 = u.pm * 256 + wr * 64 + fr;
        if (pn < 25) {
            const bool isq = (pn == 2 || pn == 3 || pn == 7 || pn == 8), issig = pn >= 13;
            const int col0 = pn * 256 + wc * 32 + 8 * fq;
            f32x4 bv[2][2];
#pragma unroll
            for (int bj = 0; bj < 2; ++bj)
#pragma unroll
                for (int n = 0; n < 2; ++n) bv[bj][n] = *(const f32x4*)(bias + col0 + bj * 128 + 4 * n);
#pragma unroll
            for (int ai = 0; ai < 2; ++ai)
#pragma unroll
                for (int m = 0; m < 4; ++m) { bf16_t* rowp = Z + (size_t)(row0 + ai * 128 + m * 16) * ZP + col0;
#pragma unroll
                    for (int bj = 0; bj < 2; ++bj) { f32x4 v0 = acc[ai][bj][m][0] + bv[bj][0], v1 = acc[ai][bj][m][1] + bv[bj][1];
                        if (isq) { v0 = v0 * QSCALE; v1 = v1 * QSCALE; }
                        if (issig) {
#pragma unroll
                            for (int i = 0; i < 4; ++i) { v0[i] = sigmoidf_(v0[i]); v1[i] = sigmoidf_(v1[i]); } }
                        *(u32x4*)(rowp + bj * 128) = pack8(v0, v1); } }
        } else if (wc == 0) {
            const int c0 = 8 * fq;
            const f32x4 b0 = *(const f32x4*)(bias + 6400 + c0), b1 = *(const f32x4*)(bias + 6400 + c0 + 4);
#pragma unroll
            for (int ai = 0; ai < 2; ++ai)
#pragma unroll
                for (int m = 0; m < 4; ++m) { float* rowp = S32 + (size_t)(row0 + ai * 128 + m * 16) * 32 + c0;
                    f32x4 v0 = acc[ai][0][m][0] + b0, v1 = acc[ai][0][m][1] + b1;
#pragma unroll
                    for (int i = 0; i < 4; ++i) { v0[i] = (fq < 3) ? sigmoidf_(v0[i]) : log_sigmoidf_(v0[i]); v1[i] = (fq < 3) ? sigmoidf_(v1[i]) : log_sigmoidf_(v1[i]); }
                    *(f32x4*)(rowp) = v0; *(f32x4*)(rowp + 4) = v1; }
        }
    }
};

struct SchedC1 {
    int c;
    __device__ __forceinline__ bool next(int i, Unit& u) const { if (i > 0 || c >= 16) return false; const int kv = c >> 3, pm = c & 7, bg = pm >> 1, half = pm & 1, b = bg >> 1, gq = bg & 1;
        u.pm = pm; u.pn = 0; u.aux = kv; u.aoff = ((size_t)(b * SEQ + 16 * 256 * half) * ZP + ZC_KVN + kv * 128 + gq * 64) * 2; u.boff = (size_t)kv * 256 * 2048 * 2; return true; }
};
struct EpiC1 {
    bf16_t* H1; const float* b1c;
    __device__ __forceinline__ void operator()(AccT acc, const Unit& u, int wr, int wc, int fr, int fq) const {
        const int kv = u.aux, row0 = u.pm * 256 + wr * 64 + fr, col0 = wc * 32 + 8 * fq;
#pragma unroll
        for (int ai = 0; ai < 2; ++ai)
#pragma unroll
            for (int m = 0; m < 4; ++m) { bf16_t* rowp = H1 + ((size_t)kv * 2048 + row0 + ai * 128 + m * 16) * 256 + col0;
#pragma unroll
                for (int bj = 0; bj < 2; ++bj) { f32x4 v0 = acc[ai][bj][m][0] + *(const f32x4*)(b1c + kv * 256 + col0 + bj * 128), v1 = acc[ai][bj][m][1] + *(const f32x4*)(b1c + kv * 256 + col0 + bj * 128 + 4);
#pragma unroll
                    for (int i = 0; i < 4; ++i) { v0[i] = gelu_tanhf_(v0[i]); v1[i] = gelu_tanhf_(v1[i]); }
                    *(u32x4*)(rowp + bj * 128) = pack8(v0, v1); } }
    }
};

struct SchedUp {
    pg8::TileOrder o;
    __device__ __forceinline__ bool next(int i, Unit& u) const { int pm, pn; const int ti = i / 3, nb = i - 3 * ti; if (!o.tile(ti, pm, pn)) return false; u.pm = pm; u.pn = pn; u.aux = nb;
        u.aoff = ((size_t)pm * 256 * 1536 + nb * 512) * 2; u.boff = ((size_t)(nb * 1024 + pn * 256) * 512) * 2; return true; }
};
struct EpiUp {
    const bf16_t* Z; float* scr; bf16_t* MRG;
    __device__ __forceinline__ void operator()(AccT acc, const Unit& u, int wr, int wc, int fr, int fq) const {
        const int nb = u.aux, row0 = u.pm * 256 + wr * 64 + fr, col0 = u.pn * 256 + wc * 32 + 8 * fq;
#pragma unroll
        for (int ai = 0; ai < 2; ++ai)
#pragma unroll
            for (int m = 0; m < 4; ++m) { const size_t row = (size_t)(row0 + ai * 128 + m * 16);
#pragma unroll
                for (int bj = 0; bj < 2; ++bj) { const int col = col0 + bj * 128;
                    const u32x4 gw = *(const u32x4*)(Z + row * ZP + ZC_GM + nb * 1024 + col);
                    f32x4 v0 = acc[ai][bj][m][0], v1 = acc[ai][bj][m][1];
                    v0[0] *= bflo(gw.x); v0[1] *= bfhi(gw.x); v0[2] *= bflo(gw.y); v0[3] *= bfhi(gw.y); v1[0] *= bflo(gw.z); v1[1] *= bfhi(gw.z); v1[2] *= bflo(gw.w); v1[3] *= bfhi(gw.w);
                    float* sp = scr + row * DM + col;
                    if (nb > 0) { v0 = v0 + *(const f32x4*)sp; v1 = v1 + *(const f32x4*)(sp + 4); }
                    if (nb < 2) { *(f32x4*)sp = v0; *(f32x4*)(sp + 4) = v1; }
                    else *(u32x4*)(MRG + row * DM + col) = pack8(v0, v1); } }
    }
};

struct SchedWo {
    pg8::TileOrder o;
    __device__ __forceinline__ bool next(int i, Unit& u) const { int pm, pn; if (!o.tile(i, pm, pn)) return false; u.pm = pm; u.pn = pn; u.aux = 0;
        u.aoff = (size_t)pm * 256 * DM * 2; u.boff = (size_t)pn * 256 * DM * 2; return true; }
};
struct EpiWo {
    const float* X; float* V1;
    __device__ __forceinline__ void operator()(AccT acc, const Unit& u, int wr, int wc, int fr, int fq) const {
        const int row0 = u.pm * 256 + wr * 64 + fr, col0 = u.pn * 256 + wc * 32 + 8 * fq;
#pragma unroll
        for (int ai = 0; ai < 2; ++ai)
#pragma unroll
            for (int m = 0; m < 4; ++m) { const size_t off = (size_t)(row0 + ai * 128 + m * 16) * DM + col0;
#pragma unroll
                for (int bj = 0; bj < 2; ++bj) { const f32x4 x0 = *(const f32x4*)(X + off + bj * 128), x1 = *(const f32x4*)(X + off + bj * 128 + 4);
                    *(f32x4*)(V1 + off + bj * 128) = x0 * ALPHA + acc[ai][bj][m][0]; *(f32x4*)(V1 + off + bj * 128 + 4) = x1 * ALPHA + acc[ai][bj][m][1]; } }
    }
};

struct SchedMoe {
    const int* blk; int nblk, G, c, ntn, nrowB;
    __device__ __forceinline__ bool next(int i, Unit& u) const { const long L = (long)i * G + c; const int b = (int)(L / ntn), tn = (int)(L % ntn); if (b >= nblk) return false; const int e = blk[b];
        u.pm = b; u.pn = tn; u.aux = e; u.aoff = (size_t)b * 256 * DM * 2; u.boff = ((size_t)e * nrowB + tn * 256) * DM * 2; return true; }
};
struct EpiMoe1 {
    bf16_t* ACT; const float* b1;
    __device__ __forceinline__ void operator()(AccT acc, const Unit& u, int wr, int wc, int fr, int fq) const {
        const int e = u.aux, row0 = u.pm * 256 + wr * 64 + fr, cg0 = u.pn * 128 + wc * 32 + 8 * fq;
        const float* bp = b1 + (size_t)e * 2048 + cg0;
        const f32x4 bg0 = *(const f32x4*)bp, bg1 = *(const f32x4*)(bp + 4), bu0 = *(const f32x4*)(bp + 1024), bu1 = *(const f32x4*)(bp + 1028);
#pragma unroll
        for (int ai = 0; ai < 2; ++ai)
#pragma unroll
            for (int m = 0; m < 4; ++m) { const size_t row = (size_t)(row0 + ai * 128 + m * 16);
                f32x4 g0 = acc[ai][0][m][0] + bg0, g1 = acc[ai][0][m][1] + bg1, u0 = acc[ai][1][m][0] + bu0, u1 = acc[ai][1][m][1] + bu1, a0, a1;
#pragma unroll
                for (int i = 0; i < 4; ++i) {
                    float gg = fminf(g0[i], 7.f), uu = fminf(fmaxf(u0[i], -7.f), 7.f); a0[i] = (uu + 1.f) * (gg * sigmoidf_(1.702f * gg));
                    gg = fminf(g1[i], 7.f); uu = fminf(fmaxf(u1[i], -7.f), 7.f); a1[i] = (uu + 1.f) * (gg * sigmoidf_(1.702f * gg)); }
                *(u32x4*)(ACT + row * DM + cg0) = pack8(a0, a1); }
    }
};
struct EpiMoe2 {
    bf16_t* YB; const float* b2; const float* sg;
    __device__ __forceinline__ void operator()(AccT acc, const Unit& u, int wr, int wc, int fr, int fq) const {
        const int e = u.aux, row0 = u.pm * 256 + wr * 64 + fr, col0 = u.pn * 256 + wc * 32 + 8 * fq;
#pragma unroll
        for (int ai = 0; ai < 2; ++ai)
#pragma unroll
            for (int m = 0; m < 4; ++m) { const size_t row = (size_t)(row0 + ai * 128 + m * 16); const float gt = sg[row];
#pragma unroll
                for (int bj = 0; bj < 2; ++bj) { const float* bp = b2 + (size_t)e * DM + col0 + bj * 128;
                    const f32x4 v0 = (acc[ai][bj][m][0] + *(const f32x4*)bp) * gt, v1 = (acc[ai][bj][m][1] + *(const f32x4*)(bp + 4)) * gt;
                    *(u32x4*)(YB + row * DM + col0 + bj * 128) = pack8(v0, v1); } }
    }
};
namespace att {
enum { M_FOX = 0, M_WIN = 1, M_SLC = 2, M_CMP = 3 };
constexpr int BUFSZ = 16640;
constexpr int IMP_OFF = 2 * BUFSZ;
constexpr int IMP_W = 132;
constexpr int LDS_NEED = IMP_OFF + 8 * 8 * IMP_W * 4;
typedef short v4i16_t __attribute__((ext_vector_type(4)));
typedef short s16x4 __attribute__((ext_vector_type(4)));

struct P { const bf16_t* Z; const float* S32; const float* cum; const bf16_t* KC; const bf16_t* VC; unsigned* sel; float* onsa; bf16_t* YS; };

__device__ __forceinline__ s16x4 vtr(LAS const unsigned char* p) { return __builtin_bit_cast(s16x4, __builtin_amdgcn_ds_read_tr16_b64_v4i16((LAS v4i16_t*)p)); }
#define MFMA32(a, b, c) __builtin_amdgcn_mfma_f32_32x32x16_bf16((a), (b), (c), 0, 0, 0)

template <int MODE>
__device__ __forceinline__ void attn_unit(LAS unsigned char* lds, const P& A, const int b, const int hg, const int qb) {
    const int tid = threadIdx.x, lane = tid & 63, wid = __builtin_amdgcn_readfirstlane(tid >> 6), r32 = lane & 31, hi = lane >> 5;
    const float NEG_INF = -__builtin_inff();
    int tq, qcol, hh = 0;
    if (MODE == M_FOX) { tq = qb * 256 + wid * 32 + r32; qcol = ZC_FOX + hg * 64; }
    else { hh = r32 >> 3; tq = qb * 64 + wid * 8 + (r32 & 7); qcol = ZC_QN + (hg * 4 + hh) * 64; }
    const size_t tokrow = (size_t)b * SEQ + tq;
    bf16x8 qf[4];
    { const bf16_t* qp = A.Z + tokrow * ZP + qcol + hi * 8;
#pragma unroll
      for (int ds = 0; ds < 4; ++ds) qf[ds] = *(const bf16x8*)(qp + ds * 16); }
    const bf16_t *Kg, *Vg; int kp, t_lo, t_hi;
    if (MODE == M_FOX) { Kg = A.Z + (size_t)b * SEQ * ZP + ZC_FOX + 512 + hg * 64; Vg = Kg + 512; kp = ZP; t_lo = 0; t_hi = 4 * qb + 3; }
    else if (MODE == M_WIN) { Kg = A.Z + (size_t)b * SEQ * ZP + ZC_KVN + 512 + hg * 64; Vg = Kg + 128; kp = ZP; t_lo = qb > 8 ? qb - 8 : 0; t_hi = qb; }
    else if (MODE == M_SLC) { Kg = A.Z + (size_t)b * SEQ * ZP + ZC_KVN + 256 + hg * 64; Vg = Kg + 128; kp = ZP; t_lo = 0; t_hi = qb; }
    else { Kg = A.KC + (size_t)(b * 2 + hg) * 512 * 64; Vg = A.VC + (size_t)(b * 2 + hg) * 512 * 64; kp = 64; t_lo = 0; t_hi = (4 * qb + 2) >> 6; if (t_hi > 7) t_hi = 7; }
    const bf16_t* kld = Kg + (size_t)lane * kp + wid * 8;
    const unsigned kst = (unsigned)(wid * 1024 + lane * 16);
    const int vrow = (tid >> 2) & 63, vch = (tid & 3) | ((tid >> 8) << 2);
    const bf16_t* vld = Vg + (size_t)vrow * kp + vch * 8;
    const unsigned vst = (unsigned)(8192 + 1024 * (vrow >> 3) + 512 * (vch >> 2) + 64 * (vrow & 7) + 16 * (vch & 3));
    const float* cumk = nullptr; float cq = 0.f;
    if (MODE == M_FOX) { cumk = A.cum + (size_t)(b * 8 + hg) * SEQ; cq = cumk[tq]; }
    const unsigned kfb = (unsigned)(hi * 1024 + r32 * 16);
    const unsigned vfb = (unsigned)(8192 + 256 * hi + 64 * ((lane & 15) >> 2) + 32 * ((lane >> 4) & 1) + 8 * (lane & 3));
    unsigned sel0 = 0u, sel1 = 0u, sel2 = 0u, sel3 = 0u;
    if (MODE == M_SLC) { const u32x4 s4 = *(const u32x4*)(A.sel + ((size_t)(b * 2 + hg) * SEQ + tq) * 4); sel0 = s4.x; sel1 = s4.y; sel2 = s4.z; sel3 = s4.w; }

    float m_run = -1e30f, l_run = 0.f;
    f32x16 o0, o1;
#pragma unroll
    for (int r = 0; r < 16; ++r) { o0[r] = 0.f; o1[r] = 0.f; }

    LAS float* impw = (LAS float*)(lds + IMP_OFF) + wid * 8 * IMP_W;
    if (MODE == M_CMP) {
        for (int i = lane; i < 8 * IMP_W; i += 64) impw[i] = 0.f;
    }

    const int npass = (MODE == M_CMP) ? 2 : 1;
    float inv_l = 0.f;
    for (int pass = 0; pass < npass; ++pass) {
        const bool stat_only = (MODE == M_CMP) && (pass == 0);
        {
            const u32x4 kr = *(const u32x4*)(kld + (size_t)t_lo * 64 * kp), vr = *(const u32x4*)(vld + (size_t)t_lo * 64 * kp);
            *(LAS u32x4*)(lds + kst) = kr; *(LAS u32x4*)(lds + vst) = vr;
            if (MODE == M_FOX) { if (tid < 64) *(LAS float*)(lds + 16384 + tid * 4) = cumk[t_lo * 64 + tid]; }
        }
        __syncthreads();
        for (int t = t_lo; t <= t_hi; ++t) {
            const int cur = (t - t_lo) & 1;
            LAS unsigned char* buf = lds + cur * BUFSZ;
            LAS unsigned char* nbuf = lds + (cur ^ 1) * BUFSZ;
            u32x4 kr, vr; float br = 0.f;
            const bool pre = t < t_hi;
            if (pre) { kr = *(const u32x4*)(kld + (size_t)(t + 1) * 64 * kp); vr = *(const u32x4*)(vld + (size_t)(t + 1) * 64 * kp);
                       if (MODE == M_FOX) { if (tid < 64) br = cumk[(t + 1) * 64 + tid]; } }
            bool active = true;
            if (MODE == M_SLC) { const bool mine = (((t < 64) ? ((t < 32) ? sel0 : sel1) : ((t < 96) ? sel2 : sel3)) >> (t & 31)) & 1u; active = __any(mine); }
            if (active) {
                f32x16 p0, p1;
                if (MODE == M_FOX) {
                    LAS const float* bs = (LAS const float*)(buf + 16384);
#pragma unroll
                    for (int g4 = 0; g4 < 4; ++g4) { const f32x4 c0 = *(LAS const f32x4*)(bs + 8 * g4 + 4 * hi), c1 = *(LAS const f32x4*)(bs + 32 + 8 * g4 + 4 * hi);
#pragma unroll
                        for (int i = 0; i < 4; ++i) { p0[4 * g4 + i] = cq - c0[i]; p1[4 * g4 + i] = cq - c1[i]; } }
                } else {
#pragma unroll
                    for (int r = 0; r < 16; ++r) { p0[r] = 0.f; p1[r] = 0.f; }
                }
#pragma unroll
                for (int ds = 0; ds < 4; ++ds) {
                    const bf16x8 k0 = *(LAS const bf16x8*)(buf + kfb + ds * 2048), k1 = *(LAS const bf16x8*)(buf + kfb + ds * 2048 + 512);
                    p0 = MFMA32(k0, qf[ds], p0); p1 = MFMA32(k1, qf[ds], p1);
                }
                const int kv0 = t * 64 + 4 * hi;
                if (MODE == M_FOX) {
                    if (t >= 4 * qb) {
#pragma unroll
                        for (int r = 0; r < 16; ++r) { const int kv = kv0 + (r & 3) + 8 * (r >> 2); if (kv > tq) p0[r] = NEG_INF; if (kv + 32 > tq) p1[r] = NEG_INF; } }
                } else if (MODE == M_WIN) {
                    if (t == qb || t == qb - 8) {
#pragma unroll
                        for (int r = 0; r < 16; ++r) { const int kv = kv0 + (r & 3) + 8 * (r >> 2); if (kv > tq || kv <= tq - 512) p0[r] = NEG_INF; if (kv + 32 > tq || kv + 32 <= tq - 512) p1[r] = NEG_INF; } }
                } else if (MODE == M_SLC) {
                    const bool mine = (((t < 64) ? ((t < 32) ? sel0 : sel1) : ((t < 96) ? sel2 : sel3)) >> (t & 31)) & 1u;
                    if (t == qb || !mine) {
#pragma unroll
                        for (int r = 0; r < 16; ++r) { const int kv = kv0 + (r & 3) + 8 * (r >> 2); if (!mine || kv > tq) p0[r] = NEG_INF; if (!mine || kv + 32 > tq) p1[r] = NEG_INF; } }
                } else {
#pragma unroll
                    for (int r = 0; r < 16; ++r) { const int c = kv0 + (r & 3) + 8 * (r >> 2); if (16 * c + 31 > tq) p0[r] = NEG_INF; if (16 * (c + 32) + 31 > tq) p1[r] = NEG_INF; }
                }
                if (!(MODE == M_CMP && pass == 1)) {
                    float mx = fmaxf(p0[0], p1[0]);
#pragma unroll
                    for (int r = 1; r < 16; ++r) mx = fmaxf(mx, fmaxf(p0[r], p1[r]));
                    mx = fmaxf(mx, __shfl_xor(mx, 32));
                    const float mn = fmaxf(m_run, mx);
                    if (__any(mn > m_run)) {
                        const float al = __builtin_amdgcn_exp2f(m_run - mn); l_run *= al;
                        if (!stat_only) {
#pragma unroll
                            for (int r = 0; r < 16; ++r) { o0[r] *= al; o1[r] *= al; } }
                        m_run = mn;
                    }
                    float ls = 0.f;
#pragma unroll
                    for (int r = 0; r < 16; ++r) { p0[r] = __builtin_amdgcn_exp2f(p0[r] - m_run); p1[r] = __builtin_amdgcn_exp2f(p1[r] - m_run); ls += p0[r] + p1[r]; }
                    l_run += ls;
                } else {
#pragma unroll
                    for (int r = 0; r < 16; ++r) { p0[r] = __builtin_amdgcn_exp2f(p0[r] - m_run) * inv_l; p1[r] = __builtin_amdgcn_exp2f(p1[r] - m_run) * inv_l; }
                }
                if (!stat_only) {
                    bf16x8 pk[2][2];
#pragma unroll
                    for (int s = 0; s < 2; ++s) {
                        u32x4 w0, w1;
                        w0.x = cvtpk(p0[8 * s + 0], p0[8 * s + 1]); w0.y = cvtpk(p0[8 * s + 2], p0[8 * s + 3]); w0.z = cvtpk(p0[8 * s + 4], p0[8 * s + 5]); w0.w = cvtpk(p0[8 * s + 6], p0[8 * s + 7]);
                        w1.x = cvtpk(p1[8 * s + 0], p1[8 * s + 1]); w1.y = cvtpk(p1[8 * s + 2], p1[8 * s + 3]); w1.z = cvtpk(p1[8 * s + 4], p1[8 * s + 5]); w1.w = cvtpk(p1[8 * s + 6], p1[8 * s + 7]);
                        pk[0][s] = __builtin_bit_cast(bf16x8, w0); pk[1][s] = __builtin_bit_cast(bf16x8, w1);
                    }
#pragma unroll
                    for (int kb = 0; kb < 2; ++kb)
#pragma unroll
                        for (int s = 0; s < 2; ++s) {
                            LAS const unsigned char* vb = buf + vfb + 4096 * kb + 2048 * s;
                            const s16x4 a0 = vtr(vb), a1 = vtr(vb + 1024), c0 = vtr(vb + 512), c1 = vtr(vb + 1536);
                            const bf16x8 vf0 = {a0[0], a0[1], a0[2], a0[3], a1[0], a1[1], a1[2], a1[3]};
                            const bf16x8 vf1 = {c0[0], c0[1], c0[2], c0[3], c1[0], c1[1], c1[2], c1[3]};
                            o0 = MFMA32(vf0, pk[kb][s], o0); o1 = MFMA32(vf1, pk[kb][s], o1);
                        }
                    if (MODE == M_CMP) {
                        f32x16 di;
                        int r32o = r32, hio = hi; asm volatile("" : "+v"(r32o), "+v"(hio));
                        bf16x8 ovf[2][2];
#pragma unroll
                        for (int kb = 0; kb < 2; ++kb)
#pragma unroll
                            for (int s = 0; s < 2; ++s)
#pragma unroll
                                for (int j = 0; j < 8; ++j) { const int cl = 32 * kb + 16 * s + 8 * (j >> 2) + 4 * hio + (j & 3); ovf[kb][s][j] = (cl >= 4 * r32o - 1 && cl <= 4 * r32o + 3) ? (short)0x3F80 : (short)0; }
#pragma unroll
                        for (int r = 0; r < 16; ++r) di[r] = 0.f;
#pragma unroll
                        for (int kb = 0; kb < 2; ++kb)
#pragma unroll
                            for (int s = 0; s < 2; ++s) di = MFMA32(pk[kb][s], ovf[kb][s], di);
                        if (r32 <= 16) {
#pragma unroll
                            for (int j = 0; j < 4; ++j) { const float v = (di[j] + di[j + 4]) + (di[j + 8] + di[j + 12]); LAS float* ip = impw + (4 * hi + j) * IMP_W + 16 * t + r32; *ip = *ip + v; }
                        }
                    }
                }
            }
            if (pre) { *(LAS u32x4*)(nbuf + kst) = kr; *(LAS u32x4*)(nbuf + vst) = vr; if (MODE == M_FOX) { if (tid < 64) *(LAS float*)(nbuf + 16384 + tid * 4) = br; } }
            __syncthreads();
        }
        if (pass == 0) { const float lt = l_run + __shfl_xor(l_run, 32); inv_l = lt > 0.f ? 1.f / lt : 0.f; }
    }
    const float sc = (MODE == M_CMP) ? 1.f : inv_l;
    if (MODE == M_FOX) {
        bf16_t* op = A.YS + tokrow * 1536 + 1024 + hg * 64 + 4 * hi;
#pragma unroll
        for (int g4 = 0; g4 < 4; ++g4) {
            u32x2 w; w.x = cvtpk(o0[4 * g4] * sc, o0[4 * g4 + 1] * sc); w.y = cvtpk(o0[4 * g4 + 2] * sc, o0[4 * g4 + 3] * sc); *(u32x2*)(op + 8 * g4) = w;
            w.x = cvtpk(o1[4 * g4] * sc, o1[4 * g4 + 1] * sc); w.y = cvtpk(o1[4 * g4 + 2] * sc, o1[4 * g4 + 3] * sc); *(u32x2*)(op + 32 + 8 * g4) = w;
        }
    } else {
        const int br = (MODE == M_CMP) ? 0 : (MODE == M_SLC) ? 1 : 2;
        const float gsc = sc * A.S32[tokrow * 32 + (hg * 4 + hh) * 3 + br];
        float* np = A.onsa + tokrow * 512 + (hg * 4 + hh) * 64 + 4 * hi;
        bf16_t* op = A.YS + tokrow * 1536 + 512 + (hg * 4 + hh) * 64 + 4 * hi;
#pragma unroll
        for (int g4 = 0; g4 < 4; ++g4) {
            f32x4 v0 = {o0[4 * g4] * gsc, o0[4 * g4 + 1] * gsc, o0[4 * g4 + 2] * gsc, o0[4 * g4 + 3] * gsc};
            f32x4 v1 = {o1[4 * g4] * gsc, o1[4 * g4 + 1] * gsc, o1[4 * g4 + 2] * gsc, o1[4 * g4 + 3] * gsc};
            if (MODE != M_CMP) { v0 = v0 + *(const f32x4*)(np + 8 * g4); v1 = v1 + *(const f32x4*)(np + 32 + 8 * g4); }
            if (MODE != M_WIN) { *(f32x4*)(np + 8 * g4) = v0; *(f32x4*)(np + 32 + 8 * g4) = v1; }
            else { u32x2 w; w.x = cvtpk(v0[0], v0[1]); w.y = cvtpk(v0[2], v0[3]); *(u32x2*)(op + 8 * g4) = w; w.x = cvtpk(v1[0], v1[1]); w.y = cvtpk(v1[2], v1[3]); *(u32x2*)(op + 32 + 8 * g4) = w; }
        }
    }
    if (MODE == M_CMP) {
        const int ql = lane >> 3, sub = lane & 7, cur = qb;
        LAS const float* row = impw + ql * IMP_W;
        unsigned bits = 0u;
#pragma unroll 1
        for (int half = 0; half < 2; ++half) {
            float sc_own[8]; int rank[8];
            const int sbase = sub * 16 + half * 8;
#pragma unroll
            for (int i = 0; i < 8; ++i) { const int s = sbase + i; float v = row[s]; if (s == 0 || s == cur || s == cur - 1) v = 1e6f; sc_own[i] = v; rank[i] = 0; }
#pragma unroll 2
            for (int sp = 0; sp <= cur; ++sp) {
                float v = row[sp]; if (sp == 0 || sp == cur || sp == cur - 1) v = 1e6f;
#pragma unroll
                for (int i = 0; i < 8; ++i) { const int s = sbase + i; rank[i] += (sp < s) ? (v >= sc_own[i] ? 1 : 0) : (v > sc_own[i] ? 1 : 0); }
            }
#pragma unroll
            for (int i = 0; i < 8; ++i) { const int s = sbase + i; if (s <= cur && rank[i] < 16) bits |= (1u << (half * 8 + i)); }
        }
        unsigned w = bits << (16 * (sub & 1));
        w |= __shfl_xor(w, 1);
        if ((sub & 1) == 0) A.sel[((size_t)(b * 2 + hg) * SEQ + qb * 64 + wid * 8 + ql) * 4 + (sub >> 1)] = w;
    }
    __syncthreads();
}
#undef MFMA32
}
struct Frame {
    LAS unsigned char* lds;
    int tid, lane, wave, G, bid;
    unsigned char* ws;
};
#define WSP(T, off) ((T*)(F.ws + (off)))

__device__ __forceinline__ int maprow(int mode, int n) {
    if (mode == 0) return n;
    if (mode == 1) {
        if (n < 512) return -1;
        if (n < 1792) return n;
        if (n < 1816) return 6400 + (n - 1792);
        if (n < 3352) return n - 24;
        if (n < 3360) return 6424 + (n - 3352);
        return n - 32;
    }
    return n < 1024 ? ((n >> 7) * 256 + (n & 127)) : (((n - 1024) >> 7) * 256 + 128 + (n & 127));
}
__device__ __forceinline__ void transpose_item(const float* W, int N, bf16_t* WT, int ld, LAS float* scr, int kb, int nb, int lane, int mode) {
    const int k0 = 64 * kb, n0 = 32 * nb;
#pragma unroll 8
    for (int i = 0; i < 32; ++i) { const int kk = 2 * i + (lane >> 5); scr[kk * 33 + (lane & 31)] = W[(size_t)(k0 + kk) * N + n0 + (lane & 31)]; }
    asm volatile("s_waitcnt lgkmcnt(0)" ::: "memory");
    const int c = lane & 7;
#pragma unroll
    for (int j = 0; j < 4; ++j) { const int n = (lane >> 3) + 8 * j; const LAS float* s = scr + (8 * c) * 33 + n;
        u32x4 o; o.x = cvtpk(s[0 * 33], s[1 * 33]); o.y = cvtpk(s[2 * 33], s[3 * 33]); o.z = cvtpk(s[4 * 33], s[5 * 33]); o.w = cvtpk(s[6 * 33], s[7 * 33]);
        const int dr = maprow(mode, n0 + n);
        if (dr >= 0) *(u32x4*)(WT + (size_t)dr * ld + k0 + 8 * c) = o; }
    asm volatile("s_waitcnt lgkmcnt(0)" ::: "memory");
}
__device__ __forceinline__ void p0_phase(Frame& F, const Args& a) {
    for (int task = F.bid; task < 16; task += F.G) {
        const int l = task >> 3, kv = (task >> 2) & 1, nblk = task & 3, n = nblk * 64 + F.lane;
        const float* pos = a.in[6] + (size_t)(l * 2 + kv) * 2048; const float* w1 = a.in[7] + (size_t)(l * 2 + kv) * 2048 * 256;
        float s = 0.f;
        for (int i = 0; i < 256; ++i) { const int jd = F.wave * 256 + i; s += pos[jd] * w1[(size_t)jd * 256 + n]; }
        LAS float* red = (LAS float*)F.lds;
        red[F.wave * 64 + F.lane] = s;
        __syncthreads();
        if (F.wave == 0) { float t = a.in[8][(l * 2 + kv) * 256 + n];
            for (int w = 0; w < 8; ++w) t += red[w * 64 + F.lane];
            WSP(float, WS_BIAS)[l * 8192 + 6656 + kv * 256 + n] = t; }
        __syncthreads();
    }
    LAS float* scr = (LAS float*)(F.lds + F.wave * 8704);
    const int gw = F.bid * NWAVES + F.wave, NGW = F.G * NWAVES;
    constexpr int I_IN = 16 * 201, I_UP = 768, I_O = 512, I_C1 = 512, I_M1 = 32768, I_M2 = 16384, I_L = I_IN + I_UP + I_O + I_C1 + I_M1 + I_M2;
    for (int it = gw; it < 2 * I_L; it += NGW) {
        const int l = it / I_L; int r = it - l * I_L;
        if (r < I_IN) { const int kb = r / 201, nb = r % 201; if (nb >= 16) transpose_item(a.in[1] + (size_t)l * DM * INW, INW, WSP(bf16_t, WS_WIN + l * WIN_L), DM, scr, kb, nb, F.lane, 1); continue; } r -= I_IN;
        if (r < I_UP) { const int nbr = r >> 8, rr = r & 255; transpose_item(a.in[11] + ((size_t)l * 3 + nbr) * 512 * 1024, 1024, WSP(bf16_t, WS_WUP + l * WUP_L) + (size_t)nbr * 1024 * 512, 512, scr, rr >> 5, rr & 31, F.lane, 0); continue; } r -= I_UP;
        if (r < I_O) { transpose_item(a.in[12] + (size_t)l * DM * DM, DM, WSP(bf16_t, WS_WO + l * WO_L), DM, scr, r >> 5, r & 31, F.lane, 0); continue; } r -= I_O;
        if (r < I_C1) { const int kv = r >> 8, rr = r & 255; transpose_item(a.in[7] + (size_t)(l * 2 + kv) * 2048 * 256, 256, WSP(bf16_t, WS_WC1 + l * WC1_L) + (size_t)kv * 256 * 2048, 2048, scr, rr >> 3, rr & 7, F.lane, 0); continue; } r -= I_C1;
        if (r < I_M1) { const int e = r >> 10, rr = r & 1023; transpose_item(a.in[17] + ((size_t)l * NEXP + e) * DM * 2048, 2048, WSP(bf16_t, WS_WM1 + l * WM1_L) + (size_t)e * 2048 * DM, DM, scr, rr >> 6, rr & 63, F.lane, 2); continue; } r -= I_M1;
        { const int e = r >> 9, rr = r & 511; transpose_item(a.in[19] + ((size_t)l * NEXP + e) * DM * DM, DM, WSP(bf16_t, WS_WM2 + l * WM2_L) + (size_t)e * DM * DM, DM, scr, rr >> 5, rr & 31, F.lane, 0); }
    }
    const int gt = F.bid * NTHREADS + F.tid, NGT = F.G * NTHREADS;
    for (int idx = gt; idx < 2 * 512 * 1024; idx += NGT) {
        const int l = idx >> 19, n = (idx >> 10) & 511, k = idx & 1023, g = n >> 7;
        const float* wr = a.in[1] + ((size_t)l * DM + k) * INW + g * 128; const float* pw = a.in[3] + ((size_t)(l * 4 + g) * 128) * 128 + (n & 127);
        float s = 0.f;
#pragma unroll 8
        for (int c = 0; c < 128; ++c) s += wr[c] * pw[(size_t)c * 128];
        WSP(bf16_t, WS_WIN + l * WIN_L)[(size_t)n * DM + k] = (bf16_t)(cvtpk(s, 0.f) & 0xffffu);
    }
    for (int idx = gt; idx < 2 * NINP; idx += NGT) {
        const int l = idx / NINP, n = idx - l * NINP; const float* bi = a.in[2] + (size_t)l * INW; float v = 0.f;
        if (n < 512) { const int g = n >> 7; const float* pw = a.in[3] + ((size_t)(l * 4 + g) * 128) * 128 + (n & 127); for (int c = 0; c < 128; ++c) v += bi[g * 128 + c] * pw[(size_t)c * 128]; }
        else if (n < 1792) v = bi[n];
        else if (n < 3328) v = bi[n + 24];
        else if (n < 6400) v = bi[n + 32];
        else if (n < 6424) v = bi[1792 + (n - 6400)];
        else if (n < 6432) v = bi[3352 + (n - 6424)];
        WSP(float, WS_BIAS)[l * 8192 + n] = v;
    }
    for (int idx = gt; idx < 2 * 224 * 128; idx += NGT) { const int l = idx / (224 * 128), r = idx - l * 224 * 128; *(u32x4*)(WSP(bf16_t, WS_WIN + l * WIN_L) + (size_t)6432 * DM + (size_t)r * 8) = (u32x4){0u, 0u, 0u, 0u}; }
    for (int idx = gt; idx < NTOK * DM / 4; idx += NGT) { const f32x4 v = ((const f32x4*)a.in[0])[idx]; ((f32x4*)a.out)[idx] = v; u32x2 w; w.x = cvtpk(v[0], v[1]); w.y = cvtpk(v[2], v[3]); ((u32x2*)WSP(bf16_t, WS_XB))[idx] = w; }
}

__device__ __forceinline__ void prep_thin(Frame& F, const Args& a, int l) {
    if (F.bid < 16 || F.G <= 16) return;
    const int j = F.bid - 16, GJ = F.G - 16;
    if (F.wave == 0) {
        for (int seq = j; seq < 16; seq += GJ) {
            const int b = seq >> 3, h = seq & 7;
            const float* src = WSP(float, WS_S32) + ((size_t)b * SEQ + F.lane * 128) * 32 + 24 + h;
            float s = 0.f;
#pragma unroll 8
            for (int i = 0; i < 128; ++i) s += src[(size_t)i * 32];
            float incl = s;
#pragma unroll
            for (int o = 1; o < 64; o <<= 1) { const float t = __shfl_up(incl, o); if (F.lane >= o) incl += t; }
            float run = incl - s;
            float* dst = WSP(float, WS_CUM) + (size_t)seq * SEQ + F.lane * 128;
#pragma unroll 8
            for (int i = 0; i < 128; ++i) { run += src[(size_t)i * 32]; dst[i] = run * LOG2E; }
        }
    }
    const bf16_t* Z = WSP(bf16_t, WS_Z); bf16_t* YS = WSP(bf16_t, WS_YS);
    const float* pb = a.in[4] + (size_t)l * 512; const float* ps = a.in[5] + (size_t)l * 512;
    for (int idx = j * NTHREADS + F.tid; idx < NTOK * 64; idx += GJ * NTHREADS) {
        const int n = idx >> 6, c8 = (idx & 63) * 8, t = n & (SEQ - 1), win = 2 << (c8 >> 7), cnt = (t + 1 < win) ? t + 1 : win;
        float sum[8];
#pragma unroll
        for (int i = 0; i < 8; ++i) sum[i] = 0.f;
        float self[8];
        for (int q = 0; q < cnt; ++q) { const u32x4 w = *(const u32x4*)(Z + (size_t)(n - q) * ZP + c8);
            const float v[8] = {bflo(w.x), bfhi(w.x), bflo(w.y), bfhi(w.y), bflo(w.z), bfhi(w.z), bflo(w.w), bfhi(w.w)};
#pragma unroll
            for (int i = 0; i < 8; ++i) { sum[i] += v[i]; if (q == 0) self[i] = v[i]; } }
        const float ic = 1.f / (float)cnt; float y[8];
#pragma unroll
        for (int i = 0; i < 8; ++i) y[i] = (sum[i] * ic - self[i] + pb[c8 + i]) * ps[c8 + i];
        u32x4 o; o.x = cvtpk(y[0], y[1]); o.y = cvtpk(y[2], y[3]); o.z = cvtpk(y[4], y[5]); o.w = cvtpk(y[6], y[7]);
        *(u32x4*)(YS + (size_t)n * 1536 + c8) = o;
    }
}

__device__ __forceinline__ void c2_phase(Frame& F, const Args& a, int l) {
    const int gw = F.bid * NWAVES + F.wave, NGW = F.G * NWAVES;
    for (int task = gw; task < 4096; task += NGW) {
        const int kv = task >> 11, row = task & 2047;
        const bf16_t* h = WSP(bf16_t, WS_H1) + ((size_t)kv * 2048 + row) * 256;
        const float* w2 = a.in[9] + (size_t)(l * 2 + kv) * 256 * 64 + F.lane;
        float s = a.in[10][(l * 2 + kv) * 64 + F.lane];
#pragma unroll 8
        for (int n = 0; n < 256; ++n) s += bf2f(h[n]) * w2[(size_t)n * 64];
        if ((row & 511) == 511) s = 0.f;
        WSP(bf16_t, WS_KC)[((size_t)kv * 2048 + row) * 64 + F.lane] = (bf16_t)(cvtpk(s, 0.f) & 0xffffu);
    }
}

constexpr int RW_PITCH = 1028;
__device__ __forceinline__ void ln_router_phase(Frame& F, const Args& a, int l) {
    LAS float* rwT = (LAS float*)F.lds;
    LAS int* hist = (LAS int*)(F.lds + 32 * RW_PITCH * 4);
    const float* rw = a.in[15] + (size_t)l * DM * NEXP;
    for (int idx = F.tid; idx < DM * NEXP; idx += NTHREADS) { const int k = idx >> 5, e = idx & 31; rwT[e * RW_PITCH + k] = rw[idx]; }
    const float* g1 = a.in[13] + (size_t)l * DM; const float* b1 = a.in[14] + (size_t)l * DM; const float* rb = a.in[16] + (size_t)l * NEXP;
    const float* V1 = WSP(float, WS_V1); float* X = a.out; bf16_t* XB = WSP(bf16_t, WS_XB);
    int* TOPI = (int*)(F.ws + WS_MOE + MOE_TOPI); float* TOPG = (float*)(F.ws + WS_MOE + MOE_TOPG); int* HIST = (int*)(F.ws + WS_MOE + MOE_HIST);
    __syncthreads();
    for (int chunk = F.bid; chunk < 256; chunk += F.G) {
        if (F.tid < 32) hist[F.tid] = 0;
        __syncthreads();
        for (int r = 0; r < 8; ++r) {
            const size_t row = (size_t)chunk * 64 + F.wave * 8 + r;
            f32x4 v[4]; float s = 0.f;
#pragma unroll
            for (int j = 0; j < 4; ++j) { v[j] = ((const f32x4*)(V1 + row * DM))[F.lane + 64 * j]; s += (v[j][0] + v[j][1]) + (v[j][2] + v[j][3]); }
            const float mean = wave_sum(s) * (1.f / DM); float s2 = 0.f;
#pragma unroll
            for (int j = 0; j < 4; ++j) { v[j] = v[j] - mean; s2 += (v[j][0] * v[j][0] + v[j][1] * v[j][1]) + (v[j][2] * v[j][2] + v[j][3] * v[j][3]); }
            const float rstd = 1.f / sqrtf(wave_sum(s2) * (1.f / DM) + LN_EPS);
#pragma unroll
            for (int j = 0; j < 4; ++j) { const f32x4 gg = ((const f32x4*)g1)[F.lane + 64 * j], bb = ((const f32x4*)b1)[F.lane + 64 * j]; v[j] = v[j] * rstd * gg + bb;
                ((f32x4*)(X + row * DM))[F.lane + 64 * j] = v[j];
                u32x2 w; w.x = cvtpk(v[j][0], v[j][1]); w.y = cvtpk(v[j][2], v[j][3]); ((u32x2*)(XB + row * DM))[F.lane + 64 * j] = w; }
            float acc[32];
#pragma unroll
            for (int e = 0; e < 32; ++e) { float t = 0.f;
#pragma unroll
                for (int j = 0; j < 4; ++j) { const f32x4 w = *(LAS const f32x4*)(rwT + e * RW_PITCH + 4 * (F.lane + 64 * j)); t += (v[j][0] * w[0] + v[j][1] * w[1]) + (v[j][2] * w[2] + v[j][3] * w[3]); }
                acc[e] = t; }
#define RS_STEP(CNT, BIT) _Pragma("unroll") for (int i = 0; i < CNT; ++i) { const bool up = (F.lane & BIT) != 0; const float send = up ? acc[i] : acc[i + CNT]; const float keep = up ? acc[i + CNT] : acc[i]; acc[i] = keep + __shfl_xor(send, BIT); }
            RS_STEP(16, 32) RS_STEP(8, 16) RS_STEP(4, 8) RS_STEP(2, 4) RS_STEP(1, 2)
#undef RS_STEP
            const int e = F.lane >> 1;
            float lg = acc[0] + __shfl_xor(acc[0], 1) + rb[e];
            float tv[4]; int ti[4];
#pragma unroll
            for (int k = 0; k < 4; ++k) {
                float mx = lg;
#pragma unroll
                for (int o = 1; o < 64; o <<= 1) mx = fmaxf(mx, __shfl_xor(mx, o));
                int cand = (lg == mx) ? e : 99;
#pragma unroll
                for (int o = 1; o < 64; o <<= 1) { const int t = __shfl_xor(cand, o); cand = t < cand ? t : cand; }
                tv[k] = mx; ti[k] = cand; if (e == cand) lg = -__builtin_inff();
            }
            if (F.lane == 0) {
                const float e1 = __expf(tv[1] - tv[0]), e2 = __expf(tv[2] - tv[0]), e3 = __expf(tv[3] - tv[0]); const float inv = 1.f / (1.f + e1 + e2 + e3);
                *(int4*)(TOPI + row * 4) = make_int4(ti[0], ti[1], ti[2], ti[3]);
                *(f32x4*)(TOPG + row * 4) = (f32x4){inv, e1 * inv, e2 * inv, e3 * inv};
                atomicAdd((int*)&hist[ti[0]], 1); atomicAdd((int*)&hist[ti[1]], 1); atomicAdd((int*)&hist[ti[2]], 1); atomicAdd((int*)&hist[ti[3]], 1);
            }
        }
        __syncthreads();
        if (F.tid < 32) HIST[chunk * 32 + F.tid] = hist[F.tid];
        __syncthreads();
    }
}

__device__ __forceinline__ void scatter_phase(Frame& F, const Args& a) {
    LAS int* hl = (LAS int*)F.lds;
    LAS int* segsum = hl + 8192;
    LAS int* pstart = segsum + 512;
    LAS int* total = pstart + 32;
    LAS int* padded = total + 32;
    LAS int* ea = padded + 32;
    LAS int* slotl = ea + 256;
    const int* HIST = (const int*)(F.ws + WS_MOE + MOE_HIST); const int* TOPI = (const int*)(F.ws + WS_MOE + MOE_TOPI); const float* TOPG = (const float*)(F.ws + WS_MOE + MOE_TOPG);
    int* TOKSLOT = (int*)(F.ws + WS_MOE + MOE_TOKSLOT); int* BLK = (int*)(F.ws + WS_MOE + MOE_BLK); int* SLOTTOK = (int*)(F.ws + WS_MOE + MOE_SLOTTOK); float* SLOTG = (float*)(F.ws + WS_MOE + MOE_SLOTG);
    for (int idx = F.tid; idx < 8192; idx += NTHREADS) hl[idx] = HIST[idx];
    __syncthreads();
    { const int e = F.tid & 31, seg = F.tid >> 5; int s = 0; for (int i = 0; i < 16; ++i) s += hl[(seg * 16 + i) * 32 + e]; segsum[seg * 32 + e] = s; }
    __syncthreads();
    if (F.tid < 32) { int run = 0; for (int seg = 0; seg < 16; ++seg) { const int t = segsum[seg * 32 + F.tid]; segsum[seg * 32 + F.tid] = run; run += t; } total[F.tid] = run; padded[F.tid] = (run + 255) & ~255; }
    __syncthreads();
    { const int e = F.tid & 31, seg = F.tid >> 5; int run = segsum[seg * 32 + e]; for (int i = 0; i < 16; ++i) { const int t = hl[(seg * 16 + i) * 32 + e]; hl[(seg * 16 + i) * 32 + e] = run; run += t; } }
    if (F.tid == 0) { int run = 0; for (int e = 0; e < 32; ++e) { pstart[e] = run; run += padded[e]; } }
    __syncthreads();
    if (F.bid == 0) {
        for (int b = F.tid; b < NBLK; b += NTHREADS) { int ex = -1; for (int e = 0; e < 32; ++e) if (b * 256 >= pstart[e] && b * 256 < pstart[e] + padded[e]) ex = e; BLK[b] = ex; }
        if (F.tid == 0) BLK[NBLK] = (pstart[31] + padded[31]) >> 8;
    }
    for (int e = F.bid; e < 32; e += F.G)
        for (int s = pstart[e] + total[e] + F.tid; s < pstart[e] + padded[e]; s += NTHREADS) { SLOTG[s] = 0.f; SLOTTOK[s] = -1; }
    const bf16_t* XB = WSP(bf16_t, WS_XB); bf16_t* XS = WSP(bf16_t, WS_XS);
    for (int chunk = F.bid; chunk < 256; chunk += F.G) {
        int e = 0, tok = 0;
        if (F.tid < 256) { tok = chunk * 64 + (F.tid >> 2); e = TOPI[tok * 4 + (F.tid & 3)]; ea[F.tid] = e; }
        __syncthreads();
        if (F.tid < 256) { int cnt = 0; for (int q = 0; q < F.tid; ++q) cnt += (ea[q] == e) ? 1 : 0;
            const int slot = pstart[e] + hl[chunk * 32 + e] + cnt; slotl[F.tid] = slot;
            TOKSLOT[tok * 4 + (F.tid & 3)] = slot; SLOTTOK[slot] = tok; SLOTG[slot] = TOPG[tok * 4 + (F.tid & 3)]; }
        __syncthreads();
        for (int q = 0; q < 32; ++q) { const int as = F.wave * 32 + q, tk = chunk * 64 + (as >> 2), slot = slotl[as];
            const u32x4* src = (const u32x4*)(XB + (size_t)tk * DM); u32x4* dst = (u32x4*)(XS + (size_t)slot * DM);
            dst[F.lane] = src[F.lane]; dst[F.lane + 64] = src[F.lane + 64]; }
        __syncthreads();
    }
}

__device__ __forceinline__ void combine_phase(Frame& F, const Args& a, int l) {
    const int gw = F.bid * NWAVES + F.wave, NGW = F.G * NWAVES;
    const float* g2 = a.in[21] + (size_t)l * DM; const float* b2 = a.in[22] + (size_t)l * DM;
    const int* TOKSLOT = (const int*)(F.ws + WS_MOE + MOE_TOKSLOT); const bf16_t* YB = WSP(bf16_t, WS_YB);
    float* X = a.out; bf16_t* XB = WSP(bf16_t, WS_XB);
    for (int row = gw; row < NTOK; row += NGW) {
        const int4 sl = *(const int4*)(TOKSLOT + (size_t)row * 4);
        f32x4 v[4]; float s = 0.f;
#pragma unroll
        for (int j = 0; j < 4; ++j) {
            const f32x4 x = ((const f32x4*)(X + (size_t)row * DM))[F.lane + 64 * j];
            const u32x2 y0 = ((const u32x2*)(YB + (size_t)sl.x * DM))[F.lane + 64 * j], y1 = ((const u32x2*)(YB + (size_t)sl.y * DM))[F.lane + 64 * j],
                        y2 = ((const u32x2*)(YB + (size_t)sl.z * DM))[F.lane + 64 * j], y3 = ((const u32x2*)(YB + (size_t)sl.w * DM))[F.lane + 64 * j];
            f32x4 y;
            y[0] = ((bflo(y0.x) + bflo(y1.x)) + bflo(y2.x)) + bflo(y3.x); y[1] = ((bfhi(y0.x) + bfhi(y1.x)) + bfhi(y2.x)) + bfhi(y3.x);
            y[2] = ((bflo(y0.y) + bflo(y1.y)) + bflo(y2.y)) + bflo(y3.y); y[3] = ((bfhi(y0.y) + bfhi(y1.y)) + bfhi(y2.y)) + bfhi(y3.y);
            v[j] = x * ALPHA + y; s += (v[j][0] + v[j][1]) + (v[j][2] + v[j][3]);
        }
        const float mean = wave_sum(s) * (1.f / DM); float s2 = 0.f;
#pragma unroll
        for (int j = 0; j < 4; ++j) { v[j] = v[j] - mean; s2 += (v[j][0] * v[j][0] + v[j][1] * v[j][1]) + (v[j][2] * v[j][2] + v[j][3] * v[j][3]); }
        const float rstd = 1.f / sqrtf(wave_sum(s2) * (1.f / DM) + LN_EPS);
#pragma unroll
        for (int j = 0; j < 4; ++j) { const f32x4 gg = ((const f32x4*)g2)[F.lane + 64 * j], bb = ((const f32x4*)b2)[F.lane + 64 * j]; v[j] = v[j] * rstd * gg + bb;
            ((f32x4*)(X + (size_t)row * DM))[F.lane + 64 * j] = v[j];
            u32x2 w; w.x = cvtpk(v[j][0], v[j][1]); w.y = cvtpk(v[j][2], v[j][3]); ((u32x2*)(XB + (size_t)row * DM))[F.lane + 64 * j] = w; }
    }
}
constexpr int PH_PER_LAYER = 14, N_PHASES = 1 + NLAYER * PH_PER_LAYER;

template <int MODE> __device__ __forceinline__ void attn_phase_nsa(Frame& F, const att::P& AP) {
    for (int u = F.bid; u < 256; u += F.G) {
        const int bg = u >> 6, s = u & 63;
        att::attn_unit<MODE>(F.lds, AP, bg >> 1, bg & 1, s);
        att::attn_unit<MODE>(F.lds, AP, bg >> 1, bg & 1, 127 - s);
    }
}

template <int SP> __device__ __forceinline__ void run_phase(Frame& F, const Args& args, const int l) {
    const float* BIASL = WSP(float, WS_BIAS) + l * 8192;
    att::P AP{WSP(bf16_t, WS_Z), WSP(float, WS_S32), WSP(float, WS_CUM), WSP(bf16_t, WS_KC), WSP(bf16_t, WS_KC) + 2048 * 64, WSP(unsigned, WS_SEL), WSP(float, WS_ONSA), WSP(bf16_t, WS_YS)};
    if constexpr (SP == 99) { p0_phase(F, args); }
    else if constexpr (SP == 0) {
        pg8::Gemm g{WSP(bf16_t, WS_XB), WSP(bf16_t, WS_WIN + l * WIN_L), DM, DM, DM, 128};
        SchedInProj S; S.o.init(NTOK / 256, NINP / 256, F.G, F.bid);
        EpiInProj E{WSP(bf16_t, WS_Z), WSP(float, WS_S32), BIASL};
        pg8::gemm_phase(F.lds, g, S, E);
    } else if constexpr (SP == 1) {
        pg8::Gemm g{WSP(bf16_t, WS_Z), WSP(bf16_t, WS_WC1 + l * WC1_L), 16 * ZP, 2048, 2048, ZP * 2};
        SchedC1 S{F.bid};
        EpiC1 E{WSP(bf16_t, WS_H1), BIASL + 6656};
        pg8::gemm_phase(F.lds, g, S, E);
        prep_thin(F, args, l);
    } else if constexpr (SP == 2) { c2_phase(F, args, l); }
    else if constexpr (SP == 3) { attn_phase_nsa<att::M_CMP>(F, AP); }
    else if constexpr (SP == 4) { attn_phase_nsa<att::M_SLC>(F, AP); }
    else if constexpr (SP == 5) { attn_phase_nsa<att::M_WIN>(F, AP); }
    else if constexpr (SP == 6) {
        for (int u = F.bid; u < 256; u += F.G) { const int bh = u >> 4, s = u & 15;
            att::attn_unit<att::M_FOX>(F.lds, AP, bh >> 3, bh & 7, s);
            att::attn_unit<att::M_FOX>(F.lds, AP, bh >> 3, bh & 7, 31 - s); }
    } else if constexpr (SP == 7) {
        pg8::Gemm g{WSP(bf16_t, WS_YS), WSP(bf16_t, WS_WUP + l * WUP_L), 1536, 512, 512, 128};
        SchedUp S; S.o.init(NTOK / 256, DM / 256, F.G, F.bid);
        EpiUp E{WSP(bf16_t, WS_Z), WSP(float, WS_MSCR), WSP(bf16_t, WS_MRG)};
        pg8::gemm_phase(F.lds, g, S, E);
    } else if constexpr (SP == 8) {
        pg8::Gemm g{WSP(bf16_t, WS_MRG), WSP(bf16_t, WS_WO + l * WO_L), DM, DM, DM, 128};
        SchedWo S; S.o.init(NTOK / 256, DM / 256, F.G, F.bid);
        EpiWo E{args.out, WSP(float, WS_V1)};
        pg8::gemm_phase(F.lds, g, S, E);
    } else if constexpr (SP == 9) { ln_router_phase(F, args, l); }
    else if constexpr (SP == 10) { scatter_phase(F, args); }
    else if constexpr (SP == 11) {
        const int* BLK = (const int*)(F.ws + WS_MOE + MOE_BLK);
        pg8::Gemm g{WSP(bf16_t, WS_XS), WSP(bf16_t, WS_WM1 + l * WM1_L), DM, DM, DM, 128};
        SchedMoe S{BLK, BLK[NBLK], F.G, F.bid, 8, 2048};
        EpiMoe1 E{WSP(bf16_t, WS_ACT), args.in[18] + (size_t)l * NEXP * 2048};
        pg8::gemm_phase(F.lds, g, S, E);
    } else if constexpr (SP == 12) {
        const int* BLK = (const int*)(F.ws + WS_MOE + MOE_BLK);
        pg8::Gemm g{WSP(bf16_t, WS_ACT), WSP(bf16_t, WS_WM2 + l * WM2_L), DM, DM, DM, 128};
        SchedMoe S{BLK, BLK[NBLK], F.G, F.bid, 4, 1024};
        EpiMoe2 E{WSP(bf16_t, WS_YB), args.in[20] + (size_t)l * NEXP * DM, (const float*)(F.ws + WS_MOE + MOE_SLOTG)};
        pg8::gemm_phase(F.lds, g, S, E);
    } else if constexpr (SP == 13) { combine_phase(F, args, l); }
}

#define MK_FRAME() \
    extern __shared__ __attribute__((aligned(16))) unsigned char lds_raw[]; \
    Frame F; F.lds = (LAS unsigned char*)lds_raw; F.tid = threadIdx.x; F.lane = F.tid & 63; F.wave = __builtin_amdgcn_readfirstlane(F.tid >> 6); \
    F.G = gridDim.x; F.bid = blockIdx.x; F.ws = args.ws;

template <int SP> __global__ void __launch_bounds__(NTHREADS, 2) mk_phase(Args args) {
    MK_FRAME();
    run_phase<SP>(F, args, args.ph_lo);
}

#ifndef MK_ONE_LAUNCH
#define MK_ONE_LAUNCH 0
#endif
#define SET_ATTR1(SP) (void)hipFuncSetAttribute((const void*)mk_phase<SP>, hipFuncAttributeMaxDynamicSharedMemorySize, LDS_BYTES)
#define SET_ATTRS() do { SET_ATTR1(99); SET_ATTR1(0); SET_ATTR1(1); SET_ATTR1(2); SET_ATTR1(3); SET_ATTR1(4); SET_ATTR1(5); SET_ATTR1(6); SET_ATTR1(7); SET_ATTR1(8); SET_ATTR1(9); SET_ATTR1(10); SET_ATTR1(11); SET_ATTR1(12); SET_ATTR1(13); } while (0)
extern "C" void kernel_launch(void* const* d_in, const int* in_sizes, int n_in, void* d_out, int out_size, void* d_ws, size_t ws_size, hipStream_t stream) {
    static int grid = 0;
    if (grid == 0) {
        if (n_in != 23 || out_size != NTOK * DM || ws_size < WS_END) { fprintf(stderr, "kernel_launch: unexpected problem (n_in %d out %d ws %zu)\n", n_in, out_size, ws_size); grid = -1; return; }
        int dev = 0, cus = 0, per_cu = 0;
        (void)hipGetDevice(&dev); (void)hipDeviceGetAttribute(&cus, hipDeviceAttributeMultiprocessorCount, dev);
        SET_ATTRS();
        (void)hipOccupancyMaxActiveBlocksPerMultiprocessor(&per_cu, (const void*)mk_phase<0>, NTHREADS, LDS_BYTES);
        (void)hipGetLastError();
        if (per_cu < 1) { fprintf(stderr, "kernel_launch: occupancy query reports %d blocks per CU\n", per_cu); per_cu = 1; }
        grid = cus;
    }
    if (grid < 0) return;
    Args a{};
    for (int i = 0; i < 23; ++i) a.in[i] = (const float*)d_in[i];
    a.out = (float*)d_out; a.ws = (unsigned char*)d_ws;
#define LAUNCH_PH(SP, L) do { a.ph_lo = (L); a.ph_hi = 0; hipLaunchKernelGGL(mk_phase<SP>, dim3(grid), dim3(NTHREADS), LDS_BYTES, stream, a); } while (0)
    LAUNCH_PH(99, 0);
    for (int l = 0; l < NLAYER; ++l) {
        LAUNCH_PH(0, l); LAUNCH_PH(1, l); LAUNCH_PH(2, l); LAUNCH_PH(3, l); LAUNCH_PH(4, l); LAUNCH_PH(5, l); LAUNCH_PH(6, l);
        LAUNCH_PH(7, l); LAUNCH_PH(8, l); LAUNCH_PH(9, l); LAUNCH_PH(10, l); LAUNCH_PH(11, l); LAUNCH_PH(12, l); LAUNCH_PH(13, l);
    }
}
```

```cpp
#include <hip/hip_runtime.h>
#include <hip/hip_cooperative_groups.h>
#include <cstdio>
#include <cstdint>
namespace cg = cooperative_groups;

constexpr int NTOK = 16384, SEQ = 8192, DM = 1024, NLAYER = 2;
constexpr int INW = 6432;
constexpr int ZP = 6400;
constexpr int NINP = 6656;
constexpr int NEXP = 32, PSLOTS = 73728, NBLK = 288;
constexpr float LN_EPS = 1e-5f;
constexpr float QSCALE = 0.125f * 1.4426950408889634f;
constexpr float LOG2E = 1.4426950408889634f;
constexpr float ALPHA = 1.4142135623730951f;
constexpr int ZC_POOL = 0, ZC_QN = 512, ZC_KVN = 1024, ZC_FOX = 1792, ZC_GM = 3328;

constexpr size_t MiB = 1u << 20;
constexpr size_t WS_CTL = 0;
constexpr size_t WS_BIAS = 1 * MiB;
constexpr size_t WS_WIN = 2 * MiB, WIN_L = 13 * MiB;
constexpr size_t WS_WUP = 28 * MiB, WUP_L = 3 * MiB;
constexpr size_t WS_WO = 34 * MiB, WO_L = 2 * MiB;
constexpr size_t WS_WC1 = 38 * MiB, WC1_L = 2 * MiB;
constexpr size_t WS_WM1 = 48 * MiB, WM1_L = 128 * MiB;
constexpr size_t WS_WM2 = 304 * MiB, WM2_L = 64 * MiB;
constexpr size_t WS_Z = 432 * MiB;
constexpr size_t WS_S32 = 640 * MiB;
constexpr size_t WS_CUM = 642 * MiB;
constexpr size_t WS_H1 = 643 * MiB;
constexpr size_t WS_KC = 645 * MiB;
constexpr size_t WS_SEL = 646 * MiB;
constexpr size_t WS_YS = 648 * MiB;
constexpr size_t WS_ONSA = 696 * MiB;
constexpr size_t WS_MSCR = 728 * MiB;
constexpr size_t WS_MRG = 792 * MiB;
constexpr size_t WS_V1 = 824 * MiB;
constexpr size_t WS_XB = 888 * MiB;
constexpr size_t WS_MOE = 920 * MiB;
constexpr size_t MOE_TOPI = 0, MOE_TOPG = 256 * 1024, MOE_TOKSLOT = 512 * 1024, MOE_HIST = 768 * 1024, MOE_BLK = 832 * 1024,
                 MOE_SLOTTOK = 1024 * 1024, MOE_SLOTG = 1536 * 1024;
constexpr size_t WS_XS = 924 * MiB;
constexpr size_t WS_ACT = 1068 * MiB;
constexpr size_t WS_YB = 1212 * MiB;
constexpr size_t WS_KV = 1356 * MiB;
constexpr size_t WS_END = 1420 * MiB;
constexpr int NSTREAM = 28;

constexpr int NWAVES = 8, NTHREADS = 512;
constexpr int LDS_BYTES = 147456;

#define LAS __attribute__((address_space(3)))
typedef unsigned short bf16_t;
typedef short bf16x8 __attribute__((ext_vector_type(8)));
typedef float f32x4 __attribute__((ext_vector_type(4)));
typedef float f32x16 __attribute__((ext_vector_type(16)));
typedef unsigned u32x4 __attribute__((ext_vector_type(4)));
typedef unsigned u32x2 __attribute__((ext_vector_type(2)));
typedef float f32x2_t __attribute__((ext_vector_type(2)));
typedef __bf16 bf16x2_t __attribute__((ext_vector_type(2)));

__device__ __forceinline__ unsigned cvtpk(float lo, float hi) { f32x2_t v = {lo, hi}; bf16x2_t b = __builtin_convertvector(v, bf16x2_t); return __builtin_bit_cast(unsigned, b); }
__device__ __forceinline__ float bf2f(bf16_t v) { return __uint_as_float((unsigned)v << 16); }
__device__ __forceinline__ float bflo(unsigned w) { return __uint_as_float(w << 16); }
__device__ __forceinline__ float bfhi(unsigned w) { return __uint_as_float(w & 0xffff0000u); }
__device__ __forceinline__ float wave_sum(float v) {
#pragma unroll
    for (int o = 1; o < 64; o <<= 1) v += __shfl_xor(v, o);
    return v;
}
__device__ __forceinline__ float sigmoidf_(float x) { return __builtin_amdgcn_rcpf(1.f + __builtin_amdgcn_exp2f(-1.4426950408889634f * x)); }

__device__ __forceinline__ int opaque_tid() { int t = threadIdx.x; asm volatile("" : "+v"(t)); return t; }

struct Args {
    const float* in[23];
    float* out;
    unsigned char* ws;
    int ph_lo, ph_hi;
};
typedef const __attribute__((address_space(4))) Args* ArgsP;
__device__ __forceinline__ ArgsP opaque_args() { ArgsP p = (ArgsP)__builtin_amdgcn_kernarg_segment_ptr(); asm volatile("" : "+s"(p)); return p; }
namespace pg8 {
constexpr int BM = 256, BK = 64, HALF = 128, HTB = HALF * BK * 2  , STAGE_BYTES = 8 * HTB;

__host__ __device__ __forceinline__ int lds_byte(int r, int c) { const int st = (r >> 4) * 2 + (c >> 5), rr = r & 15, cc = c & 31, ob = rr * 64 + cc * 2; return st * 1024 + (ob ^ (((ob >> 9) & 1) << 5)); }
__host__ __device__ __forceinline__ void stage_rc(int b, int& R, int& C) { const int st = b / 1024, sb = b % 1024, swz = sb ^ (((sb >> 9) & 1) << 5); R = (st >> 1) * 16 + swz / 64; C = (st & 1) * 32 + (swz % 64) / 2; }
__host__ __device__ __forceinline__ int perm32(int rho) { const int n = rho >> 4, i = rho & 15; return 8 * (i >> 2) + 4 * n + (i & 3); }

struct Unit { int pm, pn, aux, idx; size_t aoff, boff; };
struct Gemm { const bf16_t* A; const bf16_t* Bt; int lda, ldb, K; int kstepA; };

template <class Epi, class Sched>
__device__ __forceinline__ void gemm_phase(LAS unsigned char* lds, const Gemm g, const Sched& S, const Epi& E) {
    const int tid = opaque_tid(), wid = __builtin_amdgcn_readfirstlane(tid >> 6), lane = tid & 63, wr = wid >> 2, wc = wid & 3, fr = lane & 15, fq = lane >> 4;
    const int K = g.K, nt = K / BK;
    unsigned voffA[2], voffB[2];
#pragma unroll
    for (int i = 0; i < 2; ++i) { int R, C; stage_rc(tid * 16 + i * 8192, R, C); const int Rb = (R & ~31) + perm32(R & 31);
        voffA[i] = (unsigned)(R * g.lda + C) * 2u; voffB[i] = (unsigned)(Rb * g.ldb + C) * 2u; }
    const size_t kstepA = (size_t)g.kstepA, kstepB = (size_t)(BK * 2);
    const size_t hstepA = (size_t)HALF * g.lda * 2, hstepB = (size_t)HALF * g.ldb * 2;
    const unsigned ldsw = (unsigned)wid * 1024u;
    const int aoff = lds_byte(wr * 64 + fr, fq * 8), boff = lds_byte(wc * 32 + fr, fq * 8);
#define PG8_SA(b, h) (((b) * 2 + (h)) * HTB)
#define PG8_SB(b, h) ((4 + (b) * 2 + (h)) * HTB)
#define PG8_STAGE(bufoff, gbase, voff) do { _Pragma("unroll") for (int _i = 0; _i < 2; ++_i) \
        __builtin_amdgcn_global_load_lds((const unsigned*)((const char*)(gbase) + (voff)[_i]), (LAS unsigned*)(lds + (bufoff) + ldsw + _i * 8192), 16, 0, 0); } while (0)
#define PG8_LDA(dst, b, h) do { _Pragma("unroll") for (int m = 0; m < 4; ++m) _Pragma("unroll") for (int k = 0; k < 2; ++k) dst[m][k] = *(const LAS bf16x8*)(lds + PG8_SA(b, h) + aoff + m * 2048 + k * 1024); } while (0)
#define PG8_LDB(dst, b, h) do { _Pragma("unroll") for (int n = 0; n < 2; ++n) _Pragma("unroll") for (int k = 0; k < 2; ++k) dst[n][k] = *(const LAS bf16x8*)(lds + PG8_SB(b, h) + boff + n * 2048 + k * 1024); } while (0)
#define PG8_MMA(ai, bj, At, Bt) do { __builtin_amdgcn_s_setprio(1); _Pragma("unroll") for (int m = 0; m < 4; ++m) _Pragma("unroll") for (int n = 0; n < 2; ++n) _Pragma("unroll") for (int k = 0; k < 2; ++k) \
        acc[ai][bj][m][n] = __builtin_amdgcn_mfma_f32_16x16x32_bf16(Bt[n][k], At[m][k], acc[ai][bj][m][n], 0, 0, 0); __builtin_amdgcn_s_setprio(0); } while (0)
#define PG8_WAIT_V(n) asm volatile("s_waitcnt vmcnt(" #n ")" ::: "memory")
#define PG8_WAIT_L(n) asm volatile("s_waitcnt lgkmcnt(" #n ")" ::: "memory")
#define PG8_BAR __builtin_amdgcn_s_barrier()
#define PG8_SCHED __builtin_amdgcn_sched_barrier(0)
    Unit cur, nxt; int ui = 0;
    if (!S.next(0, cur)) return;
    f32x4 acc[2][2][4][2];
#pragma unroll
    for (int a = 0; a < 2; ++a)
#pragma unroll
        for (int b = 0; b < 2; ++b)
#pragma unroll
            for (int m = 0; m < 4; ++m)
#pragma unroll
                for (int n = 0; n < 2; ++n) acc[a][b][m][n] = (f32x4){0.f, 0.f, 0.f, 0.f};
    bf16x8 At[4][2], B0[2][2], B1[2][2];
    const char* cA = (const char*)g.A + cur.aoff; const char* cB = (const char*)g.Bt + cur.boff;
    PG8_STAGE(PG8_SB(0, 0), cB, voffB); PG8_STAGE(PG8_SB(0, 1), cB + hstepB, voffB); PG8_STAGE(PG8_SA(0, 0), cA, voffA); PG8_STAGE(PG8_SA(0, 1), cA + hstepA, voffA);
    if (wr == 1) PG8_BAR;
    PG8_WAIT_V(2); PG8_BAR;
    PG8_STAGE(PG8_SB(1, 0), cB + kstepB, voffB); PG8_STAGE(PG8_SA(1, 0), cA + kstepA, voffA); PG8_STAGE(PG8_SB(1, 1), cB + hstepB + kstepB, voffB);
    PG8_WAIT_V(6); PG8_BAR;
    for (;;) {
        const bool has_next = S.next(ui + 1, nxt);
        const char* nA = has_next ? (const char*)g.A + nxt.aoff : cA; const char* nB = has_next ? (const char*)g.Bt + nxt.boff : cB;
#pragma unroll 1
        for (int t = 0; t < nt; t += 2) {
            const bool last = (t == nt - 2);
            const char* a1 = cA + (size_t)(t + 1) * kstepA;
            const char* a2 = last ? nA : cA + (size_t)(t + 2) * kstepA; const char* b2 = last ? nB : cB + (size_t)(t + 2) * kstepB;
            const char* a3 = a2 + kstepA; const char* b3 = b2 + kstepB;
            PG8_LDB(B0, 0, 0); PG8_LDB(B1, 0, 1); PG8_SCHED; PG8_LDA(At, 0, 0); PG8_STAGE(PG8_SA(1, 1), a1 + hstepA, voffA);
            PG8_WAIT_V(8); PG8_WAIT_L(0); PG8_BAR; PG8_MMA(0, 0, At, B0); PG8_MMA(0, 1, At, B1); PG8_BAR; PG8_SCHED;
            PG8_LDA(At, 0, 1); PG8_STAGE(PG8_SB(0, 0), b2, voffB); PG8_STAGE(PG8_SB(0, 1), b2 + hstepB, voffB); PG8_STAGE(PG8_SA(0, 0), a2, voffA);
            PG8_WAIT_V(8); PG8_WAIT_L(0); PG8_BAR; PG8_MMA(1, 0, At, B0); PG8_MMA(1, 1, At, B1); PG8_BAR; PG8_SCHED;
            PG8_LDB(B0, 1, 0); PG8_LDB(B1, 1, 1); PG8_SCHED; PG8_LDA(At, 1, 0); PG8_STAGE(PG8_SA(0, 1), a2 + hstepA, voffA);
            PG8_WAIT_V(8); PG8_WAIT_L(0); PG8_BAR; PG8_MMA(0, 0, At, B0); PG8_MMA(0, 1, At, B1); PG8_BAR; PG8_SCHED;
            PG8_LDA(At, 1, 1); PG8_STAGE(PG8_SB(1, 0), b3, voffB); PG8_STAGE(PG8_SB(1, 1), b3 + hstepB, voffB); PG8_STAGE(PG8_SA(1, 0), a3, voffA);
            PG8_WAIT_V(8); PG8_WAIT_L(0); PG8_BAR; PG8_MMA(1, 0, At, B0); PG8_MMA(1, 1, At, B1); PG8_BAR; PG8_SCHED;
        }
        if (wr == 0) PG8_BAR;
        E(acc, cur, wr, wc, fr, fq);
        if (!has_next) break;
#pragma unroll
        for (int a = 0; a < 2; ++a)
#pragma unroll
            for (int b = 0; b < 2; ++b)
#pragma unroll
                for (int m = 0; m < 4; ++m)
#pragma unroll
                    for (int n = 0; n < 2; ++n) acc[a][b][m][n] = (f32x4){0.f, 0.f, 0.f, 0.f};
        cur = nxt; cA = nA; cB = nB; ++ui;
        if (wr == 1) PG8_BAR;
    }
    PG8_WAIT_V(0);
    PG8_BAR;
#undef PG8_SA
#undef PG8_SB
#undef PG8_STAGE
#undef PG8_LDA
#undef PG8_LDB
#undef PG8_MMA
#undef PG8_WAIT_V
#undef PG8_WAIT_L
#undef PG8_BAR
#undef PG8_SCHED
}

struct TileOrder {
    int nM, nN, nwg, G, c;
    __device__ __forceinline__ void init(int nM_, int nN_, int G_, int c_) { nM = nM_; nN = nN_; nwg = nM * nN; G = G_; c = c_; }
    __device__ __forceinline__ bool tile(int i, int& pm, int& pn) const {
        const long L = (long)i * G + c; if (L >= nwg) return false;
        int wgid = (int)L; { const int q = nwg / 8, r = nwg % 8, xcd = wgid % 8, off = wgid / 8; wgid = (xcd < r ? xcd * (q + 1) : r * (q + 1) + (xcd - r) * q) + off; }
        const int nig = 8 * nN, gid = wgid / nig, fm = gid * 8, gsz = (nM - fm) < 8 ? (nM - fm) : 8;
        pm = fm + ((wgid % nig) % gsz); pn = (wgid % nig) / gsz; return true;
    }
};
}
using pg8::Unit;
typedef const f32x4 (&AccT)[2][2][4][2];

__device__ __forceinline__ float log_sigmoidf_(float x) { return fminf(x, 0.f) - log1pf(__expf(-fabsf(x))); }
__device__ __forceinline__ float gelu_tanhf_(float x) { const float y = 0.7978845608028654f * (x + 0.044715f * x * x * x); const float t = 1.f - 2.f * __builtin_amdgcn_rcpf(__builtin_amdgcn_exp2f(2.8853900817779268f * y) + 1.f); return 0.5f * x * (1.f + t); }
__device__ __forceinline__ u32x4 pack8(const f32x4 a, const f32x4 b) { u32x4 w; w.x = cvtpk(a[0], a[1]); w.y = cvtpk(a[2], a[3]); w.z = cvtpk(b[0], b[1]); w.w = cvtpk(b[2], b[3]); return w; }

struct SchedInProj {
    pg8::TileOrder o;
    __device__ __forceinline__ bool next(int i, Unit& u) const { int pm, pn; if (!o.tile(i, pm, pn)) return false; u.pm = pm; u.pn = pn; u.aux = 0; u.idx = i;
        u.aoff = (size_t)pm * 256 * DM * 2; u.boff = (size_t)pn * 256 * DM * 2; return true; }
};
struct EpiInProj {
    bf16_t* Z; float* S32; const float* bias; bf16_t* KV;
    __device__ __forceinline__ void operator()(AccT acc, const Unit& u, int wr, int wc, int fr, int fq) const {
        const int pn = u.pn, row0 = u.pm * 256 + wr * 64 + fr;
        const int st0 = (pn >= 4 && pn <= 6) ? (pn - 4) * 4 : (pn == 9 || pn == 10) ? 12 + (pn - 9) * 4 : (pn == 11 || pn == 12) ? 20 + (pn - 11) * 4 : -1;
        if (st0 >= 0) {
            const int lc = wc * 32 + 8 * fq, col0 = pn * 256 + lc;
            f32x4 bv[2][2];
#pragma unroll
            for (int bj = 0; bj < 2; ++bj)
#pragma unroll
                for (int n = 0; n < 2; ++n) bv[bj][n] = *(const f32x4*)(bias + col0 + bj * 128 + 4 * n);
#pragma unroll
            for (int ai = 0; ai < 2; ++ai)
#pragma unroll
                for (int m = 0; m < 4; ++m) { const int row = row0 + ai * 128 + m * 16, bb = row >> 13, t = row & (SEQ - 1);
#pragma unroll
                    for (int bj = 0; bj < 2; ++bj) { const int l2 = lc + bj * 128; const f32x4 v0 = acc[ai][bj][m][0] + bv[bj][0], v1 = acc[ai][bj][m][1] + bv[bj][1];
                        *(u32x4*)(KV + (((size_t)(bb * NSTREAM + st0 + (l2 >> 6)) * SEQ + t) * 64) + (l2 & 63)) = pack8(v0, v1); } }
        } else if (pn < 25) {
            const bool isq = (pn == 2 || pn == 3 || pn == 7 || pn == 8), issig = pn >= 13;
            const int col0 = pn * 256 + wc * 32 + 8 * fq;
            f32x4 bv[2][2];
#pragma unroll
            for (int bj = 0; bj < 2; ++bj)
#pragma unroll
                for (int n = 0; n < 2; ++n) bv[bj][n] = *(const f32x4*)(bias + col0 + bj * 128 + 4 * n);
#pragma unroll
            for (int ai = 0; ai < 2; ++ai)
#pragma unroll
                for (int m = 0; m < 4; ++m) { bf16_t* rowp = Z + (size_t)(row0 + ai * 128 + m * 16) * ZP + col0;
#pragma unroll
                    for (int bj = 0; bj < 2; ++bj) { f32x4 v0 = acc[ai][bj][m][0] + bv[bj][0], v1 = acc[ai][bj][m][1] + bv[bj][1];
                        if (isq) { v0 = v0 * QSCALE; v1 = v1 * QSCALE; }
                        if (issig) {
#pragma unroll
                            for (int i = 0; i < 4; ++i) { v0[i] = sigmoidf_(v0[i]); v1[i] = sigmoidf_(v1[i]); } }
                        *(u32x4*)(rowp + bj * 128) = pack8(v0, v1); } }
        } else if (wc == 0) {
            const int c0 = 8 * fq;
            const f32x4 b0 = *(const f32x4*)(bias + 6400 + c0), b1 = *(const f32x4*)(bias + 6400 + c0 + 4);
#pragma unroll
            for (int ai = 0; ai < 2; ++ai)
#pragma unroll
                for (int m = 0; m < 4; ++m) { float* rowp = S32 + (size_t)(row0 + ai * 128 + m * 16) * 32 + c0;
                    f32x4 v0 = acc[ai][0][m][0] + b0, v1 = acc[ai][0][m][1] + b1;
#pragma unroll
                    for (int i = 0; i < 4; ++i) { v0[i] = (fq < 3) ? sigmoidf_(v0[i]) : log_sigmoidf_(v0[i]); v1[i] = (fq < 3) ? sigmoidf_(v1[i]) : log_sigmoidf_(v1[i]); }
                    *(f32x4*)(rowp) = v0; *(f32x4*)(rowp + 4) = v1; }
        }
    }
};

struct SchedC1 {
    int c;
    __device__ __forceinline__ bool next(int i, Unit& u) const { if (i > 0 || c >= 128) return false; const int split = c & 7, idx = c >> 3, kv = idx >> 3, pm = idx & 7, bg = pm >> 1, half = pm & 1, b = bg >> 1, gq = bg & 1;
        u.pm = pm; u.pn = 0; u.aux = kv * 8 + split;
        u.aoff = (((size_t)(b * NSTREAM + kv * 2 + gq) * SEQ + 16 * 256 * half + 4 * split) * 64) * 2; u.boff = ((size_t)kv * 256 * 2048 + split * 256) * 2; return true; }
};
struct EpiC1 {
    float* PART;
    __device__ __forceinline__ void operator()(AccT acc, const Unit& u, int wr, int wc, int fr, int fq) const {
        const int kv = u.aux >> 3, split = u.aux & 7, row0 = u.pm * 256 + wr * 64 + fr, col0 = wc * 32 + 8 * fq;
#pragma unroll
        for (int ai = 0; ai < 2; ++ai)
#pragma unroll
            for (int m = 0; m < 4; ++m) { float* rowp = PART + ((size_t)(split * 2 + kv) * 2048 + row0 + ai * 128 + m * 16) * 256 + col0;
#pragma unroll
                for (int bj = 0; bj < 2; ++bj) { *(f32x4*)(rowp + bj * 128) = acc[ai][bj][m][0]; *(f32x4*)(rowp + bj * 128 + 4) = acc[ai][bj][m][1]; } }
    }
};

struct SchedUp {
    pg8::TileOrder o;
    __device__ __forceinline__ bool next(int i, Unit& u) const { int pm, pn; const int ti = i / 3, nb = i - 3 * ti; if (!o.tile(ti, pm, pn)) return false; u.pm = pm; u.pn = pn; u.aux = nb;
        u.aoff = ((size_t)pm * 256 * 1536 + nb * 512) * 2; u.boff = ((size_t)(nb * 1024 + pn * 256) * 512) * 2; return true; }
};
struct EpiUp {
    const bf16_t* Z; float* scr; bf16_t* MRG;
    __device__ __forceinline__ void operator()(AccT acc, const Unit& u, int wr, int wc, int fr, int fq) const {
        const int nb = u.aux, row0 = u.pm * 256 + wr * 64 + fr, col0 = u.pn * 256 + wc * 32 + 8 * fq;
#pragma unroll
        for (int ai = 0; ai < 2; ++ai) {
            u32x4 gw[4][2], pw[4][2];
#pragma unroll
            for (int m = 0; m < 4; ++m)
#pragma unroll
                for (int bj = 0; bj < 2; ++bj) gw[m][bj] = *(const u32x4*)(Z + (size_t)(row0 + ai * 128 + m * 16) * ZP + ZC_GM + nb * 1024 + col0 + bj * 128);
            if (nb > 0) {
#pragma unroll
                for (int m = 0; m < 4; ++m)
#pragma unroll
                    for (int bj = 0; bj < 2; ++bj) pw[m][bj] = *(const u32x4*)(MRG + (size_t)(row0 + ai * 128 + m * 16) * DM + col0 + bj * 128);
            } else {
#pragma unroll
                for (int m = 0; m < 4; ++m)
#pragma unroll
                    for (int bj = 0; bj < 2; ++bj) pw[m][bj] = (u32x4){0u, 0u, 0u, 0u};
            }
#pragma unroll
            for (int m = 0; m < 4; ++m) { const size_t row = (size_t)(row0 + ai * 128 + m * 16);
#pragma unroll
                for (int bj = 0; bj < 2; ++bj) { const int col = col0 + bj * 128; const u32x4 g = gw[m][bj], p = pw[m][bj];
                    f32x4 v0 = acc[ai][bj][m][0], v1 = acc[ai][bj][m][1];
                    v0[0] *= bflo(g.x); v0[1] *= bfhi(g.x); v0[2] *= bflo(g.y); v0[3] *= bfhi(g.y); v1[0] *= bflo(g.z); v1[1] *= bfhi(g.z); v1[2] *= bflo(g.w); v1[3] *= bfhi(g.w);
                    v0[0] += bflo(p.x); v0[1] += bfhi(p.x); v0[2] += bflo(p.y); v0[3] += bfhi(p.y); v1[0] += bflo(p.z); v1[1] += bfhi(p.z); v1[2] += bflo(p.w); v1[3] += bfhi(p.w);
                    *(u32x4*)(MRG + row * DM + col) = pack8(v0, v1); } }
        }
    }
};

struct SchedWo {
    pg8::TileOrder o;
    __device__ __forceinline__ bool next(int i, Unit& u) const { int pm, pn; if (!o.tile(i, pm, pn)) return false; u.pm = pm; u.pn = pn; u.aux = 0;
        u.aoff = (size_t)pm * 256 * DM * 2; u.boff = (size_t)pn * 256 * DM * 2; return true; }
};
struct EpiWo {
    const float* X; const bf16_t* Xb; bf16_t* V1;
    __device__ __forceinline__ void operator()(AccT acc, const Unit& u, int wr, int wc, int fr, int fq) const {
        const int row0 = u.pm * 256 + wr * 64 + fr, col0 = u.pn * 256 + wc * 32 + 8 * fq;
#pragma unroll
        for (int ai = 0; ai < 2; ++ai) {
            f32x4 xr[4][2][2];
#pragma unroll
            for (int m = 0; m < 4; ++m) { const size_t off = (size_t)(row0 + ai * 128 + m * 16) * DM + col0;
#pragma unroll
                for (int bj = 0; bj < 2; ++bj) {
                    if (X) { xr[m][bj][0] = *(const f32x4*)(X + off + bj * 128); xr[m][bj][1] = *(const f32x4*)(X + off + bj * 128 + 4); }
                    else { const u32x4 w = *(const u32x4*)(Xb + off + bj * 128); xr[m][bj][0] = (f32x4){bflo(w.x), bfhi(w.x), bflo(w.y), bfhi(w.y)}; xr[m][bj][1] = (f32x4){bflo(w.z), bfhi(w.z), bflo(w.w), bfhi(w.w)}; } } }
#pragma unroll
            for (int m = 0; m < 4; ++m) { const size_t off = (size_t)(row0 + ai * 128 + m * 16) * DM + col0;
#pragma unroll
                for (int bj = 0; bj < 2; ++bj) *(u32x4*)(V1 + off + bj * 128) = pack8(xr[m][bj][0] * ALPHA + acc[ai][bj][m][0], xr[m][bj][1] * ALPHA + acc[ai][bj][m][1]); }
        }
    }
};

struct SchedMoe {
    const int* blk; int nblk, G, c, ntn, nrowB, first;
    __device__ __forceinline__ bool next(int i, Unit& u) const { const long L = (long)first + (long)i * G + c; const int b = (int)(L / ntn), tn = (int)(L % ntn); if (b >= nblk) return false; const int e = blk[b];
        u.pm = b; u.pn = tn; u.aux = e; u.aoff = (size_t)b * 256 * DM * 2; u.boff = ((size_t)e * nrowB + tn * 256) * DM * 2; return true; }
};
struct EpiMoe1 {
    bf16_t* ACT; const float* b1;
    __device__ __forceinline__ void operator()(AccT acc, const Unit& u, int wr, int wc, int fr, int fq) const {
        const int e = u.aux, row0 = u.pm * 256 + wr * 64 + fr, cg0 = u.pn * 128 + wc * 32 + 8 * fq;
        const float* bp = b1 + (size_t)e * 2048 + cg0;
        const f32x4 bg0 = *(const f32x4*)bp, bg1 = *(const f32x4*)(bp + 4), bu0 = *(const f32x4*)(bp + 1024), bu1 = *(const f32x4*)(bp + 1028);
#pragma unroll
        for (int ai = 0; ai < 2; ++ai)
#pragma unroll
            for (int m = 0; m < 4; ++m) { const size_t row = (size_t)(row0 + ai * 128 + m * 16);
                f32x4 g0 = acc[ai][0][m][0] + bg0, g1 = acc[ai][0][m][1] + bg1, u0 = acc[ai][1][m][0] + bu0, u1 = acc[ai][1][m][1] + bu1, a0, a1;
#pragma unroll
                for (int i = 0; i < 4; ++i) {
                    float gg = fminf(g0[i], 7.f), uu = fminf(fmaxf(u0[i], -7.f), 7.f); a0[i] = (uu + 1.f) * (gg * sigmoidf_(1.702f * gg));
                    gg = fminf(g1[i], 7.f); uu = fminf(fmaxf(u1[i], -7.f), 7.f); a1[i] = (uu + 1.f) * (gg * sigmoidf_(1.702f * gg)); }
                *(u32x4*)(ACT + row * DM + cg0) = pack8(a0, a1); }
    }
};
struct EpiMoe2 {
    bf16_t* YB; const float* b2; const float* sg;
    __device__ __forceinline__ void operator()(AccT acc, const Unit& u, int wr, int wc, int fr, int fq) const {
        const int e = u.aux, row0 = u.pm * 256 + wr * 64 + fr, col0 = u.pn * 256 + wc * 32 + 8 * fq;
        f32x4 bv[2][2]; float gtv[2][4];
#pragma unroll
        for (int bj = 0; bj < 2; ++bj) { const float* bp = b2 + (size_t)e * DM + col0 + bj * 128; bv[bj][0] = *(const f32x4*)bp; bv[bj][1] = *(const f32x4*)(bp + 4); }
#pragma unroll
        for (int ai = 0; ai < 2; ++ai)
#pragma unroll
            for (int m = 0; m < 4; ++m) gtv[ai][m] = sg[(size_t)(row0 + ai * 128 + m * 16)];
#pragma unroll
        for (int ai = 0; ai < 2; ++ai)
#pragma unroll
            for (int m = 0; m < 4; ++m) { const size_t row = (size_t)(row0 + ai * 128 + m * 16); const float gt = gtv[ai][m];
#pragma unroll
                for (int bj = 0; bj < 2; ++bj) {
                    const f32x4 v0 = (acc[ai][bj][m][0] + bv[bj][0]) * gt, v1 = (acc[ai][bj][m][1] + bv[bj][1]) * gt;
                    *(u32x4*)(YB + row * DM + col0 + bj * 128) = pack8(v0, v1); } }
    }
};

struct SchedMoeT {
    const int* blk; int nblk, G, c, l; unsigned* arrive;
    __device__ __forceinline__ bool next(int i, Unit& u) const {
        const int L = i * G + c, N1 = nblk * 8, tail = N1 % G; u.idx = i;
        if (L < N1) { const int b = L >> 3, tn = L & 7, e = blk[b]; u.pm = b; u.pn = tn; u.aux = e;
            u.aoff = WS_XS + (size_t)b * 256 * DM * 2; u.boff = WS_WM1 + (size_t)l * WM1_L + ((size_t)e * 2048 + tn * 256) * DM * 2; return true; }
        if (tail == 0 || i != N1 / G || i < 2) return false;
        const int j = c - tail, b = j >> 2, tn = j & 3; if (j < 0 || b >= nblk) return false;
        const int e = blk[b]; u.pm = b; u.pn = 8 + tn; u.aux = e;
        u.aoff = WS_ACT + (size_t)b * 256 * DM * 2; u.boff = WS_WM2 + (size_t)l * WM2_L + ((size_t)e * 1024 + tn * 256) * DM * 2;
        unsigned sp = 0u;
        while ((unsigned)__builtin_amdgcn_readfirstlane((int)__hip_atomic_load(arrive, __ATOMIC_RELAXED, __HIP_MEMORY_SCOPE_AGENT)) < (unsigned)G) { __builtin_amdgcn_s_sleep(1); if (++sp > (1u << 24)) break; }
        __builtin_amdgcn_fence(__ATOMIC_ACQUIRE, "agent");
        return true;
    }
};
struct EpiMoeT {
    EpiMoe1 e1; EpiMoe2 e2; unsigned* arrive; bool publish;
    __device__ __forceinline__ void operator()(AccT acc, const Unit& u, int wr, int wc, int fr, int fq) const {
        if (u.pn < 8) {
            e1(acc, u, wr, wc, fr, fq);
            if (publish && u.idx == 1) {
                asm volatile("s_waitcnt vmcnt(0)" ::: "memory");
                __builtin_amdgcn_s_barrier();
                if (wr == 0 && wc == 0 && (fr | fq) == 0) { __builtin_amdgcn_fence(__ATOMIC_RELEASE, "agent"); asm volatile("s_waitcnt vmcnt(0)" ::: "memory"); (void)__hip_atomic_fetch_add(arrive, 1u, __ATOMIC_RELAXED, __HIP_MEMORY_SCOPE_AGENT); }
            }
        } else { Unit v = u; v.pn = u.pn - 8; e2(acc, v, wr, wc, fr, fq); }
    }
};

struct EpiInProjT {
    EpiInProj e; unsigned* arrive; bool publish;
    __device__ __forceinline__ void operator()(AccT acc, const Unit& u, int wr, int wc, int fr, int fq) const {
        e(acc, u, wr, wc, fr, fq);
        if (publish && u.pn < 2) {
            asm volatile("s_waitcnt vmcnt(0)" ::: "memory");
            __builtin_amdgcn_s_barrier();
            if (wr == 0 && wc == 0 && (fr | fq) == 0) { __builtin_amdgcn_fence(__ATOMIC_RELEASE, "agent"); asm volatile("s_waitcnt vmcnt(0)" ::: "memory"); (void)__hip_atomic_fetch_add(arrive, 1u, __ATOMIC_RELAXED, __HIP_MEMORY_SCOPE_AGENT); }
        }
    }
};
namespace attc {
enum { M_FOX = 0, M_WIN = 1, M_SLC = 2, M_CMP = 3 };
constexpr int KB0 = 0, KBSZ = 8448  , VB0 = 2 * KBSZ, VBSZ = 8192;
constexpr int IMP_OFF = VB0 + 2 * VBSZ;
constexpr int IMP_W = 132;
constexpr int KEY_OFF = IMP_OFF + 8 * 8 * IMP_W * 4;
constexpr int LDS_NEED = KEY_OFF + 8 * 8 * 128 * 4;
typedef short v4i16_t __attribute__((ext_vector_type(4)));
typedef short s16x4 __attribute__((ext_vector_type(4)));

struct P { const bf16_t* Z; const bf16_t* KV; const float* S32; const float* cum; const bf16_t* KC; const bf16_t* VC; unsigned* sel; float* onsa; bf16_t* YS; };

__device__ __forceinline__ s16x4 vtr(LAS const unsigned char* p) { return __builtin_bit_cast(s16x4, __builtin_amdgcn_ds_read_tr16_b64_v4i16((LAS v4i16_t*)p)); }
#define MFMA32C(a, b, c) __builtin_amdgcn_mfma_f32_32x32x16_bf16((a), (b), (c), 0, 0, 0)

#define LDS_BARC() asm volatile("s_waitcnt lgkmcnt(0)\n\ts_barrier" ::: "memory")

template <int MODE, int PASS>
__device__ __forceinline__ void attn_steps(LAS unsigned char* lds, f32x16& o0, f32x16& o1, float& m_run, float& lsum, bool& shifted, const float inv_l, const bf16x8 (&qf)[4],
                                           const bf16_t* kld, const bf16_t* vld, const float* cumk, const int kp,
                                           const int t_lo, const int nT, const int qb, const int tq, const float cq, const unsigned sel0, const unsigned sel1, const unsigned sel2, const unsigned sel3,
                                           LAS float* impw, const int tid, const int lane, const int wid) {
#ifndef HALF_EXPR
#define HALF_EXPR (wid >> 2)
#endif
    const int r32 = lane & 31, hi = lane >> 5, half = HALF_EXPR;
    const float NEG_INF = -__builtin_inff();
    const unsigned kst = (unsigned)(wid * 1024 + lane * 16);
    const int vrow = (tid >> 2) & 63, vch = (tid & 3) | ((tid >> 8) << 2);
    const unsigned vst = (unsigned)(1024 * (vrow >> 3) + 512 * (vch >> 2) + 64 * (vrow & 7) + 16 * (vch & 3));
    const unsigned kfb = (unsigned)(hi * 1024 + r32 * 16);
    const unsigned vfb = (unsigned)(256 * hi + 64 * ((lane & 15) >> 2) + 32 * ((lane >> 4) & 1) + 8 * (lane & 3));
    u32x4 kr = {0u, 0u, 0u, 0u}, vr = {0u, 0u, 0u, 0u}; float br = 0.f;
    f32x16 p0, p1; bf16x8 pk00, pk01, pk10, pk11;
#define SELBIT(tt) ((((tt) < 64) ? (((tt) < 32) ? sel0 : sel1) : (((tt) < 96) ? sel2 : sel3)) >> ((tt) & 31)) & 1u
#define LOAD_SET(w) do { if ((w) + 1 < nT) { kr = *(const u32x4*)(kld + (size_t)(t_lo + (w) + 1) * 64 * kp); if (MODE == M_FOX) { if (tid < 64) br = cumk[(t_lo + (w) + 1) * 64 + tid]; } } \
        if (PASS != 0) { if ((w) < nT) vr = *(const u32x4*)(vld + (size_t)(t_lo + (w)) * 64 * kp); } } while (0)
#define WRITE_SET(w) do { if ((w) + 1 < nT) { LAS unsigned char* kb_ = lds + KB0 + (((w) + 1) & 1) * KBSZ; *(LAS u32x4*)(kb_ + kst) = kr; if (MODE == M_FOX) { if (tid < 64) *(LAS float*)(kb_ + 8192 + tid * 4) = br; } } \
        if (PASS != 0) { if ((w) < nT) *(LAS u32x4*)(lds + VB0 + ((w) & 1) * VBSZ + vst) = vr; } } while (0)
#define QK_TILE(j) do { LAS const unsigned char* kbuf_ = lds + KB0 + ((j) & 1) * KBSZ; \
        if (MODE == M_FOX) { LAS const float* bs_ = (LAS const float*)(kbuf_ + 8192); const float cqm_ = cq - m_run; \
            _Pragma("unroll") for (int g4 = 0; g4 < 4; ++g4) { const f32x4 c0_ = *(LAS const f32x4*)(bs_ + 8 * g4 + 4 * hi), c1_ = *(LAS const f32x4*)(bs_ + 32 + 8 * g4 + 4 * hi); \
                _Pragma("unroll") for (int i = 0; i < 4; ++i) { p0[4 * g4 + i] = cqm_ - c0_[i]; p1[4 * g4 + i] = cqm_ - c1_[i]; } } \
        } else { _Pragma("unroll") for (int r = 0; r < 16; ++r) { p0[r] = 0.f; p1[r] = 0.f; } } \
        _Pragma("unroll") for (int ds = 0; ds < 4; ++ds) { const bf16x8 k0_ = *(LAS const bf16x8*)(kbuf_ + kfb + ds * 2048), k1_ = *(LAS const bf16x8*)(kbuf_ + kfb + ds * 2048 + 512); \
            p0 = MFMA32C(k0_, qf[ds], p0); p1 = MFMA32C(k1_, qf[ds], p1); } } while (0)

    {
        const u32x4 kr0 = *(const u32x4*)(kld + (size_t)t_lo * 64 * kp);
        float br0 = 0.f; if (MODE == M_FOX) { if (tid < 64) br0 = cumk[t_lo * 64 + tid]; }
        LOAD_SET(0);
        *(LAS u32x4*)(lds + KB0 + kst) = kr0;
        if (MODE == M_FOX) { if (tid < 64) *(LAS float*)(lds + KB0 + 8192 + tid * 4) = br0; }
    }
    LDS_BARC();
    if (half == 1) LDS_BARC();
    { bool act0 = true; if (MODE == M_SLC) { const bool mine0 = SELBIT(t_lo); act0 = __any(mine0); }
      if (act0) QK_TILE(0); }
    if (half == 1) { WRITE_SET(0); LOAD_SET(1); }
    LDS_BARC();
#pragma unroll 1
    for (int it = 0; it < nT; ++it) {
        const int t = t_lo + it;
        bool act = true, mine = true;
        if (MODE == M_SLC) { mine = SELBIT(t); act = __any(mine); }
        if (act) {
            if (MODE != M_FOX && shifted) {
#pragma unroll
                for (int r = 0; r < 16; ++r) { p0[r] -= m_run; p1[r] -= m_run; } }
            const int kv0 = t * 64 + 4 * hi;
            if (MODE == M_FOX) {
                if (t >= 4 * qb) {
#pragma unroll
                    for (int r = 0; r < 16; ++r) { const int kv = kv0 + (r & 3) + 8 * (r >> 2); if (kv > tq) p0[r] = NEG_INF; if (kv + 32 > tq) p1[r] = NEG_INF; } }
            } else if (MODE == M_WIN) {
                if (t == qb || t == qb - 8) {
#pragma unroll
                    for (int r = 0; r < 16; ++r) { const int kv = kv0 + (r & 3) + 8 * (r >> 2); if (kv > tq || kv <= tq - 512) p0[r] = NEG_INF; if (kv + 32 > tq || kv + 32 <= tq - 512) p1[r] = NEG_INF; } }
            } else if (MODE == M_SLC) {
                if (t == qb || !mine) {
#pragma unroll
                    for (int r = 0; r < 16; ++r) { const int kv = kv0 + (r & 3) + 8 * (r >> 2); if (!mine || kv > tq) p0[r] = NEG_INF; if (!mine || kv + 32 > tq) p1[r] = NEG_INF; } }
            } else {
#pragma unroll
                for (int r = 0; r < 16; ++r) { const int c = kv0 + (r & 3) + 8 * (r >> 2); if (16 * c + 31 > tq) p0[r] = NEG_INF; if (16 * (c + 32) + 31 > tq) p1[r] = NEG_INF; }
            }
#pragma unroll
            for (int r = 0; r < 16; ++r) { p0[r] = __builtin_amdgcn_exp2f(p0[r]); p1[r] = __builtin_amdgcn_exp2f(p1[r]); }
            if (PASS != 1) {
                float mx = fmaxf(p0[0], p1[0]);
#pragma unroll
                for (int r = 1; r < 16; ++r) mx = fmaxf(mx, fmaxf(p0[r], p1[r]));
                { const auto rr = __builtin_amdgcn_permlane32_swap(__float_as_uint(mx), __float_as_uint(mx), false, false); mx = fmaxf(__uint_as_float(rr[0]), __uint_as_float(rr[1])); }
                if (__any(mx > 256.f)) {
                    const float dl = mx > 1.f ? __builtin_amdgcn_logf(mx) : 0.f;
                    const float scl = __builtin_amdgcn_exp2f(-dl);
                    m_run += dl; shifted = true; lsum *= scl;
#pragma unroll
                    for (int r = 0; r < 16; ++r) { p0[r] *= scl; p1[r] *= scl; }
                    if (PASS == 2) {
#pragma unroll
                        for (int r = 0; r < 16; ++r) { o0[r] *= scl; o1[r] *= scl; } }
                }
                float ls = 0.f;
#pragma unroll
                for (int r = 0; r < 16; ++r) ls += p0[r] + p1[r];
                lsum += ls;
            }
            if (PASS != 0) {
                if (PASS == 1) {
#pragma unroll
                    for (int r = 0; r < 16; ++r) { p0[r] *= inv_l; p1[r] *= inv_l; } }
                u32x4 w;
                w.x = cvtpk(p0[0], p0[1]); w.y = cvtpk(p0[2], p0[3]); w.z = cvtpk(p0[4], p0[5]); w.w = cvtpk(p0[6], p0[7]); pk00 = __builtin_bit_cast(bf16x8, w);
                w.x = cvtpk(p0[8], p0[9]); w.y = cvtpk(p0[10], p0[11]); w.z = cvtpk(p0[12], p0[13]); w.w = cvtpk(p0[14], p0[15]); pk01 = __builtin_bit_cast(bf16x8, w);
                w.x = cvtpk(p1[0], p1[1]); w.y = cvtpk(p1[2], p1[3]); w.z = cvtpk(p1[4], p1[5]); w.w = cvtpk(p1[6], p1[7]); pk10 = __builtin_bit_cast(bf16x8, w);
                w.x = cvtpk(p1[8], p1[9]); w.y = cvtpk(p1[10], p1[11]); w.z = cvtpk(p1[12], p1[13]); w.w = cvtpk(p1[14], p1[15]); pk11 = __builtin_bit_cast(bf16x8, w);
            }
        }
#ifdef PROBE_VALU
        if (MODE == M_FOX) { float acc_ = 0.f;
#pragma unroll
            for (int r = 0; r < 16; ++r) { float x0_ = p0[r], x1_ = p1[r]; asm volatile("v_exp_f32 %0, %0\n\tv_exp_f32 %1, %1" : "+v"(x0_), "+v"(x1_)); acc_ += x0_ + x1_; }
            asm volatile("" :: "v"(acc_)); }
#endif
        if (PASS != 0) asm volatile("" : "+v"(pk00), "+v"(pk01), "+v"(pk10), "+v"(pk11));
        asm volatile("" : "+v"(lsum));
        { const int w = it + half; WRITE_SET(w); LOAD_SET(w + 1); }
        LDS_BARC();
#ifdef PROBE_BAR
        LDS_BARC(); LDS_BARC();
#endif
        const bool doPV = (PASS != 0) && act;
        bool doQK = it + 1 < nT;
        if (MODE == M_SLC) { if (doQK) { const bool minen = SELBIT(t + 1); doQK = __any(minen); } }
        bf16x8 vf[4][2], kf[8]; f32x4 bc[8];
        if (doPV) {
            LAS const unsigned char* vb = lds + VB0 + (it & 1) * VBSZ + vfb;
#pragma unroll
            for (int q4 = 0; q4 < 4; ++q4) { const s16x4 a0_ = vtr(vb + 2048 * q4), a1_ = vtr(vb + 2048 * q4 + 1024), c0_ = vtr(vb + 2048 * q4 + 512), c1_ = vtr(vb + 2048 * q4 + 1536);
                vf[q4][0] = (bf16x8){a0_[0], a0_[1], a0_[2], a0_[3], a1_[0], a1_[1], a1_[2], a1_[3]}; vf[q4][1] = (bf16x8){c0_[0], c0_[1], c0_[2], c0_[3], c1_[0], c1_[1], c1_[2], c1_[3]}; }
        }
        if (doQK) {
            LAS const unsigned char* kbuf_ = lds + KB0 + ((it + 1) & 1) * KBSZ;
#pragma unroll
            for (int ds = 0; ds < 4; ++ds) { kf[2 * ds] = *(LAS const bf16x8*)(kbuf_ + kfb + ds * 2048); kf[2 * ds + 1] = *(LAS const bf16x8*)(kbuf_ + kfb + ds * 2048 + 512); }
            if (MODE == M_FOX) { LAS const float* bs_ = (LAS const float*)(kbuf_ + 8192);
#pragma unroll
                for (int g4 = 0; g4 < 4; ++g4) { bc[2 * g4] = *(LAS const f32x4*)(bs_ + 8 * g4 + 4 * hi); bc[2 * g4 + 1] = *(LAS const f32x4*)(bs_ + 32 + 8 * g4 + 4 * hi); } }
        }
        __builtin_amdgcn_sched_barrier(0);
        if (doPV) {
            o0 = MFMA32C(vf[0][0], pk00, o0); o1 = MFMA32C(vf[0][1], pk00, o1);
            o0 = MFMA32C(vf[1][0], pk01, o0); o1 = MFMA32C(vf[1][1], pk01, o1);
            o0 = MFMA32C(vf[2][0], pk10, o0); o1 = MFMA32C(vf[2][1], pk10, o1);
            o0 = MFMA32C(vf[3][0], pk11, o0); o1 = MFMA32C(vf[3][1], pk11, o1);
            if (MODE == M_CMP) {
                f32x16 di;
                int r32o = r32, hio = hi; asm volatile("" : "+v"(r32o), "+v"(hio));
#pragma unroll
                for (int r = 0; r < 16; ++r) di[r] = 0.f;
#define IMP_STEP(KB, SS, PKX) do { bf16x8 ov_; _Pragma("unroll") for (int j = 0; j < 8; ++j) { const int cl_ = 32 * (KB) + 16 * (SS) + 8 * (j >> 2) + 4 * hio + (j & 3); ov_[j] = (cl_ >= 4 * r32o - 1 && cl_ <= 4 * r32o + 3) ? (short)0x3F80 : (short)0; } \
                di = MFMA32C(PKX, ov_, di); } while (0)
                IMP_STEP(0, 0, pk00); IMP_STEP(0, 1, pk01); IMP_STEP(1, 0, pk10); IMP_STEP(1, 1, pk11);
#undef IMP_STEP
                if (r32 <= 16) {
#pragma unroll
                    for (int j = 0; j < 4; ++j) { const float v = (di[j] + di[j + 4]) + (di[j + 8] + di[j + 12]); LAS float* ip = impw + (4 * hi + j) * IMP_W + 16 * t + r32; *ip = *ip + v; }
                }
            }
        }
        if (doQK) {
            if (MODE == M_FOX) { const float cqm_ = cq - m_run;
#pragma unroll
                for (int g4 = 0; g4 < 4; ++g4)
#pragma unroll
                    for (int i = 0; i < 4; ++i) { p0[4 * g4 + i] = cqm_ - bc[2 * g4][i]; p1[4 * g4 + i] = cqm_ - bc[2 * g4 + 1][i]; }
            } else {
#pragma unroll
                for (int r = 0; r < 16; ++r) { p0[r] = 0.f; p1[r] = 0.f; } }
#pragma unroll
            for (int ds = 0; ds < 4; ++ds) { p0 = MFMA32C(kf[2 * ds], qf[ds], p0); p1 = MFMA32C(kf[2 * ds + 1], qf[ds], p1); }
        }
        LDS_BARC();
    }
    if (half == 0) LDS_BARC();
#undef SELBIT
#undef LOAD_SET
#undef WRITE_SET
#undef QK_TILE
}

template <int MODE>
__device__ __forceinline__ void attn_unit(LAS unsigned char* lds, const P& A, const int b, const int hg, const int qb) {
    const int tid = opaque_tid(), lane = tid & 63, wid = __builtin_amdgcn_readfirstlane(tid >> 6), r32 = lane & 31, hi = lane >> 5;
    int tq, qcol, hh = 0;
    if (MODE == M_FOX) { tq = qb * 256 + wid * 32 + r32; qcol = ZC_FOX + hg * 64; }
    else { hh = r32 >> 3; tq = qb * 64 + wid * 8 + (r32 & 7); qcol = ZC_QN + (hg * 4 + hh) * 64; }
    const size_t tokrow = (size_t)b * SEQ + tq;
    bf16x8 qf[4];
    { const bf16_t* qp = A.Z + tokrow * ZP + qcol + hi * 8;
#pragma unroll
      for (int ds = 0; ds < 4; ++ds) qf[ds] = *(const bf16x8*)(qp + ds * 16); }
    const bf16_t *Kg, *Vg; int kp, t_lo, t_hi;
    const bf16_t* KVb = A.KV + (size_t)b * NSTREAM * SEQ * 64;
    if (MODE == M_FOX) { Kg = KVb + (size_t)(12 + hg) * SEQ * 64; Vg = KVb + (size_t)(20 + hg) * SEQ * 64; kp = 64; t_lo = 0; t_hi = 4 * qb + 3; }
    else if (MODE == M_WIN) { Kg = KVb + (size_t)(8 + hg) * SEQ * 64; Vg = KVb + (size_t)(10 + hg) * SEQ * 64; kp = 64; t_lo = qb > 8 ? qb - 8 : 0; t_hi = qb; }
    else if (MODE == M_SLC) { Kg = KVb + (size_t)(4 + hg) * SEQ * 64; Vg = KVb + (size_t)(6 + hg) * SEQ * 64; kp = 64; t_lo = 0; t_hi = qb; }
    else { Kg = A.KC + (size_t)(b * 2 + hg) * 512 * 64; Vg = A.VC + (size_t)(b * 2 + hg) * 512 * 64; kp = 64; t_lo = 0; t_hi = (4 * qb + 2) >> 6; if (t_hi > 7) t_hi = 7; }
    const int nT = t_hi - t_lo + 1;
    const bf16_t* kld = Kg + (size_t)lane * kp + wid * 8;
    const int vrow = (tid >> 2) & 63, vch = (tid & 3) | ((tid >> 8) << 2);
    const bf16_t* vld = Vg + (size_t)vrow * kp + vch * 8;
    const float* cumk = nullptr; float cq = 0.f;
    if (MODE == M_FOX) { cumk = A.cum + (size_t)(b * 8 + hg) * SEQ; cq = cumk[tq]; }
    unsigned sel0 = 0u, sel1 = 0u, sel2 = 0u, sel3 = 0u;
    if (MODE == M_SLC) { const u32x4 s4 = *(const u32x4*)(A.sel + ((size_t)(b * 2 + hg) * SEQ + tq) * 4); sel0 = s4.x; sel1 = s4.y; sel2 = s4.z; sel3 = s4.w; }

    asm volatile("" : "+v"(qf[0]), "+v"(qf[1]), "+v"(qf[2]), "+v"(qf[3]));
    asm volatile("" : "+v"(cq), "+v"(sel0), "+v"(sel1), "+v"(sel2), "+v"(sel3));
    f32x16 o0, o1;
#pragma unroll
    for (int r = 0; r < 16; ++r) { o0[r] = 0.f; o1[r] = 0.f; }
    float m_run = 0.f, lsum = 0.f; bool shifted = false;
    LAS float* impw = (LAS float*)(lds + IMP_OFF) + wid * 8 * IMP_W;
    float sc;
    if (MODE == M_CMP) {
        for (int i = lane; i < 8 * IMP_W; i += 64) impw[i] = 0.f;
        attn_steps<MODE, 0>(lds, o0, o1, m_run, lsum, shifted, 0.f, qf, kld, vld, cumk, kp, t_lo, nT, qb, tq, cq, sel0, sel1, sel2, sel3, impw, tid, lane, wid);
        float inv_l;
        { const auto rr = __builtin_amdgcn_permlane32_swap(__float_as_uint(lsum), __float_as_uint(lsum), false, false); const float lt = __uint_as_float(rr[0]) + __uint_as_float(rr[1]); inv_l = lt > 0.f ? 1.f / lt : 0.f; }
        attn_steps<MODE, 1>(lds, o0, o1, m_run, lsum, shifted, inv_l, qf, kld, vld, cumk, kp, t_lo, nT, qb, tq, cq, sel0, sel1, sel2, sel3, impw, tid, lane, wid);
        sc = 1.f;
    } else {
        attn_steps<MODE, 2>(lds, o0, o1, m_run, lsum, shifted, 0.f, qf, kld, vld, cumk, kp, t_lo, nT, qb, tq, cq, sel0, sel1, sel2, sel3, impw, tid, lane, wid);
        const auto rr = __builtin_amdgcn_permlane32_swap(__float_as_uint(lsum), __float_as_uint(lsum), false, false); const float lt = __uint_as_float(rr[0]) + __uint_as_float(rr[1]);
        sc = lt > 0.f ? 1.f / lt : 0.f;
    }
    if (MODE == M_FOX) {
        bf16_t* op = A.YS + tokrow * 1536 + 1024 + hg * 64 + 4 * hi;
#pragma unroll
        for (int g4 = 0; g4 < 4; ++g4) {
            u32x2 w; w.x = cvtpk(o0[4 * g4] * sc, o0[4 * g4 + 1] * sc); w.y = cvtpk(o0[4 * g4 + 2] * sc, o0[4 * g4 + 3] * sc); *(u32x2*)(op + 8 * g4) = w;
            w.x = cvtpk(o1[4 * g4] * sc, o1[4 * g4 + 1] * sc); w.y = cvtpk(o1[4 * g4 + 2] * sc, o1[4 * g4 + 3] * sc); *(u32x2*)(op + 32 + 8 * g4) = w;
        }
    } else {
        const int br = (MODE == M_CMP) ? 0 : (MODE == M_SLC) ? 1 : 2;
        const float gsc = sc * A.S32[tokrow * 32 + (hg * 4 + hh) * 3 + br];
        bf16_t* np = (bf16_t*)A.onsa + tokrow * 512 + (hg * 4 + hh) * 64 + 4 * hi;
        bf16_t* op = A.YS + tokrow * 1536 + 512 + (hg * 4 + hh) * 64 + 4 * hi;
#pragma unroll
        for (int g4 = 0; g4 < 4; ++g4) {
            f32x4 v0 = {o0[4 * g4] * gsc, o0[4 * g4 + 1] * gsc, o0[4 * g4 + 2] * gsc, o0[4 * g4 + 3] * gsc};
            f32x4 v1 = {o1[4 * g4] * gsc, o1[4 * g4 + 1] * gsc, o1[4 * g4 + 2] * gsc, o1[4 * g4 + 3] * gsc};
            if (MODE != M_CMP) { const u32x2 a0_ = *(const u32x2*)(np + 8 * g4), a1_ = *(const u32x2*)(np + 32 + 8 * g4);
                v0[0] += bflo(a0_.x); v0[1] += bfhi(a0_.x); v0[2] += bflo(a0_.y); v0[3] += bfhi(a0_.y); v1[0] += bflo(a1_.x); v1[1] += bfhi(a1_.x); v1[2] += bflo(a1_.y); v1[3] += bfhi(a1_.y); }
            if (MODE != M_WIN) { u32x2 w_; w_.x = cvtpk(v0[0], v0[1]); w_.y = cvtpk(v0[2], v0[3]); *(u32x2*)(np + 8 * g4) = w_; w_.x = cvtpk(v1[0], v1[1]); w_.y = cvtpk(v1[2], v1[3]); *(u32x2*)(np + 32 + 8 * g4) = w_; }
            else { u32x2 w; w.x = cvtpk(v0[0], v0[1]); w.y = cvtpk(v0[2], v0[3]); *(u32x2*)(op + 8 * g4) = w; w.x = cvtpk(v1[0], v1[1]); w.y = cvtpk(v1[2], v1[3]); *(u32x2*)(op + 32 + 8 * g4) = w; }
        }
    }
    if (MODE == M_CMP) {
        const int ql = lane >> 3, sub = lane & 7, cur = qb;
        LAS const float* row = impw + ql * IMP_W;
        LAS unsigned* keys = (LAS unsigned*)(lds + KEY_OFF) + wid * 8 * 128 + ql * 128;
#pragma unroll
        for (int i4 = 0; i4 < 4; ++i4) { u32x4 kq;
#pragma unroll
            for (int i = 0; i < 4; ++i) { const int s = sub * 16 + i4 * 4 + i; float v = row[s]; if (s == 0 || s == cur || s == cur - 1) v = 1e6f;
                kq[i] = (s <= cur) ? (((__float_as_uint(v) & ~0x7Fu) | (unsigned)(127 - s)) | 0x80000000u) : 0u; }
            *(LAS u32x4*)(keys + sub * 16 + i4 * 4) = kq; }
        unsigned bits = 0u;
#pragma unroll 1
        for (int half = 0; half < 2; ++half) {
            unsigned kown[8]; int rank[8];
            { const u32x4 k0 = *(LAS const u32x4*)(keys + sub * 16 + half * 8), k1 = *(LAS const u32x4*)(keys + sub * 16 + half * 8 + 4);
              kown[0] = k0.x; kown[1] = k0.y; kown[2] = k0.z; kown[3] = k0.w; kown[4] = k1.x; kown[5] = k1.y; kown[6] = k1.z; kown[7] = k1.w; }
#pragma unroll
            for (int i = 0; i < 8; ++i) rank[i] = 0;
#pragma unroll 2
            for (int sp4 = 0; sp4 <= (cur >> 2); ++sp4) {
                const u32x4 kk = *(LAS const u32x4*)(keys + sp4 * 4);
#pragma unroll
                for (int i = 0; i < 8; ++i) rank[i] += (kk.x > kown[i] ? 1 : 0) + (kk.y > kown[i] ? 1 : 0) + (kk.z > kown[i] ? 1 : 0) + (kk.w > kown[i] ? 1 : 0);
            }
#pragma unroll
            for (int i = 0; i < 8; ++i) { if (kown[i] != 0u && rank[i] < 16) bits |= (1u << (half * 8 + i)); }
        }
        unsigned w = bits << (16 * (sub & 1));
        w |= __shfl_xor(w, 1);
        if ((sub & 1) == 0) A.sel[((size_t)(b * 2 + hg) * SEQ + qb * 64 + wid * 8 + ql) * 4 + (sub >> 1)] = w;
    }
    __syncthreads();
}
#undef MFMA32C
}
namespace att {
enum { M_FOX = 0, M_WIN = 1, M_SLC = 2, M_CMP = 3 };
#ifndef SLC_TWO_BURST
#define SLC_TWO_BURST 1
#endif
#ifndef NB_FOX
#define NB_FOX 2
#endif
#ifndef NB_SLC
#define NB_SLC 2
#endif
#ifndef NB_WIN
#define NB_WIN 2
#endif
constexpr int KB0 = 0, KBSZ = 8448  , NSL = 5, VB0 = NSL * KBSZ, VBSZ = 8192;
__device__ __forceinline__ int ring_wrap(int x) { return x < 0 ? x + NSL : (x >= NSL ? x - NSL : x); }
constexpr int IMP_OFF = VB0 + NSL * VBSZ;
constexpr int IMP_W = 132;
constexpr int KEY_OFF = IMP_OFF + 8 * 8 * IMP_W * 4;
constexpr int LDS_NEED = KEY_OFF + 8 * 8 * 128 * 4;
typedef short v4i16_t __attribute__((ext_vector_type(4)));
typedef short s16x4 __attribute__((ext_vector_type(4)));

struct P { const bf16_t* Z; const bf16_t* KV; const float* S32; const float* cum; const bf16_t* KC; const bf16_t* VC; unsigned* sel; float* onsa; bf16_t* YS; };

__device__ __forceinline__ s16x4 vtr(LAS const unsigned char* p) { return __builtin_bit_cast(s16x4, __builtin_amdgcn_ds_read_tr16_b64_v4i16((LAS v4i16_t*)p)); }
#define MFMA32(a, b, c) __builtin_amdgcn_mfma_f32_32x32x16_bf16((a), (b), (c), 0, 0, 0)

#define LDS_BAR() asm volatile("s_waitcnt lgkmcnt(0)\n\ts_barrier" ::: "memory")

template <int MODE, int PASS>
__device__ __forceinline__ void attn_steps(LAS unsigned char* lds, f32x16& o0, f32x16& o1, float& m_run, float& lsum, bool& shifted, const float inv_l, const bf16x8 (&qf_in)[4],
                                           const bf16_t* kld, const bf16_t* vld, const float* cumk, const int kp,
                                           const int t_lo, const int nT, const int qb, const int tq, const float cq_in, const unsigned sel0_in, const unsigned sel1_in, const unsigned sel2_in, const unsigned sel3_in,
                                           LAS float* impw, const int tid, const int lane, const int wid) {
    const int r32 = lane & 31, hi = lane >> 5, half = (MODE == M_CMP) ? 0 : (wid >> 2);
    bf16x8 qf[4] = {qf_in[0], qf_in[1], qf_in[2], qf_in[3]}; float cq = cq_in; unsigned sel0 = sel0_in, sel1 = sel1_in, sel2 = sel2_in, sel3 = sel3_in;
    const float NEG_INF = -__builtin_inff();
    const unsigned kst = (unsigned)(wid * 1024 + lane * 16);
    const int vrow = (tid >> 2) & 63, vch = (tid & 3) | ((tid >> 8) << 2);
    const unsigned vst = (unsigned)(1024 * (vrow >> 3) + 512 * (vch >> 2) + 64 * (vrow & 7) + 16 * (vch & 3));
    const unsigned kfb = (unsigned)(hi * 1024 + r32 * 16);
    const unsigned vfb = (unsigned)(256 * hi + 64 * ((lane & 15) >> 2) + 32 * ((lane >> 4) & 1) + 8 * (lane & 3));
    u32x4 kr = {0u, 0u, 0u, 0u}, vr = {0u, 0u, 0u, 0u}; float br = 0.f;
    f32x16 p0, p1; bf16x8 pk00, pk01, pk10, pk11;
#pragma unroll
    for (int r = 0; r < 16; ++r) { p0[r] = 0.f; p1[r] = 0.f; }
    pk00 = (bf16x8){0, 0, 0, 0, 0, 0, 0, 0}; pk01 = pk00; pk10 = pk00; pk11 = pk00;
#define SELBIT(tt) ((((tt) < 64) ? (((tt) < 32) ? sel0 : sel1) : (((tt) < 96) ? sel2 : sel3)) >> ((tt) & 31)) & 1u
#define RSLOT(j) ring_wrap(sk + ((j) - i))
#define KSLOT(j) (lds + KB0 + RSLOT(j) * KBSZ)
#define VSLOT(j) (lds + VB0 + RSLOT(j) * VBSZ)
#define LOAD_KV(jk, jv) do { if ((jk) < nT) { __builtin_amdgcn_global_load_lds((const unsigned*)(kld + (size_t)(t_lo + (jk)) * 64 * kp), (LAS unsigned*)(KSLOT(jk) + wid * 1024), 16, 0, 0); \
            if (MODE == M_FOX) { if (tid < 64) br = cumk[(t_lo + (jk)) * 64 + tid]; } } \
        if (PASS != 0) { if ((jv) < nT) __builtin_amdgcn_global_load_lds((const unsigned*)(vld + (size_t)(t_lo + (jv)) * 64 * kp), (LAS unsigned*)(VSLOT(jv) + wid * 1024), 16, 0, 0); } } while (0)
#define WRITE_KV(jk, jv) do { if (MODE == M_FOX) { if ((jk) < nT) { if (tid < 64) *(LAS float*)(KSLOT(jk) + 8192 + tid * 4) = br; } } \
        asm volatile("s_waitcnt vmcnt(0)" ::: "memory"); } while (0)

#define SOFTMAX_SEG(j) do { const int t = t_lo + (j); bool mine = true, act = true; if (MODE == M_SLC) { mine = SELBIT(t); act = __any(mine); } \
    if (act) { \
        if (MODE != M_FOX && shifted) { _Pragma("unroll") for (int r = 0; r < 16; ++r) { p0[r] -= m_run; p1[r] -= m_run; } } \
        const int kv0 = t * 64 + 4 * hi; \
        if (MODE == M_FOX) { if (t >= 4 * qb) { _Pragma("unroll") for (int r = 0; r < 16; ++r) { const int kv = kv0 + (r & 3) + 8 * (r >> 2); if (kv > tq) p0[r] = NEG_INF; if (kv + 32 > tq) p1[r] = NEG_INF; } } } \
        else if (MODE == M_WIN) { if (t == qb || t == qb - 8) { _Pragma("unroll") for (int r = 0; r < 16; ++r) { const int kv = kv0 + (r & 3) + 8 * (r >> 2); if (kv > tq || kv <= tq - 512) p0[r] = NEG_INF; if (kv + 32 > tq || kv + 32 <= tq - 512) p1[r] = NEG_INF; } } } \
        else if (MODE == M_SLC) { if (t == qb) { _Pragma("unroll") for (int r = 0; r < 16; ++r) { const int kv = kv0 + (r & 3) + 8 * (r >> 2); if (kv > tq) p0[r] = NEG_INF; if (kv + 32 > tq) p1[r] = NEG_INF; } } }     \
        else { _Pragma("unroll") for (int r = 0; r < 16; ++r) { const int c = kv0 + (r & 3) + 8 * (r >> 2); if (16 * c + 31 > tq) p0[r] = NEG_INF; if (16 * (c + 32) + 31 > tq) p1[r] = NEG_INF; } } \
        _Pragma("unroll") for (int r = 0; r < 16; ++r) { p0[r] = __builtin_amdgcn_exp2f(p0[r]); p1[r] = __builtin_amdgcn_exp2f(p1[r]); } \
        if (PASS != 1) { \
            float mxa = fmaxf(p0[0], p1[0]), mxb = fmaxf(p0[1], p1[1]), mxc = fmaxf(p0[2], p1[2]), mxd = fmaxf(p0[3], p1[3]);     \
            _Pragma("unroll") for (int r = 4; r < 16; r += 4) { mxa = fmaxf(mxa, fmaxf(p0[r], p1[r])); mxb = fmaxf(mxb, fmaxf(p0[r + 1], p1[r + 1])); mxc = fmaxf(mxc, fmaxf(p0[r + 2], p1[r + 2])); mxd = fmaxf(mxd, fmaxf(p0[r + 3], p1[r + 3])); } \
            float mx = fmaxf(fmaxf(mxa, mxb), fmaxf(mxc, mxd)); \
            { const auto rr = __builtin_amdgcn_permlane32_swap(__float_as_uint(mx), __float_as_uint(mx), false, false); mx = fmaxf(__uint_as_float(rr[0]), __uint_as_float(rr[1])); } \
            if (__any(mx > 256.f)) {     \
                const float dl = mx > 1.f ? __builtin_amdgcn_logf(mx) : 0.f; const float scl = __builtin_amdgcn_exp2f(-dl); \
                m_run += dl; shifted = true; lsum *= scl; \
                _Pragma("unroll") for (int r = 0; r < 16; ++r) { p0[r] *= scl; p1[r] *= scl; } \
                if (PASS == 2) { _Pragma("unroll") for (int r = 0; r < 16; ++r) { o0[r] *= scl; o1[r] *= scl; } } \
            } \
            float lsa = 0.f, lsb = 0.f, lsc = 0.f, lsd = 0.f;     \
            _Pragma("unroll") for (int r = 0; r < 16; r += 4) { lsa += p0[r] + p1[r]; lsb += p0[r + 1] + p1[r + 1]; lsc += p0[r + 2] + p1[r + 2]; lsd += p0[r + 3] + p1[r + 3]; } \
            lsum += (lsa + lsb) + (lsc + lsd); \
        } \
        if (PASS != 0) { \
            if (PASS == 1) { _Pragma("unroll") for (int r = 0; r < 16; ++r) { p0[r] *= inv_l; p1[r] *= inv_l; } } \
            u32x4 w; \
            w.x = cvtpk(p0[0], p0[1]); w.y = cvtpk(p0[2], p0[3]); w.z = cvtpk(p0[4], p0[5]); w.w = cvtpk(p0[6], p0[7]); pk00 = __builtin_bit_cast(bf16x8, w); \
            w.x = cvtpk(p0[8], p0[9]); w.y = cvtpk(p0[10], p0[11]); w.z = cvtpk(p0[12], p0[13]); w.w = cvtpk(p0[14], p0[15]); pk01 = __builtin_bit_cast(bf16x8, w); \
            w.x = cvtpk(p1[0], p1[1]); w.y = cvtpk(p1[2], p1[3]); w.z = cvtpk(p1[4], p1[5]); w.w = cvtpk(p1[6], p1[7]); pk10 = __builtin_bit_cast(bf16x8, w); \
            w.x = cvtpk(p1[8], p1[9]); w.y = cvtpk(p1[10], p1[11]); w.z = cvtpk(p1[12], p1[13]); w.w = cvtpk(p1[14], p1[15]); pk11 = __builtin_bit_cast(bf16x8, w); \
        } \
    } \
    if (PASS != 0) asm volatile("" : "+v"(pk00), "+v"(pk01), "+v"(pk10), "+v"(pk11)); \
    asm volatile("" : "+v"(lsum)); \
    __builtin_amdgcn_sched_barrier(0); } while (0)

#define KFRAG_LOAD(jqk) do { LAS const unsigned char* kbuf_ = KSLOT(jqk); \
        _Pragma("unroll") for (int ds = 0; ds < 4; ++ds) { kf[2 * ds] = *(LAS const bf16x8*)(kbuf_ + kfb + ds * 2048); kf[2 * ds + 1] = *(LAS const bf16x8*)(kbuf_ + kfb + ds * 2048 + 512); } \
 } while (0)
#define VFRAG_LOAD(jpv) do { LAS const unsigned char* vb = VSLOT(jpv) + vfb; \
        _Pragma("unroll") for (int q4 = 0; q4 < 4; ++q4) { const s16x4 a0_ = vtr(vb + 2048 * q4), a1_ = vtr(vb + 2048 * q4 + 1024), c0_ = vtr(vb + 2048 * q4 + 512), c1_ = vtr(vb + 2048 * q4 + 1536); \
            vf[q4][0] = (bf16x8){a0_[0], a0_[1], a0_[2], a0_[3], a1_[0], a1_[1], a1_[2], a1_[3]}; vf[q4][1] = (bf16x8){c0_[0], c0_[1], c0_[2], c0_[3], c1_[0], c1_[1], c1_[2], c1_[3]}; } } while (0)
#define PV_MFMAS() do { \
        o0 = MFMA32(vf[0][0], pk00, o0); o1 = MFMA32(vf[0][1], pk00, o1); o0 = MFMA32(vf[1][0], pk01, o0); o1 = MFMA32(vf[1][1], pk01, o1); \
        o0 = MFMA32(vf[2][0], pk10, o0); o1 = MFMA32(vf[2][1], pk10, o1); o0 = MFMA32(vf[3][0], pk11, o0); o1 = MFMA32(vf[3][1], pk11, o1); } while (0)
#define MFMA_SEG(jpv, jqk) do { \
    bool doPV = (PASS != 0) && ((jpv) >= 0) && ((jpv) < nT), doQK = (jqk) < nT; \
    if (MODE == M_SLC) { \
        if (doPV) { const bool m1_ = SELBIT(t_lo + (jpv)); doPV = __any(m1_); } if (doQK) { const bool m2_ = SELBIT(t_lo + (jqk)); doQK = __any(m2_); } \
        if (doPV) { bf16x8 vf[4][2]; VFRAG_LOAD(jpv); __builtin_amdgcn_sched_barrier(0); PV_MFMAS(); } \
        __builtin_amdgcn_sched_barrier(0); \
        if (doQK) { bf16x8 kf[8]; KFRAG_LOAD(jqk); \
            const bool mn_ = SELBIT(t_lo + (jqk)); const float cv_ = mn_ ? 0.f : NEG_INF;     \
            _Pragma("unroll") for (int r = 0; r < 16; ++r) { p0[r] = cv_; p1[r] = cv_; } \
            __builtin_amdgcn_sched_barrier(0); \
            _Pragma("unroll") for (int ds = 0; ds < 4; ++ds) { p0 = MFMA32(kf[2 * ds], qf[ds], p0); p1 = MFMA32(kf[2 * ds + 1], qf[ds], p1); } } \
    } else { \
        bf16x8 vf[4][2], kf[8]; f32x4 bc[4]; \
        if (PASS != 0) VFRAG_LOAD(jpv); \
        KFRAG_LOAD(jqk); \
        __builtin_amdgcn_sched_barrier(0); \
        if (doPV) PV_MFMAS(); \
        if (MODE == M_FOX) { __builtin_amdgcn_sched_barrier(0); LAS const float* bs_ = (LAS const float*)(KSLOT(jqk) + 8192);     \
            _Pragma("unroll") for (int g4 = 0; g4 < 4; ++g4) bc[g4] = *(LAS const f32x4*)(bs_ + 8 * g4 + 4 * hi); } \
        if (doQK) { \
            if (MODE == M_FOX) { const float cqm_ = cq - m_run; LAS const float* bs_ = (LAS const float*)(KSLOT(jqk) + 8192); \
                _Pragma("unroll") for (int g4 = 0; g4 < 4; ++g4) _Pragma("unroll") for (int i_ = 0; i_ < 4; ++i_) p0[4 * g4 + i_] = cqm_ - bc[g4][i_]; \
                __builtin_amdgcn_sched_barrier(0); \
                _Pragma("unroll") for (int g4 = 0; g4 < 4; ++g4) bc[g4] = *(LAS const f32x4*)(bs_ + 32 + 8 * g4 + 4 * hi); \
                _Pragma("unroll") for (int ds = 0; ds < 4; ++ds) p0 = MFMA32(kf[2 * ds], qf[ds], p0); \
                __builtin_amdgcn_sched_barrier(0); \
                _Pragma("unroll") for (int g4 = 0; g4 < 4; ++g4) _Pragma("unroll") for (int i_ = 0; i_ < 4; ++i_) p1[4 * g4 + i_] = cqm_ - bc[g4][i_]; \
                _Pragma("unroll") for (int ds = 0; ds < 4; ++ds) p1 = MFMA32(kf[2 * ds + 1], qf[ds], p1); \
            } else { \
                _Pragma("unroll") for (int r = 0; r < 16; ++r) { p0[r] = 0.f; p1[r] = 0.f; } \
                _Pragma("unroll") for (int ds = 0; ds < 4; ++ds) { p0 = MFMA32(kf[2 * ds], qf[ds], p0); p1 = MFMA32(kf[2 * ds + 1], qf[ds], p1); } } } \
    } \
    __builtin_amdgcn_sched_barrier(0); } while (0)
    bf16x8 ov00 = pk00, ov01 = pk00, ov10 = pk00, ov11 = pk00;
    if (MODE == M_CMP && PASS == 1) {
#pragma unroll
        for (int j = 0; j < 8; ++j) { const int cb = 8 * (j >> 2) + 4 * hi + (j & 3) - 4 * r32;
            ov00[j] = (cb >= -1 && cb <= 3) ? (short)0x3F80 : (short)0; ov01[j] = (cb + 16 >= -1 && cb + 16 <= 3) ? (short)0x3F80 : (short)0;
            ov10[j] = (cb + 32 >= -1 && cb + 32 <= 3) ? (short)0x3F80 : (short)0; ov11[j] = (cb + 48 >= -1 && cb + 48 <= 3) ? (short)0x3F80 : (short)0; }
        asm volatile("" : "+v"(ov00), "+v"(ov01), "+v"(ov10), "+v"(ov11));
    }

    constexpr int NB = (MODE == M_FOX) ? NB_FOX : (MODE == M_SLC) ? NB_SLC : NB_WIN;
    int sk = 0;
    { const int i = 0;
      float brp[NB + 1];
#pragma unroll
      for (int j = 0; j <= NB; ++j) { brp[j] = 0.f; LOAD_KV(j, (j < NB ? j : nT)); brp[j] = br; }
      if (MODE == M_FOX) { if (tid < 64) {
#pragma unroll
          for (int j = 0; j <= NB; ++j) if (j < nT) *(LAS float*)(KSLOT(j) + 8192 + tid * 4) = brp[j]; } }
      asm volatile("" : "+v"(qf[0]), "+v"(qf[1]), "+v"(qf[2]), "+v"(qf[3]));
      asm volatile("" : "+v"(cq), "+v"(sel0), "+v"(sel1), "+v"(sel2), "+v"(sel3));
      asm volatile("s_waitcnt vmcnt(0)" ::: "memory"); }
    LDS_BAR();
#define END_STEP(i) do { if (MODE == M_FOX) { if ((i) + NB + 1 < nT) { if (tid < 64) *(LAS float*)(KSLOT((i) + NB + 1) + 8192 + tid * 4) = br; } } \
        if (((i) + 1) % NB == 0) { asm volatile("s_waitcnt vmcnt(0)" ::: "memory"); LDS_BAR(); } } while (0)
    if (half == 0) {
#pragma unroll 1
        for (int i = 0; i <= nT; ++i) {
            LOAD_KV(i + NB + 1, i + NB);
            MFMA_SEG(i - 1, i);
            if (i < nT) SOFTMAX_SEG(i);
            END_STEP(i);
            sk = (sk + 1 == NSL) ? 0 : sk + 1;
        }
    } else {
        { const int i = 0; MFMA_SEG(-1, 0); }
#pragma unroll 1
        for (int i = 0; i <= nT; ++i) {
            LOAD_KV(i + NB + 1, i + NB);
            if (i < nT) { SOFTMAX_SEG(i); MFMA_SEG(i, i + 1); }
            END_STEP(i);
            sk = (sk + 1 == NSL) ? 0 : sk + 1;
        }
    }
    if ((nT + 1) % NB != 0) { asm volatile("s_waitcnt vmcnt(0)" ::: "memory"); LDS_BAR(); }
#undef END_STEP
#undef SELBIT
#undef KSLOT
#undef RSLOT
#undef VSLOT
#undef LOAD_KV
#undef WRITE_KV
#undef SOFTMAX_SEG
#undef MFMA_SEG
#undef KFRAG_LOAD
#undef VFRAG_LOAD
#undef PV_MFMAS
#undef VFRAG_LOAD
#undef PV_MFMAS
#undef BIAS_LOAD
}

template <int MODE>
__device__ __forceinline__ void attn_unit(LAS unsigned char* lds, const P& A, const int b, const int hg, const int qb) {
    const int tid = opaque_tid(), lane = tid & 63, wid = __builtin_amdgcn_readfirstlane(tid >> 6), r32 = lane & 31, hi = lane >> 5;
    int tq, qcol, hh = 0;
    if (MODE == M_FOX) { tq = qb * 256 + wid * 32 + r32; qcol = ZC_FOX + hg * 64; }
    else { hh = r32 >> 3; tq = qb * 64 + wid * 8 + (r32 & 7); qcol = ZC_QN + (hg * 4 + hh) * 64; }
    const size_t tokrow = (size_t)b * SEQ + tq;
    bf16x8 qf[4];
    { const bf16_t* qp = A.Z + tokrow * ZP + qcol + hi * 8;
#pragma unroll
      for (int ds = 0; ds < 4; ++ds) qf[ds] = *(const bf16x8*)(qp + ds * 16); }
    const bf16_t *Kg, *Vg; int kp, t_lo, t_hi;
    const float* cumk = nullptr; float cq = 0.f;
    if (MODE == M_FOX) { cumk = A.cum + (size_t)(b * 8 + hg) * SEQ; cq = cumk[tq]; }
    const bf16_t* KVb = A.KV + (size_t)b * NSTREAM * SEQ * 64;
    if (MODE == M_FOX) { Kg = KVb + (size_t)(12 + hg) * SEQ * 64; Vg = KVb + (size_t)(20 + hg) * SEQ * 64; kp = 64; t_lo = 0; t_hi = 4 * qb + 3; }
    else if (MODE == M_WIN) { Kg = KVb + (size_t)(8 + hg) * SEQ * 64; Vg = KVb + (size_t)(10 + hg) * SEQ * 64; kp = 64; t_lo = qb > 8 ? qb - 8 : 0; t_hi = qb; }
    else if (MODE == M_SLC) { Kg = KVb + (size_t)(4 + hg) * SEQ * 64; Vg = KVb + (size_t)(6 + hg) * SEQ * 64; kp = 64; t_lo = 0; t_hi = qb; }
    else { Kg = A.KC + (size_t)(b * 2 + hg) * 512 * 64; Vg = A.VC + (size_t)(b * 2 + hg) * 512 * 64; kp = 64; t_lo = 0; t_hi = (4 * qb + 2) >> 6; if (t_hi > 7) t_hi = 7; }
    int nT = t_hi - t_lo + 1;
    if (MODE == M_FOX) {
        float qs = 0.f;
#pragma unroll
        for (int ds = 0; ds < 4; ++ds)
#pragma unroll
            for (int jj = 0; jj < 8; ++jj) { const float v = __uint_as_float((unsigned)(unsigned short)qf[ds][jj] << 16); qs += v * v; }
        { const auto rr = __builtin_amdgcn_permlane32_swap(__float_as_uint(qs), __float_as_uint(qs), false, false); qs = __uint_as_float(rr[0]) + __uint_as_float(rr[1]); }
#pragma unroll
        for (int o = 1; o < 32; o <<= 1) qs = fmaxf(qs, __shfl_xor(qs, o));
        LAS float* red = (LAS float*)(lds + IMP_OFF);
        if (lane == 0) red[wid] = qs;
        __syncthreads();
        float qn2 = red[0];
#pragma unroll
        for (int w = 1; w < 8; ++w) qn2 = fmaxf(qn2, red[w]);
        const float kmax = (A.cum + 131072)[64 * (b * 8 + hg)];
        const float bound = cumk[qb * 256] + 2.f * sqrtf(qn2) * kmax + 40.f;
        const bool needed = (tid < nT) && (cumk[tid * 64 + 63] < bound);
        const int wc_ = __popcll(__ballot(needed));
        __syncthreads();
        if (lane == 0) ((LAS int*)red)[wid] = wc_;
        __syncthreads();
        int cnt = 0;
#pragma unroll
        for (int w = 0; w < 8; ++w) cnt += ((LAS const int*)red)[w];
        t_lo = nT - cnt; nT = cnt;
        __syncthreads();
    }
    const bf16_t* kld = Kg + (size_t)lane * kp + wid * 8;
    const int vrow = wid * 8 + ((lane >> 2) & 7), vch = ((lane >> 5) << 2) | (lane & 3);
    const bf16_t* vld = Vg + (size_t)vrow * kp + vch * 8;
    unsigned sel0 = 0u, sel1 = 0u, sel2 = 0u, sel3 = 0u;
    if (MODE == M_SLC) { const u32x4 s4 = *(const u32x4*)(A.sel + ((size_t)(b * 2 + hg) * SEQ + tq) * 4); sel0 = s4.x; sel1 = s4.y; sel2 = s4.z; sel3 = s4.w; }

    f32x16 o0, o1;
#pragma unroll
    for (int r = 0; r < 16; ++r) { o0[r] = 0.f; o1[r] = 0.f; }
    float m_run = 0.f, lsum = 0.f; bool shifted = false;
    LAS float* impw = (LAS float*)(lds + IMP_OFF) + wid * 8 * IMP_W;
    float sc;
    if (MODE == M_CMP) {
        for (int i = lane; i < 8 * IMP_W; i += 64) impw[i] = 0.f;
        attn_steps<MODE, 0>(lds, o0, o1, m_run, lsum, shifted, 0.f, qf, kld, vld, cumk, kp, t_lo, nT, qb, tq, cq, sel0, sel1, sel2, sel3, impw, tid, lane, wid);
        float inv_l;
        { const auto rr = __builtin_amdgcn_permlane32_swap(__float_as_uint(lsum), __float_as_uint(lsum), false, false); const float lt = __uint_as_float(rr[0]) + __uint_as_float(rr[1]); inv_l = lt > 0.f ? 1.f / lt : 0.f; }
        attn_steps<MODE, 1>(lds, o0, o1, m_run, lsum, shifted, inv_l, qf, kld, vld, cumk, kp, t_lo, nT, qb, tq, cq, sel0, sel1, sel2, sel3, impw, tid, lane, wid);
        sc = 1.f;
    } else {
        attn_steps<MODE, 2>(lds, o0, o1, m_run, lsum, shifted, 0.f, qf, kld, vld, cumk, kp, t_lo, nT, qb, tq, cq, sel0, sel1, sel2, sel3, impw, tid, lane, wid);
        const auto rr = __builtin_amdgcn_permlane32_swap(__float_as_uint(lsum), __float_as_uint(lsum), false, false); const float lt = __uint_as_float(rr[0]) + __uint_as_float(rr[1]);
        sc = lt > 0.f ? 1.f / lt : 0.f;
    }
    if (MODE == M_FOX) {
        bf16_t* op = A.YS + tokrow * 1536 + 1024 + hg * 64 + 4 * hi;
#pragma unroll
        for (int g4 = 0; g4 < 4; ++g4) {
            u32x2 w; w.x = cvtpk(o0[4 * g4] * sc, o0[4 * g4 + 1] * sc); w.y = cvtpk(o0[4 * g4 + 2] * sc, o0[4 * g4 + 3] * sc); *(u32x2*)(op + 8 * g4) = w;
            w.x = cvtpk(o1[4 * g4] * sc, o1[4 * g4 + 1] * sc); w.y = cvtpk(o1[4 * g4 + 2] * sc, o1[4 * g4 + 3] * sc); *(u32x2*)(op + 32 + 8 * g4) = w;
        }
    } else {
        const int br = (MODE == M_CMP) ? 0 : (MODE == M_SLC) ? 1 : 2;
        const float gsc = sc * A.S32[tokrow * 32 + (hg * 4 + hh) * 3 + br];
        bf16_t* np = (bf16_t*)A.onsa + tokrow * 512 + (hg * 4 + hh) * 64 + 4 * hi;
        bf16_t* op = A.YS + tokrow * 1536 + 512 + (hg * 4 + hh) * 64 + 4 * hi;
        u32x2 pa0[4], pa1[4];
        if (MODE != M_CMP) {
#pragma unroll
            for (int g4 = 0; g4 < 4; ++g4) { pa0[g4] = *(const u32x2*)(np + 8 * g4); pa1[g4] = *(const u32x2*)(np + 32 + 8 * g4); }
        }
#pragma unroll
        for (int g4 = 0; g4 < 4; ++g4) {
            f32x4 v0 = {o0[4 * g4] * gsc, o0[4 * g4 + 1] * gsc, o0[4 * g4 + 2] * gsc, o0[4 * g4 + 3] * gsc};
            f32x4 v1 = {o1[4 * g4] * gsc, o1[4 * g4 + 1] * gsc, o1[4 * g4 + 2] * gsc, o1[4 * g4 + 3] * gsc};
            if (MODE != M_CMP) { const u32x2 a0_ = pa0[g4], a1_ = pa1[g4];
                v0[0] += bflo(a0_.x); v0[1] += bfhi(a0_.x); v0[2] += bflo(a0_.y); v0[3] += bfhi(a0_.y); v1[0] += bflo(a1_.x); v1[1] += bfhi(a1_.x); v1[2] += bflo(a1_.y); v1[3] += bfhi(a1_.y); }
            if (MODE != M_WIN) { u32x2 w_; w_.x = cvtpk(v0[0], v0[1]); w_.y = cvtpk(v0[2], v0[3]); *(u32x2*)(np + 8 * g4) = w_; w_.x = cvtpk(v1[0], v1[1]); w_.y = cvtpk(v1[2], v1[3]); *(u32x2*)(np + 32 + 8 * g4) = w_; }
            else { u32x2 w; w.x = cvtpk(v0[0], v0[1]); w.y = cvtpk(v0[2], v0[3]); *(u32x2*)(op + 8 * g4) = w; w.x = cvtpk(v1[0], v1[1]); w.y = cvtpk(v1[2], v1[3]); *(u32x2*)(op + 32 + 8 * g4) = w; }
        }
    }
    if (MODE == M_CMP) {
        const int ql = lane >> 3, sub = lane & 7, cur = qb;
        LAS const float* row = impw + ql * IMP_W;
        LAS unsigned* keys = (LAS unsigned*)(lds + KEY_OFF) + wid * 8 * 128 + ql * 128;
#pragma unroll
        for (int i4 = 0; i4 < 4; ++i4) { u32x4 kq;
#pragma unroll
            for (int i = 0; i < 4; ++i) { const int s = sub * 16 + i4 * 4 + i; float v = row[s]; if (s == 0 || s == cur || s == cur - 1) v = 1e6f;
                kq[i] = (s <= cur) ? (((__float_as_uint(v) & ~0x7Fu) | (unsigned)(127 - s)) | 0x80000000u) : 0u; }
            *(LAS u32x4*)(keys + sub * 16 + i4 * 4) = kq; }
        unsigned bits = 0u;
#pragma unroll 1
        for (int half = 0; half < 2; ++half) {
            unsigned kown[8]; int rank[8];
            { const u32x4 k0 = *(LAS const u32x4*)(keys + sub * 16 + half * 8), k1 = *(LAS const u32x4*)(keys + sub * 16 + half * 8 + 4);
              kown[0] = k0.x; kown[1] = k0.y; kown[2] = k0.z; kown[3] = k0.w; kown[4] = k1.x; kown[5] = k1.y; kown[6] = k1.z; kown[7] = k1.w; }
#pragma unroll
            for (int i = 0; i < 8; ++i) rank[i] = 0;
#pragma unroll 2
            for (int sp4 = 0; sp4 < 32; ++sp4) {
                const u32x4 kk = *(LAS const u32x4*)(keys + sp4 * 4);
#pragma unroll
                for (int i = 0; i < 8; ++i) rank[i] += (kk.x > kown[i] ? 1 : 0) + (kk.y > kown[i] ? 1 : 0) + (kk.z > kown[i] ? 1 : 0) + (kk.w > kown[i] ? 1 : 0);
            }
#pragma unroll
            for (int i = 0; i < 8; ++i) { if (kown[i] != 0u && rank[i] < 16) bits |= (1u << (half * 8 + i)); }
        }
        unsigned w = bits << (16 * (sub & 1));
        w |= __shfl_xor(w, 1);
        if ((sub & 1) == 0) A.sel[((size_t)(b * 2 + hg) * SEQ + qb * 64 + wid * 8 + ql) * 4 + (sub >> 1)] = w;
    }
    __syncthreads();
}
#undef MFMA32
}
struct Frame {
    LAS unsigned char* lds;
    int tid, lane, wave, G, bid;
    unsigned char* ws;
};
#define WSP(T, off) ((T*)(F.ws + (off)))

__device__ __forceinline__ int maprow(int mode, int n) {
    if (mode == 0) return n;
    if (mode == 1) {
        if (n < 512) return -1;
        if (n < 1792) return n;
        if (n < 1816) return 6400 + (n - 1792);
        if (n < 3352) return n - 24;
        if (n < 3360) return 6424 + (n - 3352);
        return n - 32;
    }
    return n < 1024 ? ((n >> 7) * 256 + (n & 127)) : (((n - 1024) >> 7) * 256 + 128 + (n & 127));
}
__device__ __forceinline__ void transpose_item(const float* W, int N, bf16_t* WT, int ld, LAS float* scr, int kb, int nb, int lane, int mode) {
    const int k0 = 64 * kb, n0 = 32 * nb;
    { float t[32];
#pragma unroll
      for (int i = 0; i < 32; ++i) { const int kk = 2 * i + (lane >> 5); t[i] = W[(size_t)(k0 + kk) * N + n0 + (lane & 31)]; }
#pragma unroll
      for (int i = 0; i < 32; ++i) { const int kk = 2 * i + (lane >> 5); scr[kk * 33 + (lane & 31)] = t[i]; } }
    asm volatile("s_waitcnt lgkmcnt(0)" ::: "memory");
    const int c = lane & 7;
#pragma unroll
    for (int j = 0; j < 4; ++j) { const int n = (lane >> 3) + 8 * j; const LAS float* s = scr + (8 * c) * 33 + n;
        u32x4 o; o.x = cvtpk(s[0 * 33], s[1 * 33]); o.y = cvtpk(s[2 * 33], s[3 * 33]); o.z = cvtpk(s[4 * 33], s[5 * 33]); o.w = cvtpk(s[6 * 33], s[7 * 33]);
        const int dr = maprow(mode, n0 + n);
        if (dr >= 0) *(u32x4*)(WT + (size_t)dr * ld + k0 + 8 * c) = o; }
    asm volatile("s_waitcnt lgkmcnt(0)" ::: "memory");
}
__device__ __forceinline__ void t64_load(const float* W, int N, int kb, int nb, int lane, f32x4 (&v)[16]) {
    const int k0 = 64 * kb, n0 = 64 * nb, kr = lane >> 4, c4 = lane & 15;
#pragma unroll
    for (int i = 0; i < 16; ++i) v[i] = *(const f32x4*)(W + (size_t)(k0 + 4 * i + kr) * N + n0 + 4 * c4);
}
__device__ __forceinline__ void t64_store(bf16_t* WT, int ld, LAS float* scr, int kb, int nb, int lane, int mode, const f32x4 (&v)[16]) {
    const int k0 = 64 * kb, n0 = 64 * nb, kr = lane >> 4, c4 = lane & 15;
#pragma unroll
    for (int i = 0; i < 16; ++i) { LAS float* d = scr + (4 * i + kr) * 65 + 4 * c4; d[0] = v[i][0]; d[1] = v[i][1]; d[2] = v[i][2]; d[3] = v[i][3]; }
    asm volatile("s_waitcnt lgkmcnt(0)" ::: "memory");
    const int c = lane & 7;
#pragma unroll
    for (int j = 0; j < 8; ++j) { const int n = (lane >> 3) + 8 * j; const LAS float* s = scr + (8 * c) * 65 + n;
        u32x4 o; o.x = cvtpk(s[0 * 65], s[1 * 65]); o.y = cvtpk(s[2 * 65], s[3 * 65]); o.z = cvtpk(s[4 * 65], s[5 * 65]); o.w = cvtpk(s[6 * 65], s[7 * 65]);
        const int dr = maprow(mode, n0 + n);
        *(u32x4*)(WT + (size_t)dr * ld + k0 + 8 * c) = o; }
    asm volatile("s_waitcnt lgkmcnt(0)" ::: "memory");
}
__device__ __forceinline__ void transpose_item64(const float* W, int N, bf16_t* WT, int ld, LAS float* scr, int kb, int nb, int lane, int mode) {
    f32x4 v[16];
    t64_load(W, N, kb, nb, lane, v);
    t64_store(WT, ld, scr, kb, nb, lane, mode, v);
}
constexpr int I_IN = 16 * 201, I_UP = 3 * 8 * 16, I_O = 16 * 16, I_C1 = 2 * 32 * 4, I_M1 = 32 * 16 * 32, I_M2 = 32 * 16 * 16, I_L = I_IN + I_UP + I_O + I_C1 + I_M1 + I_M2;
constexpr int CV_A1 = I_UP + I_O, CV_A2 = CV_A1 + I_M1 + I_M2, CV_ND = CV_A2 + I_L;
constexpr int CV_UNIT = 64, CV_NUNITS = (CV_ND + CV_UNIT - 1) / CV_UNIT;
__device__ __forceinline__ void weight_item(Frame& F0, ArgsP a, LAS float* scr, int l, int r) {
    Frame F = F0; asm volatile("" : "+v"(F.lane));

    if (r < I_IN) { const int kb = r / 201, nb = r % 201; if (nb >= 16) transpose_item(a->in[1] + (size_t)l * DM * INW, INW, WSP(bf16_t, WS_WIN + l * WIN_L), DM, scr, kb, nb, F.lane, 1); return; } r -= I_IN;
    if (r < I_UP) { const int nbr = r >> 7, rr = r & 127; transpose_item64(a->in[11] + ((size_t)l * 3 + nbr) * 512 * 1024, 1024, WSP(bf16_t, WS_WUP + l * WUP_L) + (size_t)nbr * 1024 * 512, 512, scr, rr >> 4, rr & 15, F.lane, 0); return; } r -= I_UP;
    if (r < I_O) { transpose_item64(a->in[12] + (size_t)l * DM * DM, DM, WSP(bf16_t, WS_WO + l * WO_L), DM, scr, r >> 4, r & 15, F.lane, 0); return; } r -= I_O;
    if (r < I_C1) { const int kv = r >> 7, rr = r & 127; transpose_item64(a->in[7] + (size_t)(l * 2 + kv) * 2048 * 256, 256, WSP(bf16_t, WS_WC1 + l * WC1_L) + (size_t)kv * 256 * 2048, 2048, scr, rr >> 2, rr & 3, F.lane, 0); return; } r -= I_C1;
    if (r < I_M1) { const int e = r >> 9, rr = r & 511; transpose_item64(a->in[17] + ((size_t)l * NEXP + e) * DM * 2048, 2048, WSP(bf16_t, WS_WM1 + l * WM1_L) + (size_t)e * 2048 * DM, DM, scr, rr >> 5, rr & 31, F.lane, 2); return; } r -= I_M1;
    { const int e = r >> 8, rr = r & 255; transpose_item64(a->in[19] + ((size_t)l * NEXP + e) * DM * DM, DM, WSP(bf16_t, WS_WM2 + l * WM2_L) + (size_t)e * DM * DM, DM, scr, rr >> 4, rr & 15, F.lane, 0); }
}
struct ItemP { const float* W; bf16_t* WT; int N, ld, kb, nb, mode, kind; };
__device__ __forceinline__ ItemP item_params(const Frame& F, ArgsP a, int l, int r) {
    ItemP p; p.kind = 0; p.mode = 0;
    if (r < I_IN) { p.kb = r / 201; p.nb = r % 201; p.W = a->in[1] + (size_t)l * DM * INW; p.N = INW; p.WT = WSP(bf16_t, WS_WIN + l * WIN_L); p.ld = DM; p.mode = 1; p.kind = p.nb >= 16 ? 1 : 2; return p; } r -= I_IN;
    if (r < I_UP) { const int nbr = r >> 7, rr = r & 127; p.W = a->in[11] + ((size_t)l * 3 + nbr) * 512 * 1024; p.N = 1024; p.WT = WSP(bf16_t, WS_WUP + l * WUP_L) + (size_t)nbr * 1024 * 512; p.ld = 512; p.kb = rr >> 4; p.nb = rr & 15; return p; } r -= I_UP;
    if (r < I_O) { p.W = a->in[12] + (size_t)l * DM * DM; p.N = DM; p.WT = WSP(bf16_t, WS_WO + l * WO_L); p.ld = DM; p.kb = r >> 4; p.nb = r & 15; return p; } r -= I_O;
    if (r < I_C1) { const int kv = r >> 7, rr = r & 127; p.W = a->in[7] + (size_t)(l * 2 + kv) * 2048 * 256; p.N = 256; p.WT = WSP(bf16_t, WS_WC1 + l * WC1_L) + (size_t)kv * 256 * 2048; p.ld = 2048; p.kb = rr >> 2; p.nb = rr & 3; return p; } r -= I_C1;
    if (r < I_M1) { const int e = r >> 9, rr = r & 511; p.W = a->in[17] + ((size_t)l * NEXP + e) * DM * 2048; p.N = 2048; p.WT = WSP(bf16_t, WS_WM1 + l * WM1_L) + (size_t)e * 2048 * DM; p.ld = DM; p.kb = rr >> 5; p.nb = rr & 31; p.mode = 2; return p; } r -= I_M1;
    { const int e = r >> 8, rr = r & 255; p.W = a->in[19] + ((size_t)l * NEXP + e) * DM * DM; p.N = DM; p.WT = WSP(bf16_t, WS_WM2 + l * WM2_L) + (size_t)e * DM * DM; p.ld = DM; p.kb = rr >> 4; p.nb = rr & 15; }
    return p;
}
__device__ __forceinline__ ItemP conv_item(const Frame& F, ArgsP a, int d) {
    if (d < CV_A1) return item_params(F, a, 0, I_IN + d);
    if (d < CV_A2) return item_params(F, a, 0, I_IN + I_UP + I_O + I_C1 + (d - CV_A1));
    return item_params(F, a, 1, d - CV_A2);
}
__device__ __forceinline__ void conv_unit(Frame& F0, ArgsP a, int cu) {
    Frame F = F0; asm volatile("" : "+v"(F.lane));
    LAS float* scr = (LAS float*)(F.lds + F.wave * 16640);
    int d = cu * CV_UNIT + F.wave;
    ItemP cur; cur.kind = 2; f32x4 v[16];
    if (d < CV_ND) { cur = conv_item(F, a, d); if (cur.kind == 0) t64_load(cur.W, cur.N, cur.kb, cur.nb, F.lane, v); }
#pragma unroll 1
    for (int i = 0; i < CV_UNIT / NWAVES; ++i) {
        const int dn = d + NWAVES;
        ItemP nx; nx.kind = 2; f32x4 vn[16];
        if (i + 1 < CV_UNIT / NWAVES && dn < CV_ND) { nx = conv_item(F, a, dn); if (nx.kind == 0) t64_load(nx.W, nx.N, nx.kb, nx.nb, F.lane, vn); }
        if (cur.kind == 0) t64_store(cur.WT, cur.ld, scr, cur.kb, cur.nb, F.lane, cur.mode, v);
        else if (cur.kind == 1) transpose_item(cur.W, cur.N, cur.WT, cur.ld, scr, cur.kb, cur.nb, F.lane, cur.mode);
        cur = nx; d = dn;
#pragma unroll
        for (int k = 0; k < 16; ++k) v[k] = vn[k];
    }
}
__device__ __forceinline__ void p0_phase(Frame& F, ArgsP a, const int jobs = 31) {
    if (jobs & 1) for (int task = F.bid; task < 128; task += F.G) {
        const int l = task >> 6, kv = (task >> 5) & 1, nblk = (task >> 3) & 3, sl = task & 7, n = nblk * 64 + F.lane;
        const float* pos = a->in[6] + (size_t)(l * 2 + kv) * 2048; const float* w1 = a->in[7] + (size_t)(l * 2 + kv) * 2048 * 256;
        float s = 0.f;
#pragma unroll 8
        for (int i = 0; i < 32; ++i) { const int jd = sl * 256 + F.wave * 32 + i; s += pos[jd] * w1[(size_t)jd * 256 + n]; }
        LAS float* red = (LAS float*)F.lds;
        red[F.wave * 64 + F.lane] = s;
        __syncthreads();
        if (F.wave == 0) { float t = 0.f;
            for (int w = 0; w < 8; ++w) t += red[w * 64 + F.lane];
            WSP(float, WS_BIAS)[l * 16384 + 6656 + (kv * 8 + sl) * 256 + n] = t; }
        __syncthreads();
    }
    LAS float* scr = (LAS float*)(F.lds + F.wave * 16640);
    const int gw = F.bid * NWAVES + F.wave, NGW = F.G * NWAVES;
    if (jobs & 2) for (int it = gw; it < I_IN + I_C1; it += NGW) weight_item(F, a, scr, 0, it < I_IN ? it : I_IN + I_UP + I_O + (it - I_IN));
    const int gt = F.bid * NTHREADS + F.tid, NGT = F.G * NTHREADS;
    if (jobs & 4) {
        __syncthreads();
        LAS float* sW = (LAS float*)F.lds;
        LAS float* sP = sW + 64 * 132;
        for (int task = (F.bid + 128) % F.G; task < 2 * 4 * 16; task += F.G) {
            const int l = task >> 6, g = (task >> 4) & 3, k0 = (task & 15) * 64;
            const float* wsrc = a->in[1] + ((size_t)l * DM + k0) * INW + g * 128; const float* psrc = a->in[3] + ((size_t)(l * 4 + g) * 128) * 128;
#pragma unroll
            for (int it = 0; it < 64 * 32 / NTHREADS; ++it) { const int i = F.tid + it * NTHREADS, r = i >> 5, c4 = i & 31; *(LAS f32x4*)(sW + r * 132 + 4 * c4) = *(const f32x4*)(wsrc + (size_t)r * INW + 4 * c4); }
#pragma unroll
            for (int it = 0; it < 128 * 32 / NTHREADS; ++it) { const int i = F.tid + it * NTHREADS, r = i >> 5, c4 = i & 31; *(LAS f32x4*)(sP + r * 132 + 4 * c4) = *(const f32x4*)(psrc + (size_t)r * 128 + 4 * c4); }
            __syncthreads();
            const int kq = F.tid & 15, nq = F.tid >> 4;
            f32x4 acc[4];
#pragma unroll
            for (int r = 0; r < 4; ++r) acc[r] = (f32x4){0.f, 0.f, 0.f, 0.f};
#pragma unroll 4
            for (int c = 0; c < 128; ++c) { const f32x4 pv = *(LAS const f32x4*)(sP + c * 132 + 4 * nq);
#pragma unroll
                for (int r = 0; r < 4; ++r) acc[r] = acc[r] + pv * sW[(4 * kq + r) * 132 + c]; }
            bf16_t* wt = WSP(bf16_t, WS_WIN + l * WIN_L) + (size_t)(g * 128 + 4 * nq) * DM + k0 + 4 * kq;
#pragma unroll
            for (int j = 0; j < 4; ++j) { u32x2 o; o.x = cvtpk(acc[0][j], acc[1][j]); o.y = cvtpk(acc[2][j], acc[3][j]); *(u32x2*)(wt + (size_t)j * DM) = o; }
            __syncthreads();
        }
    }
    if (jobs & 8) for (int idx = (F.G - 1 - F.bid) * NTHREADS + F.tid; idx < 2 * NINP; idx += NGT) {
        const int l = idx / NINP, n = idx - l * NINP; const float* bi = a->in[2] + (size_t)l * INW; float v = 0.f;
        if (n < 512) { const int g = n >> 7; const float* pw = a->in[3] + ((size_t)(l * 4 + g) * 128) * 128 + (n & 127);
#pragma unroll 32
            for (int c = 0; c < 128; ++c) v += bi[g * 128 + c] * pw[(size_t)c * 128]; }
        else if (n < 1792) v = bi[n];
        else if (n < 3328) v = bi[n + 24];
        else if (n < 6400) v = bi[n + 32];
        else if (n < 6424) v = bi[1792 + (n - 6400)];
        else if (n < 6432) v = bi[3352 + (n - 6424)];
        WSP(float, WS_BIAS)[l * 16384 + n] = v;
    }
    for (int idx = gt; idx < 2 * 224 * 128; idx += NGT) { const int l = idx / (224 * 128), r = idx - l * 224 * 128; *(u32x4*)(WSP(bf16_t, WS_WIN + l * WIN_L) + (size_t)6432 * DM + (size_t)r * 8) = (u32x4){0u, 0u, 0u, 0u}; }
    if (jobs & 16) for (int idx0 = gt; idx0 < NTOK * DM / 4; idx0 += 8 * NGT) {
        f32x4 t[8];
#pragma unroll
        for (int k = 0; k < 8; ++k) { const int idx = idx0 + k * NGT; t[k] = ((const f32x4*)a->in[0])[idx < NTOK * DM / 4 ? idx : idx0]; }
#pragma unroll
        for (int k = 0; k < 8; ++k) { const int idx = idx0 + k * NGT; if (idx < NTOK * DM / 4) { u32x2 w; w.x = cvtpk(t[k][0], t[k][1]); w.y = cvtpk(t[k][2], t[k][3]); ((u32x2*)WSP(bf16_t, WS_XB))[idx] = w; } }
    }
}

__device__ __forceinline__ void prep_thin(Frame& F, ArgsP a, int l) {
    if (F.bid < 128 || F.G <= 128) return;
    const int j = F.bid - 128, GJ = F.G - 128;
    LAS float* red = (LAS float*)F.lds;
    for (int seq = j; seq < 16; seq += GJ) {
        const int b = seq >> 3, h = seq & 7;
        const float* src = WSP(float, WS_S32) + ((size_t)b * SEQ + F.tid * 16) * 32 + 24 + h;
        float v[16]; float s = 0.f;
#pragma unroll
        for (int i = 0; i < 16; ++i) { v[i] = src[(size_t)i * 32]; }
#pragma unroll
        for (int i = 0; i < 16; ++i) { s += v[i]; v[i] = s; }
        float incl = s;
#pragma unroll
        for (int o = 1; o < 64; o <<= 1) { const float t = __shfl_up(incl, o); if (F.lane >= o) incl += t; }
        if (F.lane == 63) red[F.wave] = incl;
        __syncthreads();
        float base = incl - s;
        for (int w = 0; w < F.wave; ++w) base += red[w];
        float* dst = WSP(float, WS_CUM) + (size_t)seq * SEQ + F.tid * 16;
#pragma unroll
        for (int i4 = 0; i4 < 4; ++i4) *(f32x4*)(dst + 4 * i4) = (f32x4){(base + v[4 * i4]) * LOG2E, (base + v[4 * i4 + 1]) * LOG2E, (base + v[4 * i4 + 2]) * LOG2E, (base + v[4 * i4 + 3]) * LOG2E};
        __syncthreads();
    }
    {
        unsigned* KMAXU = (unsigned*)(WSP(float, WS_CUM) + 131072);
        const int b0 = (int)(((long)j * 2048) / GJ), b1 = (int)(((long)(j + 1) * 2048) / GJ);
        float mxs = 0.f; int curbh = b0 >> 7;
        for (int blk = b0; blk <= b1; ++blk) {
            const int bh = blk >> 7;
            if (blk == b1 || bh != curbh) {
                float m = mxs;
#pragma unroll
                for (int o = 1; o < 64; o <<= 1) m = fmaxf(m, __shfl_xor(m, o));
                if (F.lane == 0) red[F.wave] = m;
                __syncthreads();
                if (F.tid == 0 && blk > b0) { float mm = red[0]; for (int w = 1; w < 8; ++w) mm = fmaxf(mm, red[w]); atomicMax(KMAXU + 64 * curbh, __float_as_uint(sqrtf(mm))); }
                __syncthreads();
                mxs = 0.f; curbh = bh;
                if (blk == b1) break;
            }
            const int row = (blk & 127) * 64 + (F.tid >> 3);
            const int strm_ = (bh >> 3) * NSTREAM + 12 + (bh & 7);
            const bf16_t* kp_ = WSP(bf16_t, WS_KV) + ((size_t)strm_ * SEQ) * 64;
            const u32x4 w = *(const u32x4*)(kp_ + (size_t)row * 64 + (F.tid & 7) * 8);
            float s = bflo(w.x) * bflo(w.x) + bfhi(w.x) * bfhi(w.x) + bflo(w.y) * bflo(w.y) + bfhi(w.y) * bfhi(w.y) + bflo(w.z) * bflo(w.z) + bfhi(w.z) * bfhi(w.z) + bflo(w.w) * bflo(w.w) + bfhi(w.w) * bfhi(w.w);
            s += __shfl_xor(s, 1); s += __shfl_xor(s, 2); s += __shfl_xor(s, 4);
            mxs = fmaxf(mxs, s);
        }
    }
}

template <int WIN> __device__ __forceinline__ void pool_pair(const bf16_t* Z, bf16_t* YS, const float* pb, const float* ps, const int n0, const int n1, const bool two, int c8) {
    u32x4 w[2][WIN];
#pragma unroll
    for (int r = 0; r < 2; ++r) { const int n = r ? n1 : n0, t = n & (SEQ - 1);
#pragma unroll
        for (int q = 0; q < WIN; ++q) { const int qq = q <= t ? q : 0; w[r][q] = *(const u32x4*)(Z + (size_t)(n - qq) * ZP + c8); } }
    const f32x4 pb0 = *(const f32x4*)(pb + c8), pb1 = *(const f32x4*)(pb + c8 + 4), ps0 = *(const f32x4*)(ps + c8), ps1 = *(const f32x4*)(ps + c8 + 4);
    const float pbv[8] = {pb0[0], pb0[1], pb0[2], pb0[3], pb1[0], pb1[1], pb1[2], pb1[3]}, psv[8] = {ps0[0], ps0[1], ps0[2], ps0[3], ps1[0], ps1[1], ps1[2], ps1[3]};
#pragma unroll
    for (int r = 0; r < 2; ++r) { const int n = r ? n1 : n0, t = n & (SEQ - 1);
        float sum[8], self[8];
#pragma unroll
        for (int i = 0; i < 8; ++i) { sum[i] = 0.f; self[i] = 0.f; }
#pragma unroll
        for (int q = 0; q < WIN; ++q) { const float m = q <= t ? 1.f : 0.f;
            const float v[8] = {bflo(w[r][q].x), bfhi(w[r][q].x), bflo(w[r][q].y), bfhi(w[r][q].y), bflo(w[r][q].z), bfhi(w[r][q].z), bflo(w[r][q].w), bfhi(w[r][q].w)};
#pragma unroll
            for (int i = 0; i < 8; ++i) { sum[i] += m * v[i]; if (q == 0) self[i] = v[i]; } }
        const int cnt = (t + 1 < WIN) ? t + 1 : WIN; const float ic = 1.f / (float)cnt; float y[8];
#pragma unroll
        for (int i = 0; i < 8; ++i) y[i] = (sum[i] * ic - self[i] + pbv[i]) * psv[i];
        u32x4 o; o.x = cvtpk(y[0], y[1]); o.y = cvtpk(y[2], y[3]); o.z = cvtpk(y[4], y[5]); o.w = cvtpk(y[6], y[7]);
        if (r == 0 || two) *(u32x4*)(YS + (size_t)n * 1536 + c8) = o; }
}
__device__ __forceinline__ void pool_phase(Frame& F, ArgsP a, int l, const int gw, const int NGW) {
    const bf16_t* Z = WSP(bf16_t, WS_Z); bf16_t* YS = WSP(bf16_t, WS_YS);
    const float* pb = a->in[4] + (size_t)l * 512; const float* ps = a->in[5] + (size_t)l * 512;
    for (int g = 0; g < 4; ++g)
        for (int idx = gw; idx < NTOK / 4; idx += 2 * NGW) {
            const bool two = idx + NGW < NTOK / 4;
            const int n0 = idx * 4 + (F.lane >> 4), n1 = (two ? idx + NGW : idx) * 4 + (F.lane >> 4), c8 = g * 128 + (F.lane & 15) * 8;
            if (g == 0) pool_pair<2>(Z, YS, pb, ps, n0, n1, two, c8); else if (g == 1) pool_pair<4>(Z, YS, pb, ps, n0, n1, two, c8);
            else if (g == 2) pool_pair<8>(Z, YS, pb, ps, n0, n1, two, c8); else pool_pair<16>(Z, YS, pb, ps, n0, n1, two, c8);
        }
}

__device__ __forceinline__ void c2_phase(Frame& F, ArgsP a, int l) {
    const int gw = F.bid * NWAVES + F.wave, NGW = F.G * NWAVES;
    LAS float* hb = (LAS float*)F.lds + F.wave * 256;
    const float* PART = WSP(float, WS_MSCR); const float* b1p = WSP(float, WS_BIAS) + l * 16384 + 6656;
    const float* cb1 = a->in[8] + (size_t)l * 512;
    LAS float* w2l = (LAS float*)F.lds + 2048;
    { const f32x4* src = (const f32x4*)(a->in[9] + (size_t)l * 2 * 256 * 64);
      f32x4 t[16];
#pragma unroll
      for (int i = 0; i < 16; ++i) t[i] = src[F.tid + NTHREADS * i];
#pragma unroll
      for (int i = 0; i < 16; ++i) *(LAS f32x4*)(w2l + 4 * (F.tid + NTHREADS * i)) = t[i]; }
    __syncthreads();
    for (int task = gw; task < 4096; task += NGW) {
        const int kv = task >> 11, row = task & 2047;
        f32x4 hs = *(const f32x4*)(cb1 + kv * 256 + 4 * F.lane);
        f32x4 tb[8], tp[8];
#pragma unroll
        for (int sl = 0; sl < 8; ++sl) tb[sl] = *(const f32x4*)(b1p + (kv * 8 + sl) * 256 + 4 * F.lane);
#pragma unroll
        for (int sp = 0; sp < 8; ++sp) tp[sp] = *(const f32x4*)(PART + ((size_t)(sp * 2 + kv) * 2048 + row) * 256 + 4 * F.lane);
        __builtin_amdgcn_sched_barrier(0);
#pragma unroll
        for (int sl = 0; sl < 8; ++sl) hs = hs + tb[sl];
#pragma unroll
        for (int sp = 0; sp < 8; ++sp) hs = hs + tp[sp];
#pragma unroll
        for (int i = 0; i < 4; ++i) hs[i] = gelu_tanhf_(hs[i]);
        *(LAS f32x4*)(hb + 4 * F.lane) = hs;
        LAS const float* w2 = w2l + kv * 256 * 64 + F.lane;
        float s = a->in[10][(l * 2 + kv) * 64 + F.lane];
#pragma unroll 16
        for (int n = 0; n < 256; ++n) s += hb[n] * w2[n * 64];
        if ((row & 511) == 511) s = 0.f;
        WSP(bf16_t, WS_KC)[((size_t)kv * 2048 + row) * 64 + F.lane] = (bf16_t)(cvtpk(s, 0.f) & 0xffffu);
    }
}

constexpr int RW_PITCH = 1028;
__device__ __forceinline__ void ln_router_phase(Frame& F, ArgsP a, int l) {
    LAS float* rwT = (LAS float*)F.lds;
    LAS int* hist = (LAS int*)(F.lds + 32 * RW_PITCH * 4);
    const float* rw = a->in[15] + (size_t)l * DM * NEXP;
    {
        f32x4 t[16];
#pragma unroll
        for (int i = 0; i < 16; ++i) t[i] = ((const f32x4*)rw)[F.tid + NTHREADS * i];
#pragma unroll
        for (int i = 0; i < 16; ++i) { const int q = F.tid + NTHREADS * i, k = q >> 3, e0 = (q & 7) * 4;
            rwT[(e0 + 0) * RW_PITCH + k] = t[i][0]; rwT[(e0 + 1) * RW_PITCH + k] = t[i][1]; rwT[(e0 + 2) * RW_PITCH + k] = t[i][2]; rwT[(e0 + 3) * RW_PITCH + k] = t[i][3]; }
    }
    const float* g1 = a->in[13] + (size_t)l * DM; const float* b1 = a->in[14] + (size_t)l * DM; const float* rb = a->in[16] + (size_t)l * NEXP;
    const bf16_t* V1 = WSP(bf16_t, WS_V1); bf16_t* XB = WSP(bf16_t, WS_XB);
    int* TOPI = (int*)(F.ws + WS_MOE + MOE_TOPI); float* TOPG = (float*)(F.ws + WS_MOE + MOE_TOPG); int* HIST = (int*)(F.ws + WS_MOE + MOE_HIST);
    LAS float* lgbuf = (LAS float*)(F.lds + 32 * RW_PITCH * 4 + 256) + F.wave * 8 * 32;
    f32x4 ggv[4], bbv[4];
#pragma unroll
    for (int j = 0; j < 4; ++j) { ggv[j] = ((const f32x4*)g1)[F.lane + 64 * j]; bbv[j] = ((const f32x4*)b1)[F.lane + 64 * j]; }
    __syncthreads();
    for (int chunk = F.bid; chunk < 256; chunk += F.G) {
        if (F.tid < 32) hist[F.tid] = 0;
        __syncthreads();
        const size_t row0 = (size_t)chunk * 64 + F.wave * 8;
        u32x2 nx[2][4];
#pragma unroll
        for (int rr = 0; rr < 2; ++rr)
#pragma unroll
            for (int j = 0; j < 4; ++j) nx[rr][j] = ((const u32x2*)(V1 + (row0 + rr) * DM))[F.lane + 64 * j];
#pragma unroll 1
        for (int rp = 0; rp < 4; ++rp) {
            f32x4 v[2][4]; float s[2] = {0.f, 0.f};
#pragma unroll
            for (int rr = 0; rr < 2; ++rr)
#pragma unroll
                for (int j = 0; j < 4; ++j) { v[rr][j] = (f32x4){bflo(nx[rr][j].x), bfhi(nx[rr][j].x), bflo(nx[rr][j].y), bfhi(nx[rr][j].y)}; s[rr] += (v[rr][j][0] + v[rr][j][1]) + (v[rr][j][2] + v[rr][j][3]); }
            if (rp < 3) {
#pragma unroll
                for (int rr = 0; rr < 2; ++rr)
#pragma unroll
                    for (int j = 0; j < 4; ++j) nx[rr][j] = ((const u32x2*)(V1 + (row0 + 2 * rp + 2 + rr) * DM))[F.lane + 64 * j];
            }
#pragma unroll
            for (int o = 1; o < 64; o <<= 1) { s[0] += __shfl_xor(s[0], o); s[1] += __shfl_xor(s[1], o); }
            float s2[2] = {0.f, 0.f};
#pragma unroll
            for (int rr = 0; rr < 2; ++rr) { const float mean = s[rr] * (1.f / DM);
#pragma unroll
                for (int j = 0; j < 4; ++j) { v[rr][j] = v[rr][j] - mean; s2[rr] += (v[rr][j][0] * v[rr][j][0] + v[rr][j][1] * v[rr][j][1]) + (v[rr][j][2] * v[rr][j][2] + v[rr][j][3] * v[rr][j][3]); } }
#pragma unroll
            for (int o = 1; o < 64; o <<= 1) { s2[0] += __shfl_xor(s2[0], o); s2[1] += __shfl_xor(s2[1], o); }
#pragma unroll
            for (int rr = 0; rr < 2; ++rr) { const float rstd = 1.f / sqrtf(s2[rr] * (1.f / DM) + LN_EPS); const size_t row = row0 + 2 * rp + rr;
#pragma unroll
                for (int j = 0; j < 4; ++j) { const f32x4 gg = ggv[j], bb = bbv[j]; v[rr][j] = v[rr][j] * rstd * gg + bb;
                    u32x2 w; w.x = cvtpk(v[rr][j][0], v[rr][j][1]); w.y = cvtpk(v[rr][j][2], v[rr][j][3]); ((u32x2*)(XB + row * DM))[F.lane + 64 * j] = w; } }
            float acc[2][32];
            f32x4 wq[2][4];
#define RW_LOAD(buf, e) do { _Pragma("unroll") for (int j = 0; j < 4; ++j) wq[buf][j] = *(LAS const f32x4*)(rwT + (e) * RW_PITCH + 4 * (F.lane + 64 * j)); } while (0)
            f32x2_t vv[4][4];
#pragma unroll
            for (int j = 0; j < 4; ++j)
#pragma unroll
                for (int i = 0; i < 4; ++i) vv[j][i] = (f32x2_t){v[0][j][i], v[1][j][i]};
#define RW_DOT(buf, e) do { f32x2_t ta = {0.f, 0.f}, tb = {0.f, 0.f}; \
                _Pragma("unroll") for (int j = 0; j < 4; ++j) { const f32x4 w = wq[buf][j]; \
                    ta += vv[j][0] * (f32x2_t){w[0], w[0]}; tb += vv[j][1] * (f32x2_t){w[1], w[1]}; ta += vv[j][2] * (f32x2_t){w[2], w[2]}; tb += vv[j][3] * (f32x2_t){w[3], w[3]}; } \
                ta += tb; acc[0][e] = ta[0]; acc[1][e] = ta[1]; } while (0)
            RW_LOAD(0, 0);
#pragma unroll
            for (int e = 0; e < 32; e += 2) {
                RW_LOAD(1, e + 1); __builtin_amdgcn_sched_barrier(0);
                RW_DOT(0, e); __builtin_amdgcn_sched_barrier(0);
                if (e + 2 < 32) RW_LOAD(0, e + 2);
                __builtin_amdgcn_sched_barrier(0);
                RW_DOT(1, e + 1); __builtin_amdgcn_sched_barrier(0);
            }
#undef RW_LOAD
#undef RW_DOT
#define RS_STEP(CNT, BIT) _Pragma("unroll") for (int i = 0; i < CNT; ++i) { const bool up = (F.lane & BIT) != 0; \
                const float send0 = up ? acc[0][i] : acc[0][i + CNT], keep0 = up ? acc[0][i + CNT] : acc[0][i]; const float send1 = up ? acc[1][i] : acc[1][i + CNT], keep1 = up ? acc[1][i + CNT] : acc[1][i]; \
                acc[0][i] = keep0 + __shfl_xor(send0, BIT); acc[1][i] = keep1 + __shfl_xor(send1, BIT); }
            RS_STEP(16, 32) RS_STEP(8, 16) RS_STEP(4, 8) RS_STEP(2, 4) RS_STEP(1, 2)
#undef RS_STEP
            const float rbe = rb[F.lane >> 1];
            const float l0 = acc[0][0] + __shfl_xor(acc[0][0], 1) + rbe, l1 = acc[1][0] + __shfl_xor(acc[1][0], 1) + rbe;
            if ((F.lane & 1) == 0) { lgbuf[(2 * rp + 0) * 32 + (F.lane >> 1)] = l0; lgbuf[(2 * rp + 1) * 32 + (F.lane >> 1)] = l1; }
        }
        {
            const int e = F.lane >> 1;
            float lg[8], tv[8][4]; int ti[8][4];
#pragma unroll
            for (int r = 0; r < 8; ++r) lg[r] = lgbuf[r * 32 + e];
#pragma unroll
            for (int k = 0; k < 4; ++k) {
                float mx[8]; int cand[8];
#pragma unroll
                for (int r = 0; r < 8; ++r) mx[r] = lg[r];
#pragma unroll
                for (int o = 1; o < 64; o <<= 1)
#pragma unroll
                    for (int r = 0; r < 8; ++r) mx[r] = fmaxf(mx[r], __shfl_xor(mx[r], o));
#pragma unroll
                for (int r = 0; r < 8; ++r) cand[r] = (lg[r] == mx[r]) ? e : 99;
#pragma unroll
                for (int o = 1; o < 64; o <<= 1)
#pragma unroll
                    for (int r = 0; r < 8; ++r) { const int t = __shfl_xor(cand[r], o); cand[r] = t < cand[r] ? t : cand[r]; }
#pragma unroll
                for (int r = 0; r < 8; ++r) { tv[r][k] = mx[r]; ti[r][k] = cand[r]; if (e == cand[r]) lg[r] = -__builtin_inff(); }
            }
            if (F.lane == 0) {
#pragma unroll
                for (int r = 0; r < 8; ++r) {
                    const float e1 = __expf(tv[r][1] - tv[r][0]), e2 = __expf(tv[r][2] - tv[r][0]), e3 = __expf(tv[r][3] - tv[r][0]); const float inv = 1.f / (1.f + e1 + e2 + e3);
                    *(int4*)(TOPI + (row0 + r) * 4) = make_int4(ti[r][0], ti[r][1], ti[r][2], ti[r][3]);
                    *(f32x4*)(TOPG + (row0 + r) * 4) = (f32x4){inv, e1 * inv, e2 * inv, e3 * inv};
#pragma unroll
                    for (int k = 0; k < 4; ++k) __hip_atomic_fetch_add(&hist[ti[r][k]], 1, __ATOMIC_RELAXED, __HIP_MEMORY_SCOPE_WORKGROUP);
                }
            }
        }
        __syncthreads();
        if (F.tid < 32) HIST[chunk * 32 + F.tid] = hist[F.tid];
        __syncthreads();
    }
}

__device__ __forceinline__ void scatter_phase(Frame& F, ArgsP a) {
    LAS int* hl = (LAS int*)F.lds;
    LAS int* segsum = hl + 8192;
    LAS int* pstart = segsum + 512;
    LAS int* total = pstart + 32;
    LAS int* padded = total + 32;
    LAS int* ea = padded + 32;
    LAS int* slotl = ea + 256;
    const int* HIST = (const int*)(F.ws + WS_MOE + MOE_HIST); const int* TOPI = (const int*)(F.ws + WS_MOE + MOE_TOPI); const float* TOPG = (const float*)(F.ws + WS_MOE + MOE_TOPG);
    int* TOKSLOT = (int*)(F.ws + WS_MOE + MOE_TOKSLOT); int* BLK = (int*)(F.ws + WS_MOE + MOE_BLK); int* SLOTTOK = (int*)(F.ws + WS_MOE + MOE_SLOTTOK); float* SLOTG = (float*)(F.ws + WS_MOE + MOE_SLOTG);
    { u32x4 t[4];
#pragma unroll
      for (int i = 0; i < 4; ++i) t[i] = ((const u32x4*)HIST)[F.tid + NTHREADS * i];
#pragma unroll
      for (int i = 0; i < 4; ++i) *(LAS u32x4*)(hl + 4 * (F.tid + NTHREADS * i)) = t[i]; }
    __syncthreads();
    { const int e = F.tid & 31, seg = F.tid >> 5; int s = 0; for (int i = 0; i < 16; ++i) s += hl[(seg * 16 + i) * 32 + e]; segsum[seg * 32 + e] = s; }
    __syncthreads();
    if (F.tid < 32) { int run = 0; for (int seg = 0; seg < 16; ++seg) { const int t = segsum[seg * 32 + F.tid]; segsum[seg * 32 + F.tid] = run; run += t; } total[F.tid] = run; padded[F.tid] = (run + 255) & ~255; }
    __syncthreads();
    { const int e = F.tid & 31, seg = F.tid >> 5; int run = segsum[seg * 32 + e]; for (int i = 0; i < 16; ++i) { const int t = hl[(seg * 16 + i) * 32 + e]; hl[(seg * 16 + i) * 32 + e] = run; run += t; } }
    if (F.tid == 0) { int run = 0; for (int e = 0; e < 32; ++e) { pstart[e] = run; run += padded[e]; } }
    __syncthreads();
    if (F.bid == 0) {
        for (int b = F.tid; b < NBLK; b += NTHREADS) { int ex = -1; for (int e = 0; e < 32; ++e) if (b * 256 >= pstart[e] && b * 256 < pstart[e] + padded[e]) ex = e; BLK[b] = ex; }
        if (F.tid == 0) BLK[NBLK] = (pstart[31] + padded[31]) >> 8;
    }
    for (int e = F.bid; e < 32; e += F.G)
        for (int s = pstart[e] + total[e] + F.tid; s < pstart[e] + padded[e]; s += NTHREADS) { SLOTG[s] = 0.f; SLOTTOK[s] = -1; }
    const bf16_t* XB = WSP(bf16_t, WS_XB); bf16_t* XS = WSP(bf16_t, WS_XS);
    for (int chunk = F.bid; chunk < 256; chunk += F.G) {
        int e = 0, tok = 0;
        u32x4 r0[8], r1[8];
#pragma unroll
        for (int m = 0; m < 8; ++m) { const u32x4* src = (const u32x4*)(XB + (size_t)(chunk * 64 + F.wave * 8 + m) * DM); r0[m] = src[F.lane]; r1[m] = src[F.lane + 64]; }
        if (F.tid < 256) { tok = chunk * 64 + (F.tid >> 2); e = TOPI[tok * 4 + (F.tid & 3)]; ea[F.tid] = e; }
        __syncthreads();
        if (F.tid < 256) { int cnt = 0; for (int q = 0; q < F.tid; ++q) cnt += (ea[q] == e) ? 1 : 0;
            const int slot = pstart[e] + hl[chunk * 32 + e] + cnt; slotl[F.tid] = slot;
            TOKSLOT[tok * 4 + (F.tid & 3)] = slot; SLOTTOK[slot] = tok; SLOTG[slot] = TOPG[tok * 4 + (F.tid & 3)]; }
        __syncthreads();
#pragma unroll
        for (int m = 0; m < 8; ++m)
#pragma unroll
            for (int k = 0; k < 4; ++k) { const int slot = slotl[F.wave * 32 + 4 * m + k]; u32x4* dst = (u32x4*)(XS + (size_t)slot * DM); dst[F.lane] = r0[m]; dst[F.lane + 64] = r1[m]; }
        __syncthreads();
    }
}

__device__ __forceinline__ void combine_phase(Frame& F, ArgsP a, int l) {
    const int gw = F.bid * NWAVES + F.wave, NGW = F.G * NWAVES;
    const float* g2 = a->in[21] + (size_t)l * DM; const float* b2 = a->in[22] + (size_t)l * DM;
    const int* TOKSLOT = (const int*)(F.ws + WS_MOE + MOE_TOKSLOT); const bf16_t* YB = WSP(bf16_t, WS_YB);
    float* X = a->out; bf16_t* XB = WSP(bf16_t, WS_XB);
    f32x4 ggv[4], bbv[4];
#pragma unroll
    for (int j = 0; j < 4; ++j) { ggv[j] = ((const f32x4*)g2)[F.lane + 64 * j]; bbv[j] = ((const f32x4*)b2)[F.lane + 64 * j]; }
    for (int row0 = gw; row0 < NTOK; row0 += 2 * NGW) {
        int4 sl[2];
#pragma unroll
        for (int r = 0; r < 2; ++r) sl[r] = *(const int4*)(TOKSLOT + (size_t)(row0 + r * NGW < NTOK ? row0 + r * NGW : row0) * 4);
        u32x2 xw[2][4], yw[2][4][4];
#pragma unroll
        for (int r = 0; r < 2; ++r) { const int row = row0 + r * NGW < NTOK ? row0 + r * NGW : row0;
#pragma unroll
            for (int j = 0; j < 4; ++j) {
                xw[r][j] = ((const u32x2*)(XB + (size_t)row * DM))[F.lane + 64 * j];
                yw[r][0][j] = ((const u32x2*)(YB + (size_t)sl[r].x * DM))[F.lane + 64 * j]; yw[r][1][j] = ((const u32x2*)(YB + (size_t)sl[r].y * DM))[F.lane + 64 * j];
                yw[r][2][j] = ((const u32x2*)(YB + (size_t)sl[r].z * DM))[F.lane + 64 * j]; yw[r][3][j] = ((const u32x2*)(YB + (size_t)sl[r].w * DM))[F.lane + 64 * j]; } }
        __builtin_amdgcn_sched_barrier(0);
#pragma unroll
        for (int r = 0; r < 2; ++r) { const int row = row0 + r * NGW < NTOK ? row0 + r * NGW : row0;
            f32x4 v[4]; float s = 0.f;
#pragma unroll
            for (int j = 0; j < 4; ++j) {
                const u32x2 xw_ = xw[r][j]; const f32x4 x = (f32x4){bflo(xw_.x), bfhi(xw_.x), bflo(xw_.y), bfhi(xw_.y)};
                const u32x2 y0 = yw[r][0][j], y1 = yw[r][1][j], y2 = yw[r][2][j], y3 = yw[r][3][j];
                f32x4 y;
                y[0] = ((bflo(y0.x) + bflo(y1.x)) + bflo(y2.x)) + bflo(y3.x); y[1] = ((bfhi(y0.x) + bfhi(y1.x)) + bfhi(y2.x)) + bfhi(y3.x);
                y[2] = ((bflo(y0.y) + bflo(y1.y)) + bflo(y2.y)) + bflo(y3.y); y[3] = ((bfhi(y0.y) + bfhi(y1.y)) + bfhi(y2.y)) + bfhi(y3.y);
                v[j] = x * ALPHA + y; s += (v[j][0] + v[j][1]) + (v[j][2] + v[j][3]);
            }
            const float mean = wave_sum(s) * (1.f / DM); float s2 = 0.f;
#pragma unroll
            for (int j = 0; j < 4; ++j) { v[j] = v[j] - mean; s2 += (v[j][0] * v[j][0] + v[j][1] * v[j][1]) + (v[j][2] * v[j][2] + v[j][3] * v[j][3]); }
            const float rstd = 1.f / sqrtf(wave_sum(s2) * (1.f / DM) + LN_EPS);
#pragma unroll
            for (int j = 0; j < 4; ++j) { const f32x4 gg = ggv[j], bb = bbv[j]; v[j] = v[j] * rstd * gg + bb;
                if (l + 1 == NLAYER) ((f32x4*)(X + (size_t)row * DM))[F.lane + 64 * j] = v[j];
                if (l + 1 < NLAYER) { u32x2 w; w.x = cvtpk(v[j][0], v[j][1]); w.y = cvtpk(v[j][2], v[j][3]); ((u32x2*)(XB + (size_t)row * DM))[F.lane + 64 * j] = w; } }
        }
    }
}
constexpr int PH_PER_LAYER = 14, N_PHASES = 1 + NLAYER * PH_PER_LAYER;

template <int MODE> __device__ __forceinline__ void attn_phase_nsa(Frame& F, const att::P& AP) {
    for (int u0 = F.bid; u0 < 256; u0 += F.G) {
        const int u = (F.G == 256) ? ((u0 & 7) * 32 + (u0 >> 3)) : u0;
        const int bg = u >> 6, s = u & 63;
        att::attn_unit<MODE>(F.lds, AP, bg >> 1, bg & 1, s);
        att::attn_unit<MODE>(F.lds, AP, bg >> 1, bg & 1, 127 - s);
    }
}

template <int SP> __device__ __forceinline__ void run_phase(LAS unsigned char* lds, const int l) {
    ArgsP args = opaque_args();
    Frame F; F.lds = lds; F.tid = opaque_tid(); F.lane = F.tid & 63; F.wave = __builtin_amdgcn_readfirstlane(F.tid >> 6); F.G = gridDim.x; F.bid = blockIdx.x; F.ws = args->ws;
    const float* BIASL = WSP(float, WS_BIAS) + l * 16384;
    att::P AP{WSP(bf16_t, WS_Z), WSP(bf16_t, WS_KV), WSP(float, WS_S32), WSP(float, WS_CUM), WSP(bf16_t, WS_KC), WSP(bf16_t, WS_KC) + 2048 * 64, WSP(unsigned, WS_SEL), WSP(float, WS_ONSA), WSP(bf16_t, WS_YS)};
    if constexpr (SP == 99) { p0_phase(F, args); }
    else if constexpr (SP == 0) {
        pg8::Gemm g{WSP(bf16_t, WS_XB), WSP(bf16_t, WS_WIN + l * WIN_L), DM, DM, DM, 128};
        if (F.bid == 0 && F.tid < 20) (WSP(float, WS_CUM) + 131072)[64 * F.tid] = 0.f;
        SchedInProj S; S.o.init(NTOK / 256, NINP / 256, F.G, F.bid);
        constexpr int NWG_IN = (NTOK / 256) * (NINP / 256);
        const int tail = NWG_IN % F.G;
        unsigned* arrive = (unsigned*)(F.ws + WS_CTL) + 9216 + l * 64 + 16;
        EpiInProjT E{EpiInProj{WSP(bf16_t, WS_Z), WSP(float, WS_S32), BIASL, WSP(bf16_t, WS_KV)}, arrive, tail > 0};
        pg8::gemm_phase(F.lds, g, S, E);
        if (tail > 0 && F.bid >= tail) {
            unsigned sp = 0u;
            while ((unsigned)__builtin_amdgcn_readfirstlane((int)__hip_atomic_load(arrive, __ATOMIC_RELAXED, __HIP_MEMORY_SCOPE_AGENT)) < 2u * (NTOK / 256)) { __builtin_amdgcn_s_sleep(1); if (++sp > (1u << 24)) break; }
            __builtin_amdgcn_fence(__ATOMIC_ACQUIRE, "agent");
            pool_phase(F, args, l, (F.bid - tail) * NWAVES + F.wave, (F.G - tail) * NWAVES);
        }
    } else if constexpr (SP == 1) {
        pg8::Gemm g{WSP(bf16_t, WS_KV), WSP(bf16_t, WS_WC1 + l * WC1_L), 16 * 64, 2048, 256, 128};
        SchedC1 S{F.bid};
        EpiC1 E{WSP(float, WS_MSCR)};
        pg8::gemm_phase(F.lds, g, S, E);
        prep_thin(F, args, l);
        if (((NTOK / 256) * (NINP / 256)) % F.G == 0) pool_phase(F, args, l, F.bid * NWAVES + F.wave, F.G * NWAVES);
    } else if constexpr (SP == 2) { c2_phase(F, args, l); }
    else if constexpr (SP == 4) {
        attc::P APC{WSP(bf16_t, WS_Z), WSP(bf16_t, WS_KV), WSP(float, WS_S32), WSP(float, WS_CUM), WSP(bf16_t, WS_KC), WSP(bf16_t, WS_KC) + 2048 * 64, WSP(unsigned, WS_SEL), WSP(float, WS_ONSA), WSP(bf16_t, WS_YS)};
        unsigned* ctr = (unsigned*)(F.ws + WS_CTL) + 8192 + l * 64;
        volatile LAS int* slot = (volatile LAS int*)(F.lds + LDS_BYTES - 512);
        const int ncv = (l == 0) ? CV_NUNITS : 0;
        for (;;) {
            if (F.tid == 0) *slot = (int)atomicAdd(ctr, 1u);
            __syncthreads();
            const int e = __builtin_amdgcn_readfirstlane(*slot);
            __syncthreads();
            if (e >= 1024 + ncv) break;
            int u;
            if (e < 2 * ncv) { if (e & 1) { conv_unit(F, args, e >> 1); continue; } u = e >> 1; } else u = e - ncv;
            const int r = u >> 5, w = u & 31;
#ifdef PROBE_FOXONLY
            if (l >= 2 && w >= 16) continue;
#endif
            if (w < 16) {
                att::attn_unit<att::M_FOX>(F.lds, AP, w >> 3, w & 7, 31 - r);
            } else {
                const int w2 = w - 16, bg = w2 & 3, qb = 127 - 4 * r - (w2 >> 2);
                attc::attn_unit<attc::M_CMP>(F.lds, APC, bg >> 1, bg & 1, qb);
                __syncthreads();
                att::attn_unit<att::M_SLC>(F.lds, AP, bg >> 1, bg & 1, qb);
                att::attn_unit<att::M_WIN>(F.lds, AP, bg >> 1, bg & 1, qb);
            }
        }
    } else if constexpr (SP == 7) {
        pg8::Gemm g{WSP(bf16_t, WS_YS), WSP(bf16_t, WS_WUP + l * WUP_L), 1536, 512, 512, 128};
        SchedUp S; S.o.init(NTOK / 256, DM / 256, F.G, F.bid);
        EpiUp E{WSP(bf16_t, WS_Z), WSP(float, WS_MSCR), WSP(bf16_t, WS_MRG)};
        pg8::gemm_phase(F.lds, g, S, E);
    } else if constexpr (SP == 8) {
        pg8::Gemm g{WSP(bf16_t, WS_MRG), WSP(bf16_t, WS_WO + l * WO_L), DM, DM, DM, 128};
        SchedWo S; S.o.init(NTOK / 256, DM / 256, F.G, F.bid);
        EpiWo E{l == 0 ? args->in[0] : (const float*)nullptr, WSP(bf16_t, WS_XB), WSP(bf16_t, WS_V1)};
        pg8::gemm_phase(F.lds, g, S, E);
    } else if constexpr (SP == 9) { ln_router_phase(F, args, l); }
    else if constexpr (SP == 10) { scatter_phase(F, args); }
    else if constexpr (SP == 11) {
        const int* BLK = (const int*)(F.ws + WS_MOE + MOE_BLK);
        pg8::Gemm g{(const bf16_t*)F.ws, (const bf16_t*)F.ws, DM, DM, DM, 128};
        const int nblk = BLK[NBLK];
        unsigned* arrive = (unsigned*)(F.ws + WS_CTL) + 9216 + l * 64;
        SchedMoeT S{BLK, nblk, F.G, F.bid, l, arrive};
        EpiMoeT E{EpiMoe1{WSP(bf16_t, WS_ACT), args->in[18] + (size_t)l * NEXP * 2048},
                  EpiMoe2{WSP(bf16_t, WS_YB), args->in[20] + (size_t)l * NEXP * DM, (const float*)(F.ws + WS_MOE + MOE_SLOTG)}, arrive, (nblk * 8) % F.G != 0};
        pg8::gemm_phase(F.lds, g, S, E);
    } else if constexpr (SP == 12) {
        const int* BLK = (const int*)(F.ws + WS_MOE + MOE_BLK);
        pg8::Gemm g{WSP(bf16_t, WS_ACT), WSP(bf16_t, WS_WM2 + l * WM2_L), DM, DM, DM, 128};
        const int nblk = BLK[NBLK], tail = (nblk * 8) % F.G;
        SchedMoe S{BLK, nblk, F.G, F.bid, 4, 1024, tail ? F.G - tail : 0};
        EpiMoe2 E{WSP(bf16_t, WS_YB), args->in[20] + (size_t)l * NEXP * DM, (const float*)(F.ws + WS_MOE + MOE_SLOTG)};
        pg8::gemm_phase(F.lds, g, S, E);
    } else if constexpr (SP == 13) { combine_phase(F, args, l); }
}

#define XB_TMO      128
#define XB_XCNT(j)  (256  + 64 * (j))
#define XB_XSUB(j)  (1280 + 64 * (j))
#define XB_XGEN(j)  (2304 + 64 * (j))
#define XB_TOP      3328
#define XB_TOPGEN   3392
#define XCD_BAR_WORDS 3456
#define XB_SPIN_CAP (1u << 22)
__device__ __forceinline__ unsigned xb_ld(unsigned* p)              { return __hip_atomic_load(p, __ATOMIC_RELAXED, __HIP_MEMORY_SCOPE_AGENT); }
__device__ __forceinline__ unsigned xb_add(unsigned* p, unsigned v) { return __hip_atomic_fetch_add(p, v, __ATOMIC_RELAXED, __HIP_MEMORY_SCOPE_AGENT); }
__device__ __forceinline__ unsigned xb_xcc_id() { return (unsigned)__builtin_amdgcn_s_getreg((3 << 11) | 20) & 0xFu; }
#define XB_SPIN(cond, bar) do { unsigned _sp = 0; while (cond) { __builtin_amdgcn_s_sleep(1); \
    if ((++_sp & 255u) == 0u) { if (xb_ld(&(bar)[XB_TMO])) break; if (_sp > XB_SPIN_CAP) { atomicAdd(&(bar)[XB_TMO], 1u); break; } } } } while (0)
struct XcdBarrier { unsigned* bar; unsigned x; volatile LAS unsigned* st; };
__device__ __forceinline__ XcdBarrier xcd_barrier_post(unsigned* bar, volatile LAS unsigned* st) {
    XcdBarrier b; b.bar = bar; b.x = xb_xcc_id(); b.st = st;
    if (threadIdx.x == 0) (void)xb_add(&bar[XB_XCNT(b.x)], 1u);
    return b;
}
__device__ __forceinline__ void xcd_barrier_complete(unsigned* bar, unsigned x, unsigned& nloc, unsigned& nx) {
    const unsigned G = gridDim.x * gridDim.y * gridDim.z;
    unsigned sum, cnt, mine, sp = 0u;
    for (;;) {
        sum = 0u; cnt = 0u; mine = 0u;
#pragma unroll
        for (unsigned j = 0; j < 16; ++j) { const unsigned c = xb_ld(&bar[XB_XCNT(j)]); sum += c; cnt += (c > 0u) ? 1u : 0u; mine = (j == x) ? c : mine; }
        if (sum == G) break;
        __builtin_amdgcn_s_sleep(1);
        if ((++sp & 255u) == 0u) { if (xb_ld(&bar[XB_TMO])) break; if (sp > XB_SPIN_CAP) { atomicAdd(&bar[XB_TMO], 1u); break; } }
    }
    nloc = mine > 0u ? mine : 1u; nx = cnt > 0u ? cnt : 1u;
}
__device__ __forceinline__ void xcd_barrier(const XcdBarrier& b) {
    asm volatile("s_waitcnt vmcnt(0)" ::: "memory");
    __syncthreads();
    if (threadIdx.x == 0) {
        unsigned* bar = b.bar;
        __builtin_amdgcn_s_waitcnt(0);
        unsigned nloc = b.st[0], nx = b.st[1];
        if (nloc == 0u) { xcd_barrier_complete(bar, b.x, nloc, nx); b.st[0] = nloc; b.st[1] = nx; }
        const unsigned old = xb_add(&bar[XB_XSUB(b.x)], 1u);
        const unsigned gen = old / nloc;
        if (old + 1u == (gen + 1u) * nloc) {
            __builtin_amdgcn_fence(__ATOMIC_RELEASE, "agent");
            asm volatile("s_waitcnt vmcnt(0)" ::: "memory");
            const unsigned og = xb_add(&bar[XB_TOP], 1u);
            const unsigned tg = og / nx;
            if (og + 1u == (tg + 1u) * nx) xb_add(&bar[XB_TOPGEN], 1u);
            else XB_SPIN(xb_ld(&bar[XB_TOPGEN]) == tg, bar);
            __builtin_amdgcn_fence(__ATOMIC_ACQUIRE, "agent");
            xb_add(&bar[XB_XGEN(b.x)], 1u);
            asm volatile("s_waitcnt vmcnt(0)" ::: "memory");
        } else {
            XB_SPIN(xb_ld(&bar[XB_XGEN(b.x)]) == gen, bar);
            __builtin_amdgcn_fence(__ATOMIC_ACQUIRE, "agent");
            asm volatile("s_waitcnt vmcnt(0)" ::: "memory");
        }
    }
    __syncthreads();
}
constexpr int LDS_BARST = LDS_BYTES - 256;

template <int SP> __global__ void __launch_bounds__(NTHREADS, 2) mk_phase(Args args) {
    extern __shared__ __attribute__((aligned(16))) unsigned char lds_raw[];
    run_phase<SP>((LAS unsigned char*)lds_raw, args.ph_lo);
}
#ifndef REP_0
#define REP_0 1
#endif
#ifndef REP_1
#define REP_1 1
#endif
#ifndef REP_2
#define REP_2 1
#endif
#ifndef REP_3
#define REP_3 1
#endif
#ifndef REP_4
#define REP_4 1
#endif
#ifndef REP_5
#define REP_5 1
#endif
#ifndef REP_6
#define REP_6 1
#endif
#ifndef REP_7
#define REP_7 1
#endif
#ifndef REP_8
#define REP_8 1
#endif
#ifndef REP_9
#define REP_9 1
#endif
#ifndef REP_10
#define REP_10 1
#endif
#ifndef REP_11
#define REP_11 1
#endif
#ifndef REP_12
#define REP_12 1
#endif
__global__ void __launch_bounds__(NTHREADS, 2) mk_fwd(Args args) {
    extern __shared__ __attribute__((aligned(16))) unsigned char lds_raw[];
    LAS unsigned char* lds = (LAS unsigned char*)lds_raw;
    cg::grid_group grid = cg::this_grid();
    volatile LAS unsigned* bst = (volatile LAS unsigned*)(lds + LDS_BARST);
    if (threadIdx.x < 2) bst[threadIdx.x] = 0u;
    __syncthreads();
    (void)xcd_barrier_post((unsigned*)(args.ws + WS_CTL) + 1024, bst);
#define SEAM() do { XcdBarrier bar_; bar_.bar = (unsigned*)(opaque_args()->ws + WS_CTL) + 1024; bar_.x = xb_xcc_id(); bar_.st = (volatile LAS unsigned*)(lds + LDS_BARST); xcd_barrier(bar_); } while (0)
#ifndef REP_34
#define REP_34 1
#endif
#ifndef REP_PRO
#define REP_PRO 1
#endif
#ifndef REP_BAR
#define REP_BAR 0
#endif
#define REPN(N, SPX) for (int rep_ = 0; rep_ < (N); ++rep_) { run_phase<SPX>(lds, l); SEAM(); }
#ifdef PRO_JOBS
    { Frame F; F.lds = lds; F.tid = opaque_tid(); F.lane = F.tid & 63; F.wave = __builtin_amdgcn_readfirstlane(F.tid >> 6); F.G = gridDim.x; F.bid = blockIdx.x; F.ws = args.ws; p0_phase(F, opaque_args(), PRO_JOBS); grid.sync(); }
#endif
    for (int rep_ = 0; rep_ < REP_PRO; ++rep_) { run_phase<99>(lds, 0); grid.sync(); }
    for (int l = 0; l < NLAYER; ++l) {
        REPN(REP_0, 0)
        REPN(REP_1, 1)
        REPN(REP_2, 2)
        for (int rep2_ = 0; rep2_ < REP_34; ++rep2_) {
        for (int rep_ = 0; rep_ < REP_4; ++rep_) { run_phase<4>(lds, l + 2 * rep_); SEAM(); }
        }
        REPN(REP_7, 7)
        REPN(REP_8, 8)
        REPN(REP_9, 9)
        REPN(REP_10, 10)
        REPN(REP_11, 11)
        REPN(REP_12, 12)
        run_phase<13>(lds, l); if (l + 1 < NLAYER) SEAM();
        for (int rep_ = 0; rep_ < REP_BAR; ++rep_) SEAM();
    }
#undef SEAM
}

#ifndef MK_ONE_LAUNCH
#define MK_ONE_LAUNCH 1
#endif
#define SET_ATTR1(SP) (void)hipFuncSetAttribute((const void*)mk_phase<SP>, hipFuncAttributeMaxDynamicSharedMemorySize, LDS_BYTES)
#define SET_ATTRS() do { SET_ATTR1(99); SET_ATTR1(0); SET_ATTR1(1); SET_ATTR1(2); SET_ATTR1(3); SET_ATTR1(4); SET_ATTR1(5); SET_ATTR1(6); SET_ATTR1(7); SET_ATTR1(8); SET_ATTR1(9); SET_ATTR1(10); SET_ATTR1(11); SET_ATTR1(12); SET_ATTR1(13); } while (0)
extern "C" void kernel_launch(void* const* d_in, const int* in_sizes, int n_in, void* d_out, int out_size, void* d_ws, size_t ws_size, hipStream_t stream) {
    static int grid = 0;
    if (grid == 0) {
        if (n_in != 23 || out_size != NTOK * DM || ws_size < WS_END) { fprintf(stderr, "kernel_launch: unexpected problem (n_in %d out %d ws %zu)\n", n_in, out_size, ws_size); grid = -1; return; }
        int dev = 0, cus = 0, per_cu = 0;
        (void)hipGetDevice(&dev); (void)hipDeviceGetAttribute(&cus, hipDeviceAttributeMultiprocessorCount, dev);
#if MK_ONE_LAUNCH
        (void)hipFuncSetAttribute((const void*)mk_fwd, hipFuncAttributeMaxDynamicSharedMemorySize, LDS_BYTES);
        (void)hipOccupancyMaxActiveBlocksPerMultiprocessor(&per_cu, (const void*)mk_fwd, NTHREADS, LDS_BYTES);
#else
        SET_ATTRS();
        (void)hipOccupancyMaxActiveBlocksPerMultiprocessor(&per_cu, (const void*)mk_phase<0>, NTHREADS, LDS_BYTES);
#endif
        (void)hipGetLastError();
        if (per_cu < 1) { fprintf(stderr, "kernel_launch: occupancy query reports %d blocks per CU\n", per_cu); per_cu = 1; }
        grid = cus;
    }
    if (grid < 0) return;
    Args a{};
    for (int i = 0; i < 23; ++i) a.in[i] = (const float*)d_in[i];
    a.out = (float*)d_out; a.ws = (unsigned char*)d_ws;
#if MK_ONE_LAUNCH
    a.ph_lo = 0; a.ph_hi = 0;
    (void)hipMemsetAsync((char*)d_ws + WS_CTL, 0, 64 * 1024, stream);
    void* kargs[] = {&a};
    hipError_t e = hipLaunchCooperativeKernel((const void*)mk_fwd, dim3(grid), dim3(NTHREADS), kargs, LDS_BYTES, stream);
    if (e != hipSuccess) fprintf(stderr, "cooperative launch failed: %s (grid %d)\n", hipGetErrorString(e), grid);
#else
#define LAUNCH_PH(SP, L) do { a.ph_lo = (L); a.ph_hi = 0; hipLaunchKernelGGL(mk_phase<SP>, dim3(grid), dim3(NTHREADS), LDS_BYTES, stream, a); } while (0)
    LAUNCH_PH(99, 0);
    for (int l = 0; l < NLAYER; ++l) {
        LAUNCH_PH(0, l); LAUNCH_PH(1, l); LAUNCH_PH(2, l); LAUNCH_PH(3, l); LAUNCH_PH(4, l); LAUNCH_PH(5, l); LAUNCH_PH(6, l);
        LAUNCH_PH(7, l); LAUNCH_PH(8, l); LAUNCH_PH(9, l); LAUNCH_PH(10, l); LAUNCH_PH(11, l); LAUNCH_PH(12, l); LAUNCH_PH(13, l);
    }
#endif
}
```

```cpp
#include <hip/hip_runtime.h>
#include <hip/hip_cooperative_groups.h>
#include <cstdio>
#include <cstdint>
namespace cg = cooperative_groups;

constexpr int NTOK = 16384, SEQ = 8192, DM = 1024, NLAYER = 2;
constexpr int INW = 6432;
constexpr int ZP = 6400;
constexpr int NINP = 6656;
constexpr int NEXP = 32, PSLOTS = 73728, NBLK = 288;
constexpr float LN_EPS = 1e-5f;
constexpr float QSCALE = 0.125f * 1.4426950408889634f;
constexpr float LOG2E = 1.4426950408889634f;
constexpr float ALPHA = 1.4142135623730951f;
constexpr int ZC_POOL = 0, ZC_QN = 512, ZC_KVN = 1024, ZC_FOX = 1792, ZC_GM = 3328;

constexpr size_t MiB = 1u << 20;
constexpr size_t WS_CTL = 0;
constexpr size_t WS_BIAS = 1 * MiB;
constexpr size_t WS_WIN = 2 * MiB, WIN_L = 13 * MiB;
constexpr size_t WS_WUP = 28 * MiB, WUP_L = 3 * MiB;
constexpr size_t WS_WO = 34 * MiB, WO_L = 2 * MiB;
constexpr size_t WS_WC1 = 38 * MiB, WC1_L = 2 * MiB;
constexpr size_t WS_WM1 = 48 * MiB, WM1_L = 128 * MiB;
constexpr size_t WS_WM2 = 304 * MiB, WM2_L = 64 * MiB;
constexpr size_t WS_Z = 432 * MiB;
constexpr size_t WS_S32 = 640 * MiB;
constexpr size_t WS_CUM = 642 * MiB;
constexpr size_t WS_H1 = 643 * MiB;
constexpr size_t WS_KC = 645 * MiB;
constexpr size_t WS_SEL = 646 * MiB;
constexpr size_t WS_YS = 648 * MiB;
constexpr size_t WS_ONSA = 696 * MiB;
constexpr size_t WS_MSCR = 728 * MiB;
constexpr size_t WS_MRG = 792 * MiB;
constexpr size_t WS_V1 = 824 * MiB;
constexpr size_t WS_XB = 888 * MiB;
constexpr size_t WS_MOE = 920 * MiB;
constexpr size_t MOE_TOPI = 0, MOE_TOPG = 256 * 1024, MOE_TOKSLOT = 512 * 1024, MOE_HIST = 768 * 1024, MOE_BLK = 832 * 1024,
                 MOE_SLOTTOK = 1024 * 1024, MOE_SLOTG = 1536 * 1024;
constexpr size_t WS_XS = 924 * MiB;
constexpr size_t WS_ACT = 1068 * MiB;
constexpr size_t WS_YB = 1212 * MiB;
constexpr size_t WS_KV = 1356 * MiB;
constexpr size_t WS_END = 1420 * MiB;
constexpr int NSTREAM = 28;

constexpr int NWAVES = 8, NTHREADS = 512;
constexpr int LDS_BYTES = 147456;

#define LAS __attribute__((address_space(3)))
typedef unsigned short bf16_t;
typedef short bf16x8 __attribute__((ext_vector_type(8)));
typedef float f32x4 __attribute__((ext_vector_type(4)));
typedef float f32x16 __attribute__((ext_vector_type(16)));
typedef unsigned u32x4 __attribute__((ext_vector_type(4)));
typedef unsigned u32x2 __attribute__((ext_vector_type(2)));
typedef float f32x2_t __attribute__((ext_vector_type(2)));
typedef __bf16 bf16x2_t __attribute__((ext_vector_type(2)));

__device__ __forceinline__ unsigned cvtpk(float lo, float hi) { f32x2_t v = {lo, hi}; bf16x2_t b = __builtin_convertvector(v, bf16x2_t); return __builtin_bit_cast(unsigned, b); }
__device__ __forceinline__ float bf2f(bf16_t v) { return __uint_as_float((unsigned)v << 16); }
__device__ __forceinline__ float bflo(unsigned w) { return __uint_as_float(w << 16); }
__device__ __forceinline__ float bfhi(unsigned w) { return __uint_as_float(w & 0xffff0000u); }
__device__ __forceinline__ float wave_sum(float v) {
#pragma unroll
    for (int o = 1; o < 64; o <<= 1) v += __shfl_xor(v, o);
    return v;
}
__device__ __forceinline__ float sigmoidf_(float x) { return __builtin_amdgcn_rcpf(1.f + __builtin_amdgcn_exp2f(-1.4426950408889634f * x)); }

__device__ __forceinline__ int opaque_tid() { int t = threadIdx.x; asm volatile("" : "+v"(t)); return t; }

struct Args {
    const float* in[23];
    float* out;
    unsigned char* ws;
    int ph_lo, ph_hi;
};
typedef const __attribute__((address_space(4))) Args* ArgsP;
__device__ __forceinline__ ArgsP opaque_args() { ArgsP p = (ArgsP)__builtin_amdgcn_kernarg_segment_ptr(); asm volatile("" : "+s"(p)); return p; }
namespace pg8 {
constexpr int BM = 256, BK = 64, HALF = 128, HTB = HALF * BK * 2  , STAGE_BYTES = 8 * HTB;

__host__ __device__ __forceinline__ int lds_byte(int r, int c) { const int st = (r >> 4) * 2 + (c >> 5), rr = r & 15, cc = c & 31, ob = rr * 64 + cc * 2; return st * 1024 + (ob ^ (((ob >> 9) & 1) << 5)); }
__host__ __device__ __forceinline__ void stage_rc(int b, int& R, int& C) { const int st = b / 1024, sb = b % 1024, swz = sb ^ (((sb >> 9) & 1) << 5); R = (st >> 1) * 16 + swz / 64; C = (st & 1) * 32 + (swz % 64) / 2; }
__host__ __device__ __forceinline__ int perm32(int rho) { const int n = rho >> 4, i = rho & 15; return 8 * (i >> 2) + 4 * n + (i & 3); }

struct Unit { int pm, pn, aux, idx; size_t aoff, boff; };
struct Gemm { const bf16_t* A; const bf16_t* Bt; int lda, ldb, K; int kstepA; };

template <class Epi, class Sched>
__device__ __forceinline__ void gemm_phase(LAS unsigned char* lds, const Gemm g, const Sched& S, const Epi& E) {
    const int tid = opaque_tid(), wid = __builtin_amdgcn_readfirstlane(tid >> 6), lane = tid & 63, wr = wid >> 2, wc = wid & 3, fr = lane & 15, fq = lane >> 4;
    const int K = g.K, nt = K / BK;
    unsigned voffA[2], voffB[2];
#pragma unroll
    for (int i = 0; i < 2; ++i) { int R, C; stage_rc(tid * 16 + i * 8192, R, C); const int Rb = (R & ~31) + perm32(R & 31);
        voffA[i] = (unsigned)(R * g.lda + C) * 2u; voffB[i] = (unsigned)(Rb * g.ldb + C) * 2u; }
    const size_t kstepA = (size_t)g.kstepA, kstepB = (size_t)(BK * 2);
    const size_t hstepA = (size_t)HALF * g.lda * 2, hstepB = (size_t)HALF * g.ldb * 2;
    const unsigned ldsw = (unsigned)wid * 1024u;
    const int aoff = lds_byte(wr * 64 + fr, fq * 8), boff = lds_byte(wc * 32 + fr, fq * 8);
#define PG8_SA(b, h) (((b) * 2 + (h)) * HTB)
#define PG8_SB(b, h) ((4 + (b) * 2 + (h)) * HTB)
#define PG8_STAGE(bufoff, gbase, voff) do { _Pragma("unroll") for (int _i = 0; _i < 2; ++_i) \
        __builtin_amdgcn_global_load_lds((const unsigned*)((const char*)(gbase) + (voff)[_i]), (LAS unsigned*)(lds + (bufoff) + ldsw + _i * 8192), 16, 0, 0); } while (0)
#define PG8_LDA(dst, b, h) do { _Pragma("unroll") for (int m = 0; m < 4; ++m) _Pragma("unroll") for (int k = 0; k < 2; ++k) dst[m][k] = *(const LAS bf16x8*)(lds + PG8_SA(b, h) + aoff + m * 2048 + k * 1024); } while (0)
#define PG8_LDB(dst, b, h) do { _Pragma("unroll") for (int n = 0; n < 2; ++n) _Pragma("unroll") for (int k = 0; k < 2; ++k) dst[n][k] = *(const LAS bf16x8*)(lds + PG8_SB(b, h) + boff + n * 2048 + k * 1024); } while (0)
#define PG8_MMA(ai, bj, At, Bt) do { __builtin_amdgcn_s_setprio(1); _Pragma("unroll") for (int m = 0; m < 4; ++m) _Pragma("unroll") for (int n = 0; n < 2; ++n) _Pragma("unroll") for (int k = 0; k < 2; ++k) \
        acc[ai][bj][m][n] = __builtin_amdgcn_mfma_f32_16x16x32_bf16(Bt[n][k], At[m][k], acc[ai][bj][m][n], 0, 0, 0); __builtin_amdgcn_s_setprio(0); } while (0)
#define PG8_WAIT_V(n) asm volatile("s_waitcnt vmcnt(" #n ")" ::: "memory")
#define PG8_WAIT_L(n) asm volatile("s_waitcnt lgkmcnt(" #n ")" ::: "memory")
#define PG8_BAR __builtin_amdgcn_s_barrier()
#define PG8_SCHED __builtin_amdgcn_sched_barrier(0)
    Unit cur, nxt; int ui = 0;
    if (!S.next(0, cur)) return;
    f32x4 acc[2][2][4][2];
#pragma unroll
    for (int a = 0; a < 2; ++a)
#pragma unroll
        for (int b = 0; b < 2; ++b)
#pragma unroll
            for (int m = 0; m < 4; ++m)
#pragma unroll
                for (int n = 0; n < 2; ++n) acc[a][b][m][n] = (f32x4){0.f, 0.f, 0.f, 0.f};
    bf16x8 At[4][2], B0[2][2], B1[2][2];
    const char* cA = (const char*)g.A + cur.aoff; const char* cB = (const char*)g.Bt + cur.boff;
    PG8_STAGE(PG8_SB(0, 0), cB, voffB); PG8_STAGE(PG8_SB(0, 1), cB + hstepB, voffB); PG8_STAGE(PG8_SA(0, 0), cA, voffA); PG8_STAGE(PG8_SA(0, 1), cA + hstepA, voffA);
    if (wr == 1) PG8_BAR;
    PG8_WAIT_V(2); PG8_BAR;
    PG8_STAGE(PG8_SB(1, 0), cB + kstepB, voffB); PG8_STAGE(PG8_SA(1, 0), cA + kstepA, voffA); PG8_STAGE(PG8_SB(1, 1), cB + hstepB + kstepB, voffB);
    PG8_WAIT_V(6); PG8_BAR;
    for (;;) {
        const bool has_next = S.next(ui + 1, nxt);
        const char* nA = has_next ? (const char*)g.A + nxt.aoff : cA; const char* nB = has_next ? (const char*)g.Bt + nxt.boff : cB;
#pragma unroll 1
        for (int t = 0; t < nt; t += 2) {
            const bool last = (t == nt - 2);
            const char* a1 = cA + (size_t)(t + 1) * kstepA;
            const char* a2 = last ? nA : cA + (size_t)(t + 2) * kstepA; const char* b2 = last ? nB : cB + (size_t)(t + 2) * kstepB;
            const char* a3 = a2 + kstepA; const char* b3 = b2 + kstepB;
            PG8_LDB(B0, 0, 0); PG8_LDB(B1, 0, 1); PG8_SCHED; PG8_LDA(At, 0, 0); PG8_STAGE(PG8_SA(1, 1), a1 + hstepA, voffA);
            PG8_WAIT_V(8); PG8_WAIT_L(0); PG8_BAR; PG8_MMA(0, 0, At, B0); PG8_MMA(0, 1, At, B1); PG8_BAR; PG8_SCHED;
            PG8_LDA(At, 0, 1); PG8_STAGE(PG8_SB(0, 0), b2, voffB); PG8_STAGE(PG8_SB(0, 1), b2 + hstepB, voffB); PG8_STAGE(PG8_SA(0, 0), a2, voffA);
            PG8_WAIT_V(8); PG8_WAIT_L(0); PG8_BAR; PG8_MMA(1, 0, At, B0); PG8_MMA(1, 1, At, B1); PG8_BAR; PG8_SCHED;
            PG8_LDB(B0, 1, 0); PG8_LDB(B1, 1, 1); PG8_SCHED; PG8_LDA(At, 1, 0); PG8_STAGE(PG8_SA(0, 1), a2 + hstepA, voffA);
            PG8_WAIT_V(8); PG8_WAIT_L(0); PG8_BAR; PG8_MMA(0, 0, At, B0); PG8_MMA(0, 1, At, B1); PG8_BAR; PG8_SCHED;
            PG8_LDA(At, 1, 1); PG8_STAGE(PG8_SB(1, 0), b3, voffB); PG8_STAGE(PG8_SB(1, 1), b3 + hstepB, voffB); PG8_STAGE(PG8_SA(1, 0), a3, voffA);
            PG8_WAIT_V(8); PG8_WAIT_L(0); PG8_BAR; PG8_MMA(1, 0, At, B0); PG8_MMA(1, 1, At, B1); PG8_BAR; PG8_SCHED;
        }
        if (wr == 0) PG8_BAR;
        E(acc, cur, wr, wc, fr, fq);
        if (!has_next) break;
#pragma unroll
        for (int a = 0; a < 2; ++a)
#pragma unroll
            for (int b = 0; b < 2; ++b)
#pragma unroll
                for (int m = 0; m < 4; ++m)
#pragma unroll
                    for (int n = 0; n < 2; ++n) acc[a][b][m][n] = (f32x4){0.f, 0.f, 0.f, 0.f};
        cur = nxt; cA = nA; cB = nB; ++ui;
        if (wr == 1) PG8_BAR;
    }
    PG8_WAIT_V(0);
    PG8_BAR;
#undef PG8_SA
#undef PG8_SB
#undef PG8_STAGE
#undef PG8_LDA
#undef PG8_LDB
#undef PG8_MMA
#undef PG8_WAIT_V
#undef PG8_WAIT_L
#undef PG8_BAR
#undef PG8_SCHED
}

struct TileOrder {
    int nM, nN, nwg, G, c;
    __device__ __forceinline__ void init(int nM_, int nN_, int G_, int c_) { nM = nM_; nN = nN_; nwg = nM * nN; G = G_; c = c_; }
    __device__ __forceinline__ bool tile(int i, int& pm, int& pn) const {
        const long L = (long)i * G + c; if (L >= nwg) return false;
        int wgid = (int)L; { const int q = nwg / 8, r = nwg % 8, xcd = wgid % 8, off = wgid / 8; wgid = (xcd < r ? xcd * (q + 1) : r * (q + 1) + (xcd - r) * q) + off; }
        const int nig = 8 * nN, gid = wgid / nig, fm = gid * 8, gsz = (nM - fm) < 8 ? (nM - fm) : 8;
        pm = fm + ((wgid % nig) % gsz); pn = (wgid % nig) / gsz; return true;
    }
};
}
using pg8::Unit;
typedef const f32x4 (&AccT)[2][2][4][2];

__device__ __forceinline__ float log_sigmoidf_(float x) { return fminf(x, 0.f) - log1pf(__expf(-fabsf(x))); }
__device__ __forceinline__ float gelu_tanhf_(float x) { const float y = 0.7978845608028654f * (x + 0.044715f * x * x * x); const float t = 1.f - 2.f * __builtin_amdgcn_rcpf(__builtin_amdgcn_exp2f(2.8853900817779268f * y) + 1.f); return 0.5f * x * (1.f + t); }
__device__ __forceinline__ u32x4 pack8(const f32x4 a, const f32x4 b) { u32x4 w; w.x = cvtpk(a[0], a[1]); w.y = cvtpk(a[2], a[3]); w.z = cvtpk(b[0], b[1]); w.w = cvtpk(b[2], b[3]); return w; }

struct SchedInProj {
    pg8::TileOrder o;
    __device__ __forceinline__ bool next(int i, Unit& u) const { int pm, pn; if (!o.tile(i, pm, pn)) return false; u.pm = pm; u.pn = pn; u.aux = 0; u.idx = i;
        u.aoff = (size_t)pm * 256 * DM * 2; u.boff = (size_t)pn * 256 * DM * 2; return true; }
};
struct EpiInProj {
    bf16_t* Z; float* S32; const float* bias; bf16_t* KV;
    __device__ __forceinline__ void operator()(AccT acc, const Unit& u, int wr, int wc, int fr, int fq) const {
        const int pn = u.pn, row0 = u.pm * 256 + wr * 64 + fr;
        const int st0 = (pn >= 4 && pn <= 6) ? (pn - 4) * 4 : (pn == 9 || pn == 10) ? 12 + (pn - 9) * 4 : (pn == 11 || pn == 12) ? 20 + (pn - 11) * 4 : -1;
        if (st0 >= 0) {
            const int lc = wc * 32 + 8 * fq, col0 = pn * 256 + lc;
            f32x4 bv[2][2];
#pragma unroll
            for (int bj = 0; bj < 2; ++bj)
#pragma unroll
                for (int n = 0; n < 2; ++n) bv[bj][n] = *(const f32x4*)(bias + col0 + bj * 128 + 4 * n);
#pragma unroll
            for (int ai = 0; ai < 2; ++ai)
#pragma unroll
                for (int m = 0; m < 4; ++m) { const int row = row0 + ai * 128 + m * 16, bb = row >> 13, t = row & (SEQ - 1);
#pragma unroll
                    for (int bj = 0; bj < 2; ++bj) { const int l2 = lc + bj * 128; const f32x4 v0 = acc[ai][bj][m][0] + bv[bj][0], v1 = acc[ai][bj][m][1] + bv[bj][1];
                        *(u32x4*)(KV + (((size_t)(bb * NSTREAM + st0 + (l2 >> 6)) * SEQ + t) * 64) + (l2 & 63)) = pack8(v0, v1); } }
        } else if (pn < 25) {
            const bool isq = (pn == 2 || pn == 3 || pn == 7 || pn == 8), issig = pn >= 13;
            const int col0 = pn * 256 + wc * 32 + 8 * fq;
            f32x4 bv[2][2];
#pragma unroll
            for (int bj = 0; bj < 2; ++bj)
#pragma unroll
                for (int n = 0; n < 2; ++n) bv[bj][n] = *(const f32x4*)(bias + col0 + bj * 128 + 4 * n);
#pragma unroll
            for (int ai = 0; ai < 2; ++ai)
#pragma unroll
                for (int m = 0; m < 4; ++m) { bf16_t* rowp = Z + (size_t)(row0 + ai * 128 + m * 16) * ZP + col0;
#pragma unroll
                    for (int bj = 0; bj < 2; ++bj) { f32x4 v0 = acc[ai][bj][m][0] + bv[bj][0], v1 = acc[ai][bj][m][1] + bv[bj][1];
                        if (isq) { v0 = v0 * QSCALE; v1 = v1 * QSCALE; }
                        if (issig) {
#pragma unroll
                            for (int i = 0; i < 4; ++i) { v0[i] = sigmoidf_(v0[i]); v1[i] = sigmoidf_(v1[i]); } }
                        *(u32x4*)(rowp + bj * 128) = pack8(v0, v1); } }
        } else if (wc == 0) {
            const int c0 = 8 * fq;
            const f32x4 b0 = *(const f32x4*)(bias + 6400 + c0), b1 = *(const f32x4*)(bias + 6400 + c0 + 4);
#pragma unroll
            for (int ai = 0; ai < 2; ++ai)
#pragma unroll
                for (int m = 0; m < 4; ++m) { float* rowp = S32 + (size_t)(row0 + ai * 128 + m * 16) * 32 + c0;
                    f32x4 v0 = acc[ai][0][m][0] + b0, v1 = acc[ai][0][m][1] + b1;
#pragma unroll
                    for (int i = 0; i < 4; ++i) { v0[i] = (fq < 3) ? sigmoidf_(v0[i]) : log_sigmoidf_(v0[i]); v1[i] = (fq < 3) ? sigmoidf_(v1[i]) : log_sigmoidf_(v1[i]); }
                    *(f32x4*)(rowp) = v0; *(f32x4*)(rowp + 4) = v1; }
        }
    }
};

struct SchedC1 {
    int c;
    __device__ __forceinline__ bool next(int i, Unit& u) const { if (i > 0 || c >= 128) return false; const int split = c & 7, idx = c >> 3, kv = idx >> 3, pm = idx & 7, bg = pm >> 1, half = pm & 1, b = bg >> 1, gq = bg & 1;
        u.pm = pm; u.pn = 0; u.aux = kv * 8 + split;
        u.aoff = (((size_t)(b * NSTREAM + kv * 2 + gq) * SEQ + 16 * 256 * half + 4 * split) * 64) * 2; u.boff = ((size_t)kv * 256 * 2048 + split * 256) * 2; return true; }
};
struct EpiC1 {
    float* PART;
    __device__ __forceinline__ void operator()(AccT acc, const Unit& u, int wr, int wc, int fr, int fq) const {
        const int kv = u.aux >> 3, split = u.aux & 7, row0 = u.pm * 256 + wr * 64 + fr, col0 = wc * 32 + 8 * fq;
#pragma unroll
        for (int ai = 0; ai < 2; ++ai)
#pragma unroll
            for (int m = 0; m < 4; ++m) { float* rowp = PART + ((size_t)(split * 2 + kv) * 2048 + row0 + ai * 128 + m * 16) * 256 + col0;
#pragma unroll
                for (int bj = 0; bj < 2; ++bj) { *(f32x4*)(rowp + bj * 128) = acc[ai][bj][m][0]; *(f32x4*)(rowp + bj * 128 + 4) = acc[ai][bj][m][1]; } }
    }
};

struct SchedUp {
    pg8::TileOrder o;
    __device__ __forceinline__ bool next(int i, Unit& u) const { int pm, pn; const int ti = i / 3, nb = i - 3 * ti; if (!o.tile(ti, pm, pn)) return false; u.pm = pm; u.pn = pn; u.aux = nb;
        u.aoff = ((size_t)pm * 256 * 1536 + nb * 512) * 2; u.boff = ((size_t)(nb * 1024 + pn * 256) * 512) * 2; return true; }
};
struct EpiUp {
    const bf16_t* Z; float* scr; bf16_t* MRG;
    __device__ __forceinline__ void operator()(AccT acc, const Unit& u, int wr, int wc, int fr, int fq) const {
        const int nb = u.aux, row0 = u.pm * 256 + wr * 64 + fr, col0 = u.pn * 256 + wc * 32 + 8 * fq;
#pragma unroll
        for (int ai = 0; ai < 2; ++ai) {
            u32x4 gw[4][2], pw[4][2];
#pragma unroll
            for (int m = 0; m < 4; ++m)
#pragma unroll
                for (int bj = 0; bj < 2; ++bj) gw[m][bj] = *(const u32x4*)(Z + (size_t)(row0 + ai * 128 + m * 16) * ZP + ZC_GM + nb * 1024 + col0 + bj * 128);
            if (nb > 0) {
#pragma unroll
                for (int m = 0; m < 4; ++m)
#pragma unroll
                    for (int bj = 0; bj < 2; ++bj) pw[m][bj] = *(const u32x4*)(MRG + (size_t)(row0 + ai * 128 + m * 16) * DM + col0 + bj * 128);
            } else {
#pragma unroll
                for (int m = 0; m < 4; ++m)
#pragma unroll
                    for (int bj = 0; bj < 2; ++bj) pw[m][bj] = (u32x4){0u, 0u, 0u, 0u};
            }
#pragma unroll
            for (int m = 0; m < 4; ++m) { const size_t row = (size_t)(row0 + ai * 128 + m * 16);
#pragma unroll
                for (int bj = 0; bj < 2; ++bj) { const int col = col0 + bj * 128; const u32x4 g = gw[m][bj], p = pw[m][bj];
                    f32x4 v0 = acc[ai][bj][m][0], v1 = acc[ai][bj][m][1];
                    v0[0] *= bflo(g.x); v0[1] *= bfhi(g.x); v0[2] *= bflo(g.y); v0[3] *= bfhi(g.y); v1[0] *= bflo(g.z); v1[1] *= bfhi(g.z); v1[2] *= bflo(g.w); v1[3] *= bfhi(g.w);
                    v0[0] += bflo(p.x); v0[1] += bfhi(p.x); v0[2] += bflo(p.y); v0[3] += bfhi(p.y); v1[0] += bflo(p.z); v1[1] += bfhi(p.z); v1[2] += bflo(p.w); v1[3] += bfhi(p.w);
                    *(u32x4*)(MRG + row * DM + col) = pack8(v0, v1); } }
        }
    }
};

struct SchedWo {
    pg8::TileOrder o;
    __device__ __forceinline__ bool next(int i, Unit& u) const { int pm, pn; if (!o.tile(i, pm, pn)) return false; u.pm = pm; u.pn = pn; u.aux = 0;
        u.aoff = (size_t)pm * 256 * DM * 2; u.boff = (size_t)pn * 256 * DM * 2; return true; }
};
struct EpiWo {
    const float* X; const bf16_t* Xb; bf16_t* V1;
    __device__ __forceinline__ void operator()(AccT acc, const Unit& u, int wr, int wc, int fr, int fq) const {
        const int row0 = u.pm * 256 + wr * 64 + fr, col0 = u.pn * 256 + wc * 32 + 8 * fq;
#pragma unroll
        for (int ai = 0; ai < 2; ++ai) {
            f32x4 xr[4][2][2];
#pragma unroll
            for (int m = 0; m < 4; ++m) { const size_t off = (size_t)(row0 + ai * 128 + m * 16) * DM + col0;
#pragma unroll
                for (int bj = 0; bj < 2; ++bj) {
                    if (X) { xr[m][bj][0] = *(const f32x4*)(X + off + bj * 128); xr[m][bj][1] = *(const f32x4*)(X + off + bj * 128 + 4); }
                    else { const u32x4 w = *(const u32x4*)(Xb + off + bj * 128); xr[m][bj][0] = (f32x4){bflo(w.x), bfhi(w.x), bflo(w.y), bfhi(w.y)}; xr[m][bj][1] = (f32x4){bflo(w.z), bfhi(w.z), bflo(w.w), bfhi(w.w)}; } } }
#pragma unroll
            for (int m = 0; m < 4; ++m) { const size_t off = (size_t)(row0 + ai * 128 + m * 16) * DM + col0;
#pragma unroll
                for (int bj = 0; bj < 2; ++bj) *(u32x4*)(V1 + off + bj * 128) = pack8(xr[m][bj][0] * ALPHA + acc[ai][bj][m][0], xr[m][bj][1] * ALPHA + acc[ai][bj][m][1]); }
        }
    }
};

struct SchedMoe {
    const int* blk; int nblk, G, c, ntn, nrowB, first;
    __device__ __forceinline__ bool next(int i, Unit& u) const { const long L = (long)first + (long)i * G + c; const int b = (int)(L / ntn), tn = (int)(L % ntn); if (b >= nblk) return false; const int e = blk[b];
        u.pm = b; u.pn = tn; u.aux = e; u.aoff = (size_t)b * 256 * DM * 2; u.boff = ((size_t)e * nrowB + tn * 256) * DM * 2; return true; }
};
struct EpiMoe1 {
    bf16_t* ACT; const float* b1;
    __device__ __forceinline__ void operator()(AccT acc, const Unit& u, int wr, int wc, int fr, int fq) const {
        const int e = u.aux, row0 = u.pm * 256 + wr * 64 + fr, cg0 = u.pn * 128 + wc * 32 + 8 * fq;
        const float* bp = b1 + (size_t)e * 2048 + cg0;
        const f32x4 bg0 = *(const f32x4*)bp, bg1 = *(const f32x4*)(bp + 4), bu0 = *(const f32x4*)(bp + 1024), bu1 = *(const f32x4*)(bp + 1028);
#pragma unroll
        for (int ai = 0; ai < 2; ++ai)
#pragma unroll
            for (int m = 0; m < 4; ++m) { const size_t row = (size_t)(row0 + ai * 128 + m * 16);
                f32x4 g0 = acc[ai][0][m][0] + bg0, g1 = acc[ai][0][m][1] + bg1, u0 = acc[ai][1][m][0] + bu0, u1 = acc[ai][1][m][1] + bu1, a0, a1;
#pragma unroll
                for (int i = 0; i < 4; ++i) {
                    float gg = fminf(g0[i], 7.f), uu = fminf(fmaxf(u0[i], -7.f), 7.f); a0[i] = (uu + 1.f) * (gg * sigmoidf_(1.702f * gg));
                    gg = fminf(g1[i], 7.f); uu = fminf(fmaxf(u1[i], -7.f), 7.f); a1[i] = (uu + 1.f) * (gg * sigmoidf_(1.702f * gg)); }
                *(u32x4*)(ACT + row * DM + cg0) = pack8(a0, a1); }
    }
};
struct EpiMoe2 {
    bf16_t* YB; const float* b2; const float* sg;
    __device__ __forceinline__ void operator()(AccT acc, const Unit& u, int wr, int wc, int fr, int fq) const {
        const int e = u.aux, row0 = u.pm * 256 + wr * 64 + fr, col0 = u.pn * 256 + wc * 32 + 8 * fq;
        f32x4 bv[2][2]; float gtv[2][4];
#pragma unroll
        for (int bj = 0; bj < 2; ++bj) { const float* bp = b2 + (size_t)e * DM + col0 + bj * 128; bv[bj][0] = *(const f32x4*)bp; bv[bj][1] = *(const f32x4*)(bp + 4); }
#pragma unroll
        for (int ai = 0; ai < 2; ++ai)
#pragma unroll
            for (int m = 0; m < 4; ++m) gtv[ai][m] = sg[(size_t)(row0 + ai * 128 + m * 16)];
#pragma unroll
        for (int ai = 0; ai < 2; ++ai)
#pragma unroll
            for (int m = 0; m < 4; ++m) { const size_t row = (size_t)(row0 + ai * 128 + m * 16); const float gt = gtv[ai][m];
#pragma unroll
                for (int bj = 0; bj < 2; ++bj) {
                    const f32x4 v0 = (acc[ai][bj][m][0] + bv[bj][0]) * gt, v1 = (acc[ai][bj][m][1] + bv[bj][1]) * gt;
                    *(u32x4*)(YB + row * DM + col0 + bj * 128) = pack8(v0, v1); } }
    }
};

struct SchedMoeT {
    const int* blk; int nblk, G, c, l; unsigned* arrive;
    __device__ __forceinline__ bool next(int i, Unit& u) const {
        const int L = i * G + c, N1 = nblk * 8, tail = N1 % G; u.idx = i;
        if (L < N1) { const int b = L >> 3, tn = L & 7, e = blk[b]; u.pm = b; u.pn = tn; u.aux = e;
            u.aoff = WS_XS + (size_t)b * 256 * DM * 2; u.boff = WS_WM1 + (size_t)l * WM1_L + ((size_t)e * 2048 + tn * 256) * DM * 2; return true; }
        if (tail == 0 || i != N1 / G || i < 2) return false;
        const int j = c - tail, b = j >> 2, tn = j & 3; if (j < 0 || b >= nblk) return false;
        const int e = blk[b]; u.pm = b; u.pn = 8 + tn; u.aux = e;
        u.aoff = WS_ACT + (size_t)b * 256 * DM * 2; u.boff = WS_WM2 + (size_t)l * WM2_L + ((size_t)e * 1024 + tn * 256) * DM * 2;
        unsigned sp = 0u;
        while ((unsigned)__builtin_amdgcn_readfirstlane((int)__hip_atomic_load(arrive, __ATOMIC_RELAXED, __HIP_MEMORY_SCOPE_AGENT)) < (unsigned)G) { __builtin_amdgcn_s_sleep(1); if (++sp > (1u << 24)) break; }
        __builtin_amdgcn_fence(__ATOMIC_ACQUIRE, "agent");
        return true;
    }
};
struct EpiMoeT {
    EpiMoe1 e1; EpiMoe2 e2; unsigned* arrive; bool publish;
    __device__ __forceinline__ void operator()(AccT acc, const Unit& u, int wr, int wc, int fr, int fq) const {
        if (u.pn < 8) {
            e1(acc, u, wr, wc, fr, fq);
            if (publish && u.idx == 1) {
                asm volatile("s_waitcnt vmcnt(0)" ::: "memory");
                __builtin_amdgcn_s_barrier();
                if (wr == 0 && wc == 0 && (fr | fq) == 0) { __builtin_amdgcn_fence(__ATOMIC_RELEASE, "agent"); asm volatile("s_waitcnt vmcnt(0)" ::: "memory"); (void)__hip_atomic_fetch_add(arrive, 1u, __ATOMIC_RELAXED, __HIP_MEMORY_SCOPE_AGENT); }
            }
        } else { Unit v = u; v.pn = u.pn - 8; e2(acc, v, wr, wc, fr, fq); }
    }
};

struct EpiInProjT {
    EpiInProj e; unsigned* arrive; bool publish;
    __device__ __forceinline__ void operator()(AccT acc, const Unit& u, int wr, int wc, int fr, int fq) const {
        e(acc, u, wr, wc, fr, fq);
        if (publish && u.pn < 2) {
            asm volatile("s_waitcnt vmcnt(0)" ::: "memory");
            __builtin_amdgcn_s_barrier();
            if (wr == 0 && wc == 0 && (fr | fq) == 0) { __builtin_amdgcn_fence(__ATOMIC_RELEASE, "agent"); asm volatile("s_waitcnt vmcnt(0)" ::: "memory"); (void)__hip_atomic_fetch_add(arrive, 1u, __ATOMIC_RELAXED, __HIP_MEMORY_SCOPE_AGENT); }
        }
    }
};
namespace attc {
enum { M_FOX = 0, M_WIN = 1, M_SLC = 2, M_CMP = 3 };
constexpr int KB0 = 0, KBSZ = 8448  , VB0 = 2 * KBSZ, VBSZ = 8192;
constexpr int IMP_OFF = VB0 + 2 * VBSZ;
constexpr int IMP_W = 132;
constexpr int KEY_OFF = IMP_OFF + 8 * 8 * IMP_W * 4;
constexpr int LDS_NEED = KEY_OFF + 8 * 8 * 128 * 4;
typedef short v4i16_t __attribute__((ext_vector_type(4)));
typedef short s16x4 __attribute__((ext_vector_type(4)));

struct P { const bf16_t* Z; const bf16_t* KV; const float* S32; const float* cum; const bf16_t* KC; const bf16_t* VC; unsigned* sel; float* onsa; bf16_t* YS; };

__device__ __forceinline__ s16x4 vtr(LAS const unsigned char* p) { return __builtin_bit_cast(s16x4, __builtin_amdgcn_ds_read_tr16_b64_v4i16((LAS v4i16_t*)p)); }
#define MFMA32C(a, b, c) __builtin_amdgcn_mfma_f32_32x32x16_bf16((a), (b), (c), 0, 0, 0)

#define LDS_BARC() asm volatile("s_waitcnt lgkmcnt(0)\n\ts_barrier" ::: "memory")

template <int MODE, int PASS>
__device__ __forceinline__ void attn_steps(LAS unsigned char* lds, f32x16& o0, f32x16& o1, float& m_run, float& lsum, bool& shifted, const float inv_l, const bf16x8 (&qf)[4],
                                           const bf16_t* kld, const bf16_t* vld, const float* cumk, const int kp,
                                           const int t_lo, const int nT, const int qb, const int tq, const float cq, const unsigned sel0, const unsigned sel1, const unsigned sel2, const unsigned sel3,
                                           LAS float* impw, const int tid, const int lane, const int wid) {
#ifndef HALF_EXPR
#define HALF_EXPR (wid >> 2)
#endif
    const int r32 = lane & 31, hi = lane >> 5, half = HALF_EXPR;
    const float NEG_INF = -__builtin_inff();
    const unsigned kst = (unsigned)(wid * 1024 + lane * 16);
    const int vrow = (tid >> 2) & 63, vch = (tid & 3) | ((tid >> 8) << 2);
    const unsigned vst = (unsigned)(1024 * (vrow >> 3) + 512 * (vch >> 2) + 64 * (vrow & 7) + 16 * (vch & 3));
    const unsigned kfb = (unsigned)(hi * 1024 + r32 * 16);
    const unsigned vfb = (unsigned)(256 * hi + 64 * ((lane & 15) >> 2) + 32 * ((lane >> 4) & 1) + 8 * (lane & 3));
    u32x4 kr = {0u, 0u, 0u, 0u}, vr = {0u, 0u, 0u, 0u}; float br = 0.f;
    f32x16 p0, p1; bf16x8 pk00, pk01, pk10, pk11;
#define SELBIT(tt) ((((tt) < 64) ? (((tt) < 32) ? sel0 : sel1) : (((tt) < 96) ? sel2 : sel3)) >> ((tt) & 31)) & 1u
#define LOAD_SET(w) do { if ((w) + 1 < nT) { kr = *(const u32x4*)(kld + (size_t)(t_lo + (w) + 1) * 64 * kp); if (MODE == M_FOX) { if (tid < 64) br = cumk[(t_lo + (w) + 1) * 64 + tid]; } } \
        if (PASS != 0) { if ((w) < nT) vr = *(const u32x4*)(vld + (size_t)(t_lo + (w)) * 64 * kp); } } while (0)
#define WRITE_SET(w) do { if ((w) + 1 < nT) { LAS unsigned char* kb_ = lds + KB0 + (((w) + 1) & 1) * KBSZ; *(LAS u32x4*)(kb_ + kst) = kr; if (MODE == M_FOX) { if (tid < 64) *(LAS float*)(kb_ + 8192 + tid * 4) = br; } } \
        if (PASS != 0) { if ((w) < nT) *(LAS u32x4*)(lds + VB0 + ((w) & 1) * VBSZ + vst) = vr; } } while (0)
#define QK_TILE(j) do { LAS const unsigned char* kbuf_ = lds + KB0 + ((j) & 1) * KBSZ; \
        if (MODE == M_FOX) { LAS const float* bs_ = (LAS const float*)(kbuf_ + 8192); const float cqm_ = cq - m_run; \
            _Pragma("unroll") for (int g4 = 0; g4 < 4; ++g4) { const f32x4 c0_ = *(LAS const f32x4*)(bs_ + 8 * g4 + 4 * hi), c1_ = *(LAS const f32x4*)(bs_ + 32 + 8 * g4 + 4 * hi); \
                _Pragma("unroll") for (int i = 0; i < 4; ++i) { p0[4 * g4 + i] = cqm_ - c0_[i]; p1[4 * g4 + i] = cqm_ - c1_[i]; } } \
        } else { _Pragma("unroll") for (int r = 0; r < 16; ++r) { p0[r] = 0.f; p1[r] = 0.f; } } \
        _Pragma("unroll") for (int ds = 0; ds < 4; ++ds) { const bf16x8 k0_ = *(LAS const bf16x8*)(kbuf_ + kfb + ds * 2048), k1_ = *(LAS const bf16x8*)(kbuf_ + kfb + ds * 2048 + 512); \
            p0 = MFMA32C(k0_, qf[ds], p0); p1 = MFMA32C(k1_, qf[ds], p1); } } while (0)

    {
        const u32x4 kr0 = *(const u32x4*)(kld + (size_t)t_lo * 64 * kp);
        float br0 = 0.f; if (MODE == M_FOX) { if (tid < 64) br0 = cumk[t_lo * 64 + tid]; }
        LOAD_SET(0);
        *(LAS u32x4*)(lds + KB0 + kst) = kr0;
        if (MODE == M_FOX) { if (tid < 64) *(LAS float*)(lds + KB0 + 8192 + tid * 4) = br0; }
    }
    LDS_BARC();
    if (half == 1) LDS_BARC();
    { bool act0 = true; if (MODE == M_SLC) { const bool mine0 = SELBIT(t_lo); act0 = __any(mine0); }
      if (act0) QK_TILE(0); }
    if (half == 1) { WRITE_SET(0); LOAD_SET(1); }
    LDS_BARC();
#pragma unroll 1
    for (int it = 0; it < nT; ++it) {
        const int t = t_lo + it;
        bool act = true, mine = true;
        if (MODE == M_SLC) { mine = SELBIT(t); act = __any(mine); }
        if (act) {
            if (MODE != M_FOX && shifted) {
#pragma unroll
                for (int r = 0; r < 16; ++r) { p0[r] -= m_run; p1[r] -= m_run; } }
            const int kv0 = t * 64 + 4 * hi;
            if (MODE == M_FOX) {
                if (t >= 4 * qb) {
#pragma unroll
                    for (int r = 0; r < 16; ++r) { const int kv = kv0 + (r & 3) + 8 * (r >> 2); if (kv > tq) p0[r] = NEG_INF; if (kv + 32 > tq) p1[r] = NEG_INF; } }
            } else if (MODE == M_WIN) {
                if (t == qb || t == qb - 8) {
#pragma unroll
                    for (int r = 0; r < 16; ++r) { const int kv = kv0 + (r & 3) + 8 * (r >> 2); if (kv > tq || kv <= tq - 512) p0[r] = NEG_INF; if (kv + 32 > tq || kv + 32 <= tq - 512) p1[r] = NEG_INF; } }
            } else if (MODE == M_SLC) {
                if (t == qb || !mine) {
#pragma unroll
                    for (int r = 0; r < 16; ++r) { const int kv = kv0 + (r & 3) + 8 * (r >> 2); if (!mine || kv > tq) p0[r] = NEG_INF; if (!mine || kv + 32 > tq) p1[r] = NEG_INF; } }
            } else {
#pragma unroll
                for (int r = 0; r < 16; ++r) { const int c = kv0 + (r & 3) + 8 * (r >> 2); if (16 * c + 31 > tq) p0[r] = NEG_INF; if (16 * (c + 32) + 31 > tq) p1[r] = NEG_INF; }
            }
#pragma unroll
            for (int r = 0; r < 16; ++r) { p0[r] = __builtin_amdgcn_exp2f(p0[r]); p1[r] = __builtin_amdgcn_exp2f(p1[r]); }
            if (PASS != 1) {
                float mx = fmaxf(p0[0], p1[0]);
#pragma unroll
                for (int r = 1; r < 16; ++r) mx = fmaxf(mx, fmaxf(p0[r], p1[r]));
                { const auto rr = __builtin_amdgcn_permlane32_swap(__float_as_uint(mx), __float_as_uint(mx), false, false); mx = fmaxf(__uint_as_float(rr[0]), __uint_as_float(rr[1])); }
                if (__any(mx > 256.f)) {
                    const float dl = mx > 1.f ? __builtin_amdgcn_logf(mx) : 0.f;
                    const float scl = __builtin_amdgcn_exp2f(-dl);
                    m_run += dl; shifted = true; lsum *= scl;
#pragma unroll
                    for (int r = 0; r < 16; ++r) { p0[r] *= scl; p1[r] *= scl; }
                    if (PASS == 2) {
#pragma unroll
                        for (int r = 0; r < 16; ++r) { o0[r] *= scl; o1[r] *= scl; } }
                }
                float ls = 0.f;
#pragma unroll
                for (int r = 0; r < 16; ++r) ls += p0[r] + p1[r];
                lsum += ls;
            }
            if (PASS != 0) {
                if (PASS == 1) {
#pragma unroll
                    for (int r = 0; r < 16; ++r) { p0[r] *= inv_l; p1[r] *= inv_l; } }
                u32x4 w;
                w.x = cvtpk(p0[0], p0[1]); w.y = cvtpk(p0[2], p0[3]); w.z = cvtpk(p0[4], p0[5]); w.w = cvtpk(p0[6], p0[7]); pk00 = __builtin_bit_cast(bf16x8, w);
                w.x = cvtpk(p0[8], p0[9]); w.y = cvtpk(p0[10], p0[11]); w.z = cvtpk(p0[12], p0[13]); w.w = cvtpk(p0[14], p0[15]); pk01 = __builtin_bit_cast(bf16x8, w);
                w.x = cvtpk(p1[0], p1[1]); w.y = cvtpk(p1[2], p1[3]); w.z = cvtpk(p1[4], p1[5]); w.w = cvtpk(p1[6], p1[7]); pk10 = __builtin_bit_cast(bf16x8, w);
                w.x = cvtpk(p1[8], p1[9]); w.y = cvtpk(p1[10], p1[11]); w.z = cvtpk(p1[12], p1[13]); w.w = cvtpk(p1[14], p1[15]); pk11 = __builtin_bit_cast(bf16x8, w);
            }
        }
#ifdef PROBE_VALU
        if (MODE == M_FOX) { float acc_ = 0.f;
#pragma unroll
            for (int r = 0; r < 16; ++r) { float x0_ = p0[r], x1_ = p1[r]; asm volatile("v_exp_f32 %0, %0\n\tv_exp_f32 %1, %1" : "+v"(x0_), "+v"(x1_)); acc_ += x0_ + x1_; }
            asm volatile("" :: "v"(acc_)); }
#endif
        if (PASS != 0) asm volatile("" : "+v"(pk00), "+v"(pk01), "+v"(pk10), "+v"(pk11));
        asm volatile("" : "+v"(lsum));
        { const int w = it + half; WRITE_SET(w); LOAD_SET(w + 1); }
        LDS_BARC();
#ifdef PROBE_BAR
        LDS_BARC(); LDS_BARC();
#endif
        const bool doPV = (PASS != 0) && act;
        bool doQK = it + 1 < nT;
        if (MODE == M_SLC) { if (doQK) { const bool minen = SELBIT(t + 1); doQK = __any(minen); } }
        bf16x8 vf[4][2], kf[8]; f32x4 bc[8];
        if (doPV) {
            LAS const unsigned char* vb = lds + VB0 + (it & 1) * VBSZ + vfb;
#pragma unroll
            for (int q4 = 0; q4 < 4; ++q4) { const s16x4 a0_ = vtr(vb + 2048 * q4), a1_ = vtr(vb + 2048 * q4 + 1024), c0_ = vtr(vb + 2048 * q4 + 512), c1_ = vtr(vb + 2048 * q4 + 1536);
                vf[q4][0] = (bf16x8){a0_[0], a0_[1], a0_[2], a0_[3], a1_[0], a1_[1], a1_[2], a1_[3]}; vf[q4][1] = (bf16x8){c0_[0], c0_[1], c0_[2], c0_[3], c1_[0], c1_[1], c1_[2], c1_[3]}; }
        }
        if (doQK) {
            LAS const unsigned char* kbuf_ = lds + KB0 + ((it + 1) & 1) * KBSZ;
#pragma unroll
            for (int ds = 0; ds < 4; ++ds) { kf[2 * ds] = *(LAS const bf16x8*)(kbuf_ + kfb + ds * 2048); kf[2 * ds + 1] = *(LAS const bf16x8*)(kbuf_ + kfb + ds * 2048 + 512); }
            if (MODE == M_FOX) { LAS const float* bs_ = (LAS const float*)(kbuf_ + 8192);
#pragma unroll
                for (int g4 = 0; g4 < 4; ++g4) { bc[2 * g4] = *(LAS const f32x4*)(bs_ + 8 * g4 + 4 * hi); bc[2 * g4 + 1] = *(LAS const f32x4*)(bs_ + 32 + 8 * g4 + 4 * hi); } }
        }
        __builtin_amdgcn_sched_barrier(0);
        if (doPV) {
            o0 = MFMA32C(vf[0][0], pk00, o0); o1 = MFMA32C(vf[0][1], pk00, o1);
            o0 = MFMA32C(vf[1][0], pk01, o0); o1 = MFMA32C(vf[1][1], pk01, o1);
            o0 = MFMA32C(vf[2][0], pk10, o0); o1 = MFMA32C(vf[2][1], pk10, o1);
            o0 = MFMA32C(vf[3][0], pk11, o0); o1 = MFMA32C(vf[3][1], pk11, o1);
            if (MODE == M_CMP) {
                f32x16 di;
                int r32o = r32, hio = hi; asm volatile("" : "+v"(r32o), "+v"(hio));
#pragma unroll
                for (int r = 0; r < 16; ++r) di[r] = 0.f;
#define IMP_STEP(KB, SS, PKX) do { bf16x8 ov_; _Pragma("unroll") for (int j = 0; j < 8; ++j) { const int cl_ = 32 * (KB) + 16 * (SS) + 8 * (j >> 2) + 4 * hio + (j & 3); ov_[j] = (cl_ >= 4 * r32o - 1 && cl_ <= 4 * r32o + 3) ? (short)0x3F80 : (short)0; } \
                di = MFMA32C(PKX, ov_, di); } while (0)
                IMP_STEP(0, 0, pk00); IMP_STEP(0, 1, pk01); IMP_STEP(1, 0, pk10); IMP_STEP(1, 1, pk11);
#undef IMP_STEP
                if (r32 <= 16) {
#pragma unroll
                    for (int j = 0; j < 4; ++j) { const float v = (di[j] + di[j + 4]) + (di[j + 8] + di[j + 12]); LAS float* ip = impw + (4 * hi + j) * IMP_W + 16 * t + r32; *ip = *ip + v; }
                }
            }
        }
        if (doQK) {
            if (MODE == M_FOX) { const float cqm_ = cq - m_run;
#pragma unroll
                for (int g4 = 0; g4 < 4; ++g4)
#pragma unroll
                    for (int i = 0; i < 4; ++i) { p0[4 * g4 + i] = cqm_ - bc[2 * g4][i]; p1[4 * g4 + i] = cqm_ - bc[2 * g4 + 1][i]; }
            } else {
#pragma unroll
                for (int r = 0; r < 16; ++r) { p0[r] = 0.f; p1[r] = 0.f; } }
#pragma unroll
            for (int ds = 0; ds < 4; ++ds) { p0 = MFMA32C(kf[2 * ds], qf[ds], p0); p1 = MFMA32C(kf[2 * ds + 1], qf[ds], p1); }
        }
        LDS_BARC();
    }
    if (half == 0) LDS_BARC();
#undef SELBIT
#undef LOAD_SET
#undef WRITE_SET
#undef QK_TILE
}

template <int MODE>
__device__ __forceinline__ void attn_unit(LAS unsigned char* lds, const P& A, const int b, const int hg, const int qb) {
    const int tid = opaque_tid(), lane = tid & 63, wid = __builtin_amdgcn_readfirstlane(tid >> 6), r32 = lane & 31, hi = lane >> 5;
    int tq, qcol, hh = 0;
    if (MODE == M_FOX) { tq = qb * 256 + wid * 32 + r32; qcol = ZC_FOX + hg * 64; }
    else { hh = r32 >> 3; tq = qb * 64 + wid * 8 + (r32 & 7); qcol = ZC_QN + (hg * 4 + hh) * 64; }
    const size_t tokrow = (size_t)b * SEQ + tq;
    bf16x8 qf[4];
    { const bf16_t* qp = A.Z + tokrow * ZP + qcol + hi * 8;
#pragma unroll
      for (int ds = 0; ds < 4; ++ds) qf[ds] = *(const bf16x8*)(qp + ds * 16); }
    const bf16_t *Kg, *Vg; int kp, t_lo, t_hi;
    const bf16_t* KVb = A.KV + (size_t)b * NSTREAM * SEQ * 64;
    if (MODE == M_FOX) { Kg = KVb + (size_t)(12 + hg) * SEQ * 64; Vg = KVb + (size_t)(20 + hg) * SEQ * 64; kp = 64; t_lo = 0; t_hi = 4 * qb + 3; }
    else if (MODE == M_WIN) { Kg = KVb + (size_t)(8 + hg) * SEQ * 64; Vg = KVb + (size_t)(10 + hg) * SEQ * 64; kp = 64; t_lo = qb > 8 ? qb - 8 : 0; t_hi = qb; }
    else if (MODE == M_SLC) { Kg = KVb + (size_t)(4 + hg) * SEQ * 64; Vg = KVb + (size_t)(6 + hg) * SEQ * 64; kp = 64; t_lo = 0; t_hi = qb; }
    else { Kg = A.KC + (size_t)(b * 2 + hg) * 512 * 64; Vg = A.VC + (size_t)(b * 2 + hg) * 512 * 64; kp = 64; t_lo = 0; t_hi = (4 * qb + 2) >> 6; if (t_hi > 7) t_hi = 7; }
    const int nT = t_hi - t_lo + 1;
    const bf16_t* kld = Kg + (size_t)lane * kp + wid * 8;
    const int vrow = (tid >> 2) & 63, vch = (tid & 3) | ((tid >> 8) << 2);
    const bf16_t* vld = Vg + (size_t)vrow * kp + vch * 8;
    const float* cumk = nullptr; float cq = 0.f;
    if (MODE == M_FOX) { cumk = A.cum + (size_t)(b * 8 + hg) * SEQ; cq = cumk[tq]; }
    unsigned sel0 = 0u, sel1 = 0u, sel2 = 0u, sel3 = 0u;
    if (MODE == M_SLC) { const u32x4 s4 = *(const u32x4*)(A.sel + ((size_t)(b * 2 + hg) * SEQ + tq) * 4); sel0 = s4.x; sel1 = s4.y; sel2 = s4.z; sel3 = s4.w; }

    asm volatile("" : "+v"(qf[0]), "+v"(qf[1]), "+v"(qf[2]), "+v"(qf[3]));
    asm volatile("" : "+v"(cq), "+v"(sel0), "+v"(sel1), "+v"(sel2), "+v"(sel3));
    f32x16 o0, o1;
#pragma unroll
    for (int r = 0; r < 16; ++r) { o0[r] = 0.f; o1[r] = 0.f; }
    float m_run = 0.f, lsum = 0.f; bool shifted = false;
    LAS float* impw = (LAS float*)(lds + IMP_OFF) + wid * 8 * IMP_W;
    float sc;
    if (MODE == M_CMP) {
        for (int i = lane; i < 8 * IMP_W; i += 64) impw[i] = 0.f;
        attn_steps<MODE, 0>(lds, o0, o1, m_run, lsum, shifted, 0.f, qf, kld, vld, cumk, kp, t_lo, nT, qb, tq, cq, sel0, sel1, sel2, sel3, impw, tid, lane, wid);
        float inv_l;
        { const auto rr = __builtin_amdgcn_permlane32_swap(__float_as_uint(lsum), __float_as_uint(lsum), false, false); const float lt = __uint_as_float(rr[0]) + __uint_as_float(rr[1]); inv_l = lt > 0.f ? 1.f / lt : 0.f; }
        attn_steps<MODE, 1>(lds, o0, o1, m_run, lsum, shifted, inv_l, qf, kld, vld, cumk, kp, t_lo, nT, qb, tq, cq, sel0, sel1, sel2, sel3, impw, tid, lane, wid);
        sc = 1.f;
    } else {
        attn_steps<MODE, 2>(lds, o0, o1, m_run, lsum, shifted, 0.f, qf, kld, vld, cumk, kp, t_lo, nT, qb, tq, cq, sel0, sel1, sel2, sel3, impw, tid, lane, wid);
        const auto rr = __builtin_amdgcn_permlane32_swap(__float_as_uint(lsum), __float_as_uint(lsum), false, false); const float lt = __uint_as_float(rr[0]) + __uint_as_float(rr[1]);
        sc = lt > 0.f ? 1.f / lt : 0.f;
    }
    if (MODE == M_FOX) {
        bf16_t* op = A.YS + tokrow * 1536 + 1024 + hg * 64 + 4 * hi;
#pragma unroll
        for (int g4 = 0; g4 < 4; ++g4) {
            u32x2 w; w.x = cvtpk(o0[4 * g4] * sc, o0[4 * g4 + 1] * sc); w.y = cvtpk(o0[4 * g4 + 2] * sc, o0[4 * g4 + 3] * sc); *(u32x2*)(op + 8 * g4) = w;
            w.x = cvtpk(o1[4 * g4] * sc, o1[4 * g4 + 1] * sc); w.y = cvtpk(o1[4 * g4 + 2] * sc, o1[4 * g4 + 3] * sc); *(u32x2*)(op + 32 + 8 * g4) = w;
        }
    } else {
        const int br = (MODE == M_CMP) ? 0 : (MODE == M_SLC) ? 1 : 2;
        const float gsc = sc * A.S32[tokrow * 32 + (hg * 4 + hh) * 3 + br];
        bf16_t* np = (bf16_t*)A.onsa + tokrow * 512 + (hg * 4 + hh) * 64 + 4 * hi;
        bf16_t* op = A.YS + tokrow * 1536 + 512 + (hg * 4 + hh) * 64 + 4 * hi;
#pragma unroll
        for (int g4 = 0; g4 < 4; ++g4) {
            f32x4 v0 = {o0[4 * g4] * gsc, o0[4 * g4 + 1] * gsc, o0[4 * g4 + 2] * gsc, o0[4 * g4 + 3] * gsc};
            f32x4 v1 = {o1[4 * g4] * gsc, o1[4 * g4 + 1] * gsc, o1[4 * g4 + 2] * gsc, o1[4 * g4 + 3] * gsc};
            if (MODE != M_CMP) { const u32x2 a0_ = *(const u32x2*)(np + 8 * g4), a1_ = *(const u32x2*)(np + 32 + 8 * g4);
                v0[0] += bflo(a0_.x); v0[1] += bfhi(a0_.x); v0[2] += bflo(a0_.y); v0[3] += bfhi(a0_.y); v1[0] += bflo(a1_.x); v1[1] += bfhi(a1_.x); v1[2] += bflo(a1_.y); v1[3] += bfhi(a1_.y); }
            if (MODE != M_WIN) { u32x2 w_; w_.x = cvtpk(v0[0], v0[1]); w_.y = cvtpk(v0[2], v0[3]); *(u32x2*)(np + 8 * g4) = w_; w_.x = cvtpk(v1[0], v1[1]); w_.y = cvtpk(v1[2], v1[3]); *(u32x2*)(np + 32 + 8 * g4) = w_; }
            else { u32x2 w; w.x = cvtpk(v0[0], v0[1]); w.y = cvtpk(v0[2], v0[3]); *(u32x2*)(op + 8 * g4) = w; w.x = cvtpk(v1[0], v1[1]); w.y = cvtpk(v1[2], v1[3]); *(u32x2*)(op + 32 + 8 * g4) = w; }
        }
    }
    if (MODE == M_CMP) {
        const int ql = lane >> 3, sub = lane & 7, cur = qb;
        LAS const float* row = impw + ql * IMP_W;
        LAS unsigned* keys = (LAS unsigned*)(lds + KEY_OFF) + wid * 8 * 128 + ql * 128;
#pragma unroll
        for (int i4 = 0; i4 < 4; ++i4) { u32x4 kq;
#pragma unroll
            for (int i = 0; i < 4; ++i) { const int s = sub * 16 + i4 * 4 + i; float v = row[s]; if (s == 0 || s == cur || s == cur - 1) v = 1e6f;
                kq[i] = (s <= cur) ? (((__float_as_uint(v) & ~0x7Fu) | (unsigned)(127 - s)) | 0x80000000u) : 0u; }
            *(LAS u32x4*)(keys + sub * 16 + i4 * 4) = kq; }
        unsigned bits = 0u;
#pragma unroll 1
        for (int half = 0; half < 2; ++half) {
            unsigned kown[8]; int rank[8];
            { const u32x4 k0 = *(LAS const u32x4*)(keys + sub * 16 + half * 8), k1 = *(LAS const u32x4*)(keys + sub * 16 + half * 8 + 4);
              kown[0] = k0.x; kown[1] = k0.y; kown[2] = k0.z; kown[3] = k0.w; kown[4] = k1.x; kown[5] = k1.y; kown[6] = k1.z; kown[7] = k1.w; }
#pragma unroll
            for (int i = 0; i < 8; ++i) rank[i] = 0;
#pragma unroll 2
            for (int sp4 = 0; sp4 <= (cur >> 2); ++sp4) {
                const u32x4 kk = *(LAS const u32x4*)(keys + sp4 * 4);
#pragma unroll
                for (int i = 0; i < 8; ++i) rank[i] += (kk.x > kown[i] ? 1 : 0) + (kk.y > kown[i] ? 1 : 0) + (kk.z > kown[i] ? 1 : 0) + (kk.w > kown[i] ? 1 : 0);
            }
#pragma unroll
            for (int i = 0; i < 8; ++i) { if (kown[i] != 0u && rank[i] < 16) bits |= (1u << (half * 8 + i)); }
        }
        unsigned w = bits << (16 * (sub & 1));
        w |= __shfl_xor(w, 1);
        if ((sub & 1) == 0) A.sel[((size_t)(b * 2 + hg) * SEQ + qb * 64 + wid * 8 + ql) * 4 + (sub >> 1)] = w;
    }
    __syncthreads();
}
#undef MFMA32C
}
namespace att {
enum { M_FOX = 0, M_WIN = 1, M_SLC = 2, M_CMP = 3 };
#ifndef SLC_TWO_BURST
#define SLC_TWO_BURST 1
#endif
#ifndef NB_FOX
#define NB_FOX 2
#endif
#ifndef NB_SLC
#define NB_SLC 2
#endif
#ifndef NB_WIN
#define NB_WIN 2
#endif
constexpr int KB0 = 0, KBSZ = 8448  , NSL = 5, VB0 = NSL * KBSZ, VBSZ = 8192;
__device__ __forceinline__ int ring_wrap(int x) { return x < 0 ? x + NSL : (x >= NSL ? x - NSL : x); }
constexpr int IMP_OFF = VB0 + NSL * VBSZ;
constexpr int IMP_W = 132;
constexpr int KEY_OFF = IMP_OFF + 8 * 8 * IMP_W * 4;
constexpr int LDS_NEED = KEY_OFF + 8 * 8 * 128 * 4;
typedef short v4i16_t __attribute__((ext_vector_type(4)));
typedef short s16x4 __attribute__((ext_vector_type(4)));

struct P { const bf16_t* Z; const bf16_t* KV; const float* S32; const float* cum; const bf16_t* KC; const bf16_t* VC; unsigned* sel; float* onsa; bf16_t* YS; };

__device__ __forceinline__ s16x4 vtr(LAS const unsigned char* p) { return __builtin_bit_cast(s16x4, __builtin_amdgcn_ds_read_tr16_b64_v4i16((LAS v4i16_t*)p)); }
#define MFMA32(a, b, c) __builtin_amdgcn_mfma_f32_32x32x16_bf16((a), (b), (c), 0, 0, 0)

#define LDS_BAR() asm volatile("s_waitcnt lgkmcnt(0)\n\ts_barrier" ::: "memory")

template <int MODE, int PASS>
__device__ __forceinline__ void attn_steps(LAS unsigned char* lds, f32x16& o0, f32x16& o1, float& m_run, float& lsum, bool& shifted, const float inv_l, const bf16x8 (&qf_in)[4],
                                           const bf16_t* kld, const bf16_t* vld, const float* cumk, const int kp,
                                           const int t_lo, const int nT, const int qb, const int tq, const float cq_in, const unsigned sel0_in, const unsigned sel1_in, const unsigned sel2_in, const unsigned sel3_in,
                                           LAS float* impw, const int tid, const int lane, const int wid) {
    const int r32 = lane & 31, hi = lane >> 5, half = (MODE == M_CMP) ? 0 : (wid >> 2);
    bf16x8 qf[4] = {qf_in[0], qf_in[1], qf_in[2], qf_in[3]}; float cq = cq_in; unsigned sel0 = sel0_in, sel1 = sel1_in, sel2 = sel2_in, sel3 = sel3_in;
    const float NEG_INF = -__builtin_inff();
    const unsigned kst = (unsigned)(wid * 1024 + lane * 16);
    const int vrow = (tid >> 2) & 63, vch = (tid & 3) | ((tid >> 8) << 2);
    const unsigned vst = (unsigned)(1024 * (vrow >> 3) + 512 * (vch >> 2) + 64 * (vrow & 7) + 16 * (vch & 3));
    const unsigned kfb = (unsigned)(hi * 1024 + r32 * 16);
    const unsigned vfb = (unsigned)(256 * hi + 64 * ((lane & 15) >> 2) + 32 * ((lane >> 4) & 1) + 8 * (lane & 3));
    u32x4 kr = {0u, 0u, 0u, 0u}, vr = {0u, 0u, 0u, 0u}; float br = 0.f;
    f32x16 p0, p1; bf16x8 pk00, pk01, pk10, pk11;
#pragma unroll
    for (int r = 0; r < 16; ++r) { p0[r] = 0.f; p1[r] = 0.f; }
    pk00 = (bf16x8){0, 0, 0, 0, 0, 0, 0, 0}; pk01 = pk00; pk10 = pk00; pk11 = pk00;
#define SELBIT(tt) ((((tt) < 64) ? (((tt) < 32) ? sel0 : sel1) : (((tt) < 96) ? sel2 : sel3)) >> ((tt) & 31)) & 1u
#define RSLOT(j) ring_wrap(sk + ((j) - i))
#define KSLOT(j) (lds + KB0 + RSLOT(j) * KBSZ)
#define VSLOT(j) (lds + VB0 + RSLOT(j) * VBSZ)
#define LOAD_KV(jk, jv) do { if ((jk) < nT) { __builtin_amdgcn_global_load_lds((const unsigned*)(kld + (size_t)(t_lo + (jk)) * 64 * kp), (LAS unsigned*)(KSLOT(jk) + wid * 1024), 16, 0, 0); \
            if (MODE == M_FOX) { if (tid < 64) br = cumk[(t_lo + (jk)) * 64 + tid]; } } \
        if (PASS != 0) { if ((jv) < nT) __builtin_amdgcn_global_load_lds((const unsigned*)(vld + (size_t)(t_lo + (jv)) * 64 * kp), (LAS unsigned*)(VSLOT(jv) + wid * 1024), 16, 0, 0); } } while (0)
#define WRITE_KV(jk, jv) do { if (MODE == M_FOX) { if ((jk) < nT) { if (tid < 64) *(LAS float*)(KSLOT(jk) + 8192 + tid * 4) = br; } } \
        asm volatile("s_waitcnt vmcnt(0)" ::: "memory"); } while (0)

#define SOFTMAX_SEG(j) do { const int t = t_lo + (j); bool mine = true, act = true; if (MODE == M_SLC) { mine = SELBIT(t); act = __any(mine); } \
    if (act) { \
        if (MODE != M_FOX && shifted) { _Pragma("unroll") for (int r = 0; r < 16; ++r) { p0[r] -= m_run; p1[r] -= m_run; } } \
        const int kv0 = t * 64 + 4 * hi; \
        if (MODE == M_FOX) { if (t >= 4 * qb) { _Pragma("unroll") for (int r = 0; r < 16; ++r) { const int kv = kv0 + (r & 3) + 8 * (r >> 2); if (kv > tq) p0[r] = NEG_INF; if (kv + 32 > tq) p1[r] = NEG_INF; } } } \
        else if (MODE == M_WIN) { if (t == qb || t == qb - 8) { _Pragma("unroll") for (int r = 0; r < 16; ++r) { const int kv = kv0 + (r & 3) + 8 * (r >> 2); if (kv > tq || kv <= tq - 512) p0[r] = NEG_INF; if (kv + 32 > tq || kv + 32 <= tq - 512) p1[r] = NEG_INF; } } } \
        else if (MODE == M_SLC) { if (t == qb) { _Pragma("unroll") for (int r = 0; r < 16; ++r) { const int kv = kv0 + (r & 3) + 8 * (r >> 2); if (kv > tq) p0[r] = NEG_INF; if (kv + 32 > tq) p1[r] = NEG_INF; } } }     \
        else { _Pragma("unroll") for (int r = 0; r < 16; ++r) { const int c = kv0 + (r & 3) + 8 * (r >> 2); if (16 * c + 31 > tq) p0[r] = NEG_INF; if (16 * (c + 32) + 31 > tq) p1[r] = NEG_INF; } } \
        _Pragma("unroll") for (int r = 0; r < 16; ++r) { p0[r] = __builtin_amdgcn_exp2f(p0[r]); p1[r] = __builtin_amdgcn_exp2f(p1[r]); } \
        if (PASS != 1) { \
            float mxa = fmaxf(p0[0], p1[0]), mxb = fmaxf(p0[1], p1[1]), mxc = fmaxf(p0[2], p1[2]), mxd = fmaxf(p0[3], p1[3]);     \
            _Pragma("unroll") for (int r = 4; r < 16; r += 4) { mxa = fmaxf(mxa, fmaxf(p0[r], p1[r])); mxb = fmaxf(mxb, fmaxf(p0[r + 1], p1[r + 1])); mxc = fmaxf(mxc, fmaxf(p0[r + 2], p1[r + 2])); mxd = fmaxf(mxd, fmaxf(p0[r + 3], p1[r + 3])); } \
            float mx = fmaxf(fmaxf(mxa, mxb), fmaxf(mxc, mxd)); \
            { const auto rr = __builtin_amdgcn_permlane32_swap(__float_as_uint(mx), __float_as_uint(mx), false, false); mx = fmaxf(__uint_as_float(rr[0]), __uint_as_float(rr[1])); } \
            if (__any(mx > 256.f)) {     \
                const float dl = mx > 1.f ? __builtin_amdgcn_logf(mx) : 0.f; const float scl = __builtin_amdgcn_exp2f(-dl); \
                m_run += dl; shifted = true; lsum *= scl; \
                _Pragma("unroll") for (int r = 0; r < 16; ++r) { p0[r] *= scl; p1[r] *= scl; } \
                if (PASS == 2) { _Pragma("unroll") for (int r = 0; r < 16; ++r) { o0[r] *= scl; o1[r] *= scl; } } \
            } \
            float lsa = 0.f, lsb = 0.f, lsc = 0.f, lsd = 0.f;     \
            _Pragma("unroll") for (int r = 0; r < 16; r += 4) { lsa += p0[r] + p1[r]; lsb += p0[r + 1] + p1[r + 1]; lsc += p0[r + 2] + p1[r + 2]; lsd += p0[r + 3] + p1[r + 3]; } \
            lsum += (lsa + lsb) + (lsc + lsd); \
        } \
        if (PASS != 0) { \
            if (PASS == 1) { _Pragma("unroll") for (int r = 0; r < 16; ++r) { p0[r] *= inv_l; p1[r] *= inv_l; } } \
            u32x4 w; \
            w.x = cvtpk(p0[0], p0[1]); w.y = cvtpk(p0[2], p0[3]); w.z = cvtpk(p0[4], p0[5]); w.w = cvtpk(p0[6], p0[7]); pk00 = __builtin_bit_cast(bf16x8, w); \
            w.x = cvtpk(p0[8], p0[9]); w.y = cvtpk(p0[10], p0[11]); w.z = cvtpk(p0[12], p0[13]); w.w = cvtpk(p0[14], p0[15]); pk01 = __builtin_bit_cast(bf16x8, w); \
            w.x = cvtpk(p1[0], p1[1]); w.y = cvtpk(p1[2], p1[3]); w.z = cvtpk(p1[4], p1[5]); w.w = cvtpk(p1[6], p1[7]); pk10 = __builtin_bit_cast(bf16x8, w); \
            w.x = cvtpk(p1[8], p1[9]); w.y = cvtpk(p1[10], p1[11]); w.z = cvtpk(p1[12], p1[13]); w.w = cvtpk(p1[14], p1[15]); pk11 = __builtin_bit_cast(bf16x8, w); \
        } \
    } \
    if (PASS != 0) asm volatile("" : "+v"(pk00), "+v"(pk01), "+v"(pk10), "+v"(pk11)); \
    asm volatile("" : "+v"(lsum)); \
    __builtin_amdgcn_sched_barrier(0); } while (0)

#define KFRAG_LOAD(jqk) do { LAS const unsigned char* kbuf_ = KSLOT(jqk); \
        _Pragma("unroll") for (int ds = 0; ds < 4; ++ds) { kf[2 * ds] = *(LAS const bf16x8*)(kbuf_ + kfb + ds * 2048); kf[2 * ds + 1] = *(LAS const bf16x8*)(kbuf_ + kfb + ds * 2048 + 512); } \
 } while (0)
#define VFRAG_LOAD(jpv) do { LAS const unsigned char* vb = VSLOT(jpv) + vfb; \
        _Pragma("unroll") for (int q4 = 0; q4 < 4; ++q4) { const s16x4 a0_ = vtr(vb + 2048 * q4), a1_ = vtr(vb + 2048 * q4 + 1024), c0_ = vtr(vb + 2048 * q4 + 512), c1_ = vtr(vb + 2048 * q4 + 1536); \
            vf[q4][0] = (bf16x8){a0_[0], a0_[1], a0_[2], a0_[3], a1_[0], a1_[1], a1_[2], a1_[3]}; vf[q4][1] = (bf16x8){c0_[0], c0_[1], c0_[2], c0_[3], c1_[0], c1_[1], c1_[2], c1_[3]}; } } while (0)
#define PV_MFMAS() do { \
        o0 = MFMA32(vf[0][0], pk00, o0); o1 = MFMA32(vf[0][1], pk00, o1); o0 = MFMA32(vf[1][0], pk01, o0); o1 = MFMA32(vf[1][1], pk01, o1); \
        o0 = MFMA32(vf[2][0], pk10, o0); o1 = MFMA32(vf[2][1], pk10, o1); o0 = MFMA32(vf[3][0], pk11, o0); o1 = MFMA32(vf[3][1], pk11, o1); } while (0)
#define MFMA_SEG(jpv, jqk) do { \
    bool doPV = (PASS != 0) && ((jpv) >= 0) && ((jpv) < nT), doQK = (jqk) < nT; \
    if (MODE == M_SLC) { \
        if (doPV) { const bool m1_ = SELBIT(t_lo + (jpv)); doPV = __any(m1_); } if (doQK) { const bool m2_ = SELBIT(t_lo + (jqk)); doQK = __any(m2_); } \
        if (doPV) { bf16x8 vf[4][2]; VFRAG_LOAD(jpv); __builtin_amdgcn_sched_barrier(0); PV_MFMAS(); } \
        __builtin_amdgcn_sched_barrier(0); \
        if (doQK) { bf16x8 kf[8]; KFRAG_LOAD(jqk); \
            const bool mn_ = SELBIT(t_lo + (jqk)); const float cv_ = mn_ ? 0.f : NEG_INF;     \
            _Pragma("unroll") for (int r = 0; r < 16; ++r) { p0[r] = cv_; p1[r] = cv_; } \
            __builtin_amdgcn_sched_barrier(0); \
            _Pragma("unroll") for (int ds = 0; ds < 4; ++ds) { p0 = MFMA32(kf[2 * ds], qf[ds], p0); p1 = MFMA32(kf[2 * ds + 1], qf[ds], p1); } } \
    } else { \
        bf16x8 vf[4][2], kf[8]; f32x4 bc[4]; \
        if (PASS != 0) VFRAG_LOAD(jpv); \
        KFRAG_LOAD(jqk); \
        __builtin_amdgcn_sched_barrier(0); \
        if (doPV) PV_MFMAS(); \
        if (MODE == M_FOX) { __builtin_amdgcn_sched_barrier(0); LAS const float* bs_ = (LAS const float*)(KSLOT(jqk) + 8192);     \
            _Pragma("unroll") for (int g4 = 0; g4 < 4; ++g4) bc[g4] = *(LAS const f32x4*)(bs_ + 8 * g4 + 4 * hi); } \
        if (doQK) { \
            if (MODE == M_FOX) { const float cqm_ = cq - m_run; LAS const float* bs_ = (LAS const float*)(KSLOT(jqk) + 8192); \
                _Pragma("unroll") for (int g4 = 0; g4 < 4; ++g4) _Pragma("unroll") for (int i_ = 0; i_ < 4; ++i_) p0[4 * g4 + i_] = cqm_ - bc[g4][i_]; \
                __builtin_amdgcn_sched_barrier(0); \
                _Pragma("unroll") for (int g4 = 0; g4 < 4; ++g4) bc[g4] = *(LAS const f32x4*)(bs_ + 32 + 8 * g4 + 4 * hi); \
                _Pragma("unroll") for (int ds = 0; ds < 4; ++ds) p0 = MFMA32(kf[2 * ds], qf[ds], p0); \
                __builtin_amdgcn_sched_barrier(0); \
                _Pragma("unroll") for (int g4 = 0; g4 < 4; ++g4) _Pragma("unroll") for (int i_ = 0; i_ < 4; ++i_) p1[4 * g4 + i_] = cqm_ - bc[g4][i_]; \
                _Pragma("unroll") for (int ds = 0; ds < 4; ++ds) p1 = MFMA32(kf[2 * ds + 1], qf[ds], p1); \
            } else { \
                _Pragma("unroll") for (int r = 0; r < 16; ++r) { p0[r] = 0.f; p1[r] = 0.f; } \
                _Pragma("unroll") for (int ds = 0; ds < 4; ++ds) { p0 = MFMA32(kf[2 * ds], qf[ds], p0); p1 = MFMA32(kf[2 * ds + 1], qf[ds], p1); } } } \
    } \
    __builtin_amdgcn_sched_barrier(0); } while (0)
    bf16x8 ov00 = pk00, ov01 = pk00, ov10 = pk00, ov11 = pk00;
    if (MODE == M_CMP && PASS == 1) {
#pragma unroll
        for (int j = 0; j < 8; ++j) { const int cb = 8 * (j >> 2) + 4 * hi + (j & 3) - 4 * r32;
            ov00[j] = (cb >= -1 && cb <= 3) ? (short)0x3F80 : (short)0; ov01[j] = (cb + 16 >= -1 && cb + 16 <= 3) ? (short)0x3F80 : (short)0;
            ov10[j] = (cb + 32 >= -1 && cb + 32 <= 3) ? (short)0x3F80 : (short)0; ov11[j] = (cb + 48 >= -1 && cb + 48 <= 3) ? (short)0x3F80 : (short)0; }
        asm volatile("" : "+v"(ov00), "+v"(ov01), "+v"(ov10), "+v"(ov11));
    }

    constexpr int NB = (MODE == M_FOX) ? NB_FOX : (MODE == M_SLC) ? NB_SLC : NB_WIN;
    int sk = 0;
    { const int i = 0;
      float brp[NB + 1];
#pragma unroll
      for (int j = 0; j <= NB; ++j) { brp[j] = 0.f; LOAD_KV(j, (j < NB ? j : nT)); brp[j] = br; }
      if (MODE == M_FOX) { if (tid < 64) {
#pragma unroll
          for (int j = 0; j <= NB; ++j) if (j < nT) *(LAS float*)(KSLOT(j) + 8192 + tid * 4) = brp[j]; } }
      asm volatile("" : "+v"(qf[0]), "+v"(qf[1]), "+v"(qf[2]), "+v"(qf[3]));
      asm volatile("" : "+v"(cq), "+v"(sel0), "+v"(sel1), "+v"(sel2), "+v"(sel3));
      asm volatile("s_waitcnt vmcnt(0)" ::: "memory"); }
    LDS_BAR();
#define END_STEP(i) do { if (MODE == M_FOX) { if ((i) + NB + 1 < nT) { if (tid < 64) *(LAS float*)(KSLOT((i) + NB + 1) + 8192 + tid * 4) = br; } } \
        if (((i) + 1) % NB == 0) { asm volatile("s_waitcnt vmcnt(0)" ::: "memory"); LDS_BAR(); } } while (0)
    if (half == 0) {
#pragma unroll 1
        for (int i = 0; i <= nT; ++i) {
            LOAD_KV(i + NB + 1, i + NB);
            MFMA_SEG(i - 1, i);
            if (i < nT) SOFTMAX_SEG(i);
            END_STEP(i);
            sk = (sk + 1 == NSL) ? 0 : sk + 1;
        }
    } else {
        { const int i = 0; MFMA_SEG(-1, 0); }
#pragma unroll 1
        for (int i = 0; i <= nT; ++i) {
            LOAD_KV(i + NB + 1, i + NB);
            if (i < nT) { SOFTMAX_SEG(i); MFMA_SEG(i, i + 1); }
            END_STEP(i);
            sk = (sk + 1 == NSL) ? 0 : sk + 1;
        }
    }
    if ((nT + 1) % NB != 0) { asm volatile("s_waitcnt vmcnt(0)" ::: "memory"); LDS_BAR(); }
#undef END_STEP
#undef SELBIT
#undef KSLOT
#undef RSLOT
#undef VSLOT
#undef LOAD_KV
#undef WRITE_KV
#undef SOFTMAX_SEG
#undef MFMA_SEG
#undef KFRAG_LOAD
#undef VFRAG_LOAD
#undef PV_MFMAS
#undef VFRAG_LOAD
#undef PV_MFMAS
#undef BIAS_LOAD
}

template <int MODE>
__device__ __forceinline__ void attn_unit(LAS unsigned char* lds, const P& A, const int b, const int hg, const int qb) {
    const int tid = opaque_tid(), lane = tid & 63, wid = __builtin_amdgcn_readfirstlane(tid >> 6), r32 = lane & 31, hi = lane >> 5;
    int tq, qcol, hh = 0;
    if (MODE == M_FOX) { tq = qb * 256 + wid * 32 + r32; qcol = ZC_FOX + hg * 64; }
    else { hh = r32 >> 3; tq = qb * 64 + wid * 8 + (r32 & 7); qcol = ZC_QN + (hg * 4 + hh) * 64; }
    const size_t tokrow = (size_t)b * SEQ + tq;
    bf16x8 qf[4];
    { const bf16_t* qp = A.Z + tokrow * ZP + qcol + hi * 8;
#pragma unroll
      for (int ds = 0; ds < 4; ++ds) qf[ds] = *(const bf16x8*)(qp + ds * 16); }
    const bf16_t *Kg, *Vg; int kp, t_lo, t_hi;
    const float* cumk = nullptr; float cq = 0.f;
    if (MODE == M_FOX) { cumk = A.cum + (size_t)(b * 8 + hg) * SEQ; cq = cumk[tq]; }
    const bf16_t* KVb = A.KV + (size_t)b * NSTREAM * SEQ * 64;
    if (MODE == M_FOX) { Kg = KVb + (size_t)(12 + hg) * SEQ * 64; Vg = KVb + (size_t)(20 + hg) * SEQ * 64; kp = 64; t_lo = 0; t_hi = 4 * qb + 3; }
    else if (MODE == M_WIN) { Kg = KVb + (size_t)(8 + hg) * SEQ * 64; Vg = KVb + (size_t)(10 + hg) * SEQ * 64; kp = 64; t_lo = qb > 8 ? qb - 8 : 0; t_hi = qb; }
    else if (MODE == M_SLC) { Kg = KVb + (size_t)(4 + hg) * SEQ * 64; Vg = KVb + (size_t)(6 + hg) * SEQ * 64; kp = 64; t_lo = 0; t_hi = qb; }
    else { Kg = A.KC + (size_t)(b * 2 + hg) * 512 * 64; Vg = A.VC + (size_t)(b * 2 + hg) * 512 * 64; kp = 64; t_lo = 0; t_hi = (4 * qb + 2) >> 6; if (t_hi > 7) t_hi = 7; }
    int nT = t_hi - t_lo + 1;
    if (MODE == M_FOX) {
        float qs = 0.f;
#pragma unroll
        for (int ds = 0; ds < 4; ++ds)
#pragma unroll
            for (int jj = 0; jj < 8; ++jj) { const float v = __uint_as_float((unsigned)(unsigned short)qf[ds][jj] << 16); qs += v * v; }
        { const auto rr = __builtin_amdgcn_permlane32_swap(__float_as_uint(qs), __float_as_uint(qs), false, false); qs = __uint_as_float(rr[0]) + __uint_as_float(rr[1]); }
#pragma unroll
        for (int o = 1; o < 32; o <<= 1) qs = fmaxf(qs, __shfl_xor(qs, o));
        LAS float* red = (LAS float*)(lds + IMP_OFF);
        if (lane == 0) red[wid] = qs;
        __syncthreads();
        float qn2 = red[0];
#pragma unroll
        for (int w = 1; w < 8; ++w) qn2 = fmaxf(qn2, red[w]);
        const float kmax = (A.cum + 131072)[64 * (b * 8 + hg)];
        const float bound = cumk[qb * 256] + 2.f * sqrtf(qn2) * kmax + 40.f;
        const bool needed = (tid < nT) && (cumk[tid * 64 + 63] < bound);
        const int wc_ = __popcll(__ballot(needed));
        __syncthreads();
        if (lane == 0) ((LAS int*)red)[wid] = wc_;
        __syncthreads();
        int cnt = 0;
#pragma unroll
        for (int w = 0; w < 8; ++w) cnt += ((LAS const int*)red)[w];
        t_lo = nT - cnt; nT = cnt;
        __syncthreads();
    }
    const bf16_t* kld = Kg + (size_t)lane * kp + wid * 8;
    const int vrow = wid * 8 + ((lane >> 2) & 7), vch = ((lane >> 5) << 2) | (lane & 3);
    const bf16_t* vld = Vg + (size_t)vrow * kp + vch * 8;
    unsigned sel0 = 0u, sel1 = 0u, sel2 = 0u, sel3 = 0u;
    if (MODE == M_SLC) { const u32x4 s4 = *(const u32x4*)(A.sel + ((size_t)(b * 2 + hg) * SEQ + tq) * 4); sel0 = s4.x; sel1 = s4.y; sel2 = s4.z; sel3 = s4.w; }

    f32x16 o0, o1;
#pragma unroll
    for (int r = 0; r < 16; ++r) { o0[r] = 0.f; o1[r] = 0.f; }
    float m_run = 0.f, lsum = 0.f; bool shifted = false;
    LAS float* impw = (LAS float*)(lds + IMP_OFF) + wid * 8 * IMP_W;
    float sc;
    if (MODE == M_CMP) {
        for (int i = lane; i < 8 * IMP_W; i += 64) impw[i] = 0.f;
        attn_steps<MODE, 0>(lds, o0, o1, m_run, lsum, shifted, 0.f, qf, kld, vld, cumk, kp, t_lo, nT, qb, tq, cq, sel0, sel1, sel2, sel3, impw, tid, lane, wid);
        float inv_l;
        { const auto rr = __builtin_amdgcn_permlane32_swap(__float_as_uint(lsum), __float_as_uint(lsum), false, false); const float lt = __uint_as_float(rr[0]) + __uint_as_float(rr[1]); inv_l = lt > 0.f ? 1.f / lt : 0.f; }
        attn_steps<MODE, 1>(lds, o0, o1, m_run, lsum, shifted, inv_l, qf, kld, vld, cumk, kp, t_lo, nT, qb, tq, cq, sel0, sel1, sel2, sel3, impw, tid, lane, wid);
        sc = 1.f;
    } else {
        attn_steps<MODE, 2>(lds, o0, o1, m_run, lsum, shifted, 0.f, qf, kld, vld, cumk, kp, t_lo, nT, qb, tq, cq, sel0, sel1, sel2, sel3, impw, tid, lane, wid);
        const auto rr = __builtin_amdgcn_permlane32_swap(__float_as_uint(lsum), __float_as_uint(lsum), false, false); const float lt = __uint_as_float(rr[0]) + __uint_as_float(rr[1]);
        sc = lt > 0.f ? 1.f / lt : 0.f;
    }
    if (MODE == M_FOX) {
        bf16_t* op = A.YS + tokrow * 1536 + 1024 + hg * 64 + 4 * hi;
#pragma unroll
        for (int g4 = 0; g4 < 4; ++g4) {
            u32x2 w; w.x = cvtpk(o0[4 * g4] * sc, o0[4 * g4 + 1] * sc); w.y = cvtpk(o0[4 * g4 + 2] * sc, o0[4 * g4 + 3] * sc); *(u32x2*)(op + 8 * g4) = w;
            w.x = cvtpk(o1[4 * g4] * sc, o1[4 * g4 + 1] * sc); w.y = cvtpk(o1[4 * g4 + 2] * sc, o1[4 * g4 + 3] * sc); *(u32x2*)(op + 32 + 8 * g4) = w;
        }
    } else {
        const int br = (MODE == M_CMP) ? 0 : (MODE == M_SLC) ? 1 : 2;
        const float gsc = sc * A.S32[tokrow * 32 + (hg * 4 + hh) * 3 + br];
        bf16_t* np = (bf16_t*)A.onsa + tokrow * 512 + (hg * 4 + hh) * 64 + 4 * hi;
        bf16_t* op = A.YS + tokrow * 1536 + 512 + (hg * 4 + hh) * 64 + 4 * hi;
        u32x2 pa0[4], pa1[4];
        if (MODE != M_CMP) {
#pragma unroll
            for (int g4 = 0; g4 < 4; ++g4) { pa0[g4] = *(const u32x2*)(np + 8 * g4); pa1[g4] = *(const u32x2*)(np + 32 + 8 * g4); }
        }
#pragma unroll
        for (int g4 = 0; g4 < 4; ++g4) {
            f32x4 v0 = {o0[4 * g4] * gsc, o0[4 * g4 + 1] * gsc, o0[4 * g4 + 2] * gsc, o0[4 * g4 + 3] * gsc};
            f32x4 v1 = {o1[4 * g4] * gsc, o1[4 * g4 + 1] * gsc, o1[4 * g4 + 2] * gsc, o1[4 * g4 + 3] * gsc};
            if (MODE != M_CMP) { const u32x2 a0_ = pa0[g4], a1_ = pa1[g4];
                v0[0] += bflo(a0_.x); v0[1] += bfhi(a0_.x); v0[2] += bflo(a0_.y); v0[3] += bfhi(a0_.y); v1[0] += bflo(a1_.x); v1[1] += bfhi(a1_.x); v1[2] += bflo(a1_.y); v1[3] += bfhi(a1_.y); }
            if (MODE != M_WIN) { u32x2 w_; w_.x = cvtpk(v0[0], v0[1]); w_.y = cvtpk(v0[2], v0[3]); *(u32x2*)(np + 8 * g4) = w_; w_.x = cvtpk(v1[0], v1[1]); w_.y = cvtpk(v1[2], v1[3]); *(u32x2*)(np + 32 + 8 * g4) = w_; }
            else { u32x2 w; w.x = cvtpk(v0[0], v0[1]); w.y = cvtpk(v0[2], v0[3]); *(u32x2*)(op + 8 * g4) = w; w.x = cvtpk(v1[0], v1[1]); w.y = cvtpk(v1[2], v1[3]); *(u32x2*)(op + 32 + 8 * g4) = w; }
        }
    }
    if (MODE == M_CMP) {
        const int ql = lane >> 3, sub = lane & 7, cur = qb;
        LAS const float* row = impw + ql * IMP_W;
        LAS unsigned* keys = (LAS unsigned*)(lds + KEY_OFF) + wid * 8 * 128 + ql * 128;
#pragma unroll
        for (int i4 = 0; i4 < 4; ++i4) { u32x4 kq;
#pragma unroll
            for (int i = 0; i < 4; ++i) { const int s = sub * 16 + i4 * 4 + i; float v = row[s]; if (s == 0 || s == cur || s == cur - 1) v = 1e6f;
                kq[i] = (s <= cur) ? (((__float_as_uint(v) & ~0x7Fu) | (unsigned)(127 - s)) | 0x80000000u) : 0u; }
            *(LAS u32x4*)(keys + sub * 16 + i4 * 4) = kq; }
        unsigned bits = 0u;
#pragma unroll 1
        for (int half = 0; half < 2; ++half) {
            unsigned kown[8]; int rank[8];
            { const u32x4 k0 = *(LAS const u32x4*)(keys + sub * 16 + half * 8), k1 = *(LAS const u32x4*)(keys + sub * 16 + half * 8 + 4);
              kown[0] = k0.x; kown[1] = k0.y; kown[2] = k0.z; kown[3] = k0.w; kown[4] = k1.x; kown[5] = k1.y; kown[6] = k1.z; kown[7] = k1.w; }
#pragma unroll
            for (int i = 0; i < 8; ++i) rank[i] = 0;
#pragma unroll 2
            for (int sp4 = 0; sp4 < 32; ++sp4) {
                const u32x4 kk = *(LAS const u32x4*)(keys + sp4 * 4);
#pragma unroll
                for (int i = 0; i < 8; ++i) rank[i] += (kk.x > kown[i] ? 1 : 0) + (kk.y > kown[i] ? 1 : 0) + (kk.z > kown[i] ? 1 : 0) + (kk.w > kown[i] ? 1 : 0);
            }
#pragma unroll
            for (int i = 0; i < 8; ++i) { if (kown[i] != 0u && rank[i] < 16) bits |= (1u << (half * 8 + i)); }
        }
        unsigned w = bits << (16 * (sub & 1));
        w |= __shfl_xor(w, 1);
        if ((sub & 1) == 0) A.sel[((size_t)(b * 2 + hg) * SEQ + qb * 64 + wid * 8 + ql) * 4 + (sub >> 1)] = w;
    }
    __syncthreads();
}
#undef MFMA32
}
struct Frame {
    LAS unsigned char* lds;
    int tid, lane, wave, G, bid;
    unsigned char* ws;
};
#define WSP(T, off) ((T*)(F.ws + (off)))

__device__ __forceinline__ int maprow(int mode, int n) {
    if (mode == 0) return n;
    if (mode == 1) {
        if (n < 512) return -1;
        if (n < 1792) return n;
        if (n < 1816) return 6400 + (n - 1792);
        if (n < 3352) return n - 24;
        if (n < 3360) return 6424 + (n - 3352);
        return n - 32;
    }
    return n < 1024 ? ((n >> 7) * 256 + (n & 127)) : (((n - 1024) >> 7) * 256 + 128 + (n & 127));
}
__device__ __forceinline__ void transpose_item(const float* W, int N, bf16_t* WT, int ld, LAS float* scr, int kb, int nb, int lane, int mode) {
    const int k0 = 64 * kb, n0 = 32 * nb;
    { float t[32];
#pragma unroll
      for (int i = 0; i < 32; ++i) { const int kk = 2 * i + (lane >> 5); t[i] = W[(size_t)(k0 + kk) * N + n0 + (lane & 31)]; }
#pragma unroll
      for (int i = 0; i < 32; ++i) { const int kk = 2 * i + (lane >> 5); scr[kk * 33 + (lane & 31)] = t[i]; } }
    asm volatile("s_waitcnt lgkmcnt(0)" ::: "memory");
    const int c = lane & 7;
#pragma unroll
    for (int j = 0; j < 4; ++j) { const int n = (lane >> 3) + 8 * j; const LAS float* s = scr + (8 * c) * 33 + n;
        u32x4 o; o.x = cvtpk(s[0 * 33], s[1 * 33]); o.y = cvtpk(s[2 * 33], s[3 * 33]); o.z = cvtpk(s[4 * 33], s[5 * 33]); o.w = cvtpk(s[6 * 33], s[7 * 33]);
        const int dr = maprow(mode, n0 + n);
        if (dr >= 0) *(u32x4*)(WT + (size_t)dr * ld + k0 + 8 * c) = o; }
    asm volatile("s_waitcnt lgkmcnt(0)" ::: "memory");
}
__device__ __forceinline__ void t64_load(const float* W, int N, int kb, int nb, int lane, f32x4 (&v)[16]) {
    const int k0 = 64 * kb, n0 = 64 * nb, kr = lane >> 4, c4 = lane & 15;
#pragma unroll
    for (int i = 0; i < 16; ++i) v[i] = *(const f32x4*)(W + (size_t)(k0 + 4 * i + kr) * N + n0 + 4 * c4);
}
__device__ __forceinline__ void t64_store(bf16_t* WT, int ld, LAS float* scr, int kb, int nb, int lane, int mode, const f32x4 (&v)[16]) {
    const int k0 = 64 * kb, n0 = 64 * nb, kr = lane >> 4, c4 = lane & 15;
#pragma unroll
    for (int i = 0; i < 16; ++i) { LAS float* d = scr + (4 * i + kr) * 65 + 4 * c4; d[0] = v[i][0]; d[1] = v[i][1]; d[2] = v[i][2]; d[3] = v[i][3]; }
    asm volatile("s_waitcnt lgkmcnt(0)" ::: "memory");
    const int c = lane & 7;
#pragma unroll
    for (int j = 0; j < 8; ++j) { const int n = (lane >> 3) + 8 * j; const LAS float* s = scr + (8 * c) * 65 + n;
        u32x4 o; o.x = cvtpk(s[0 * 65], s[1 * 65]); o.y = cvtpk(s[2 * 65], s[3 * 65]); o.z = cvtpk(s[4 * 65], s[5 * 65]); o.w = cvtpk(s[6 * 65], s[7 * 65]);
        const int dr = maprow(mode, n0 + n);
        *(u32x4*)(WT + (size_t)dr * ld + k0 + 8 * c) = o; }
    asm volatile("s_waitcnt lgkmcnt(0)" ::: "memory");
}
__device__ __forceinline__ void transpose_item64(const float* W, int N, bf16_t* WT, int ld, LAS float* scr, int kb, int nb, int lane, int mode) {
    f32x4 v[16];
    t64_load(W, N, kb, nb, lane, v);
    t64_store(WT, ld, scr, kb, nb, lane, mode, v);
}
constexpr int I_IN = 16 * 201, I_UP = 3 * 8 * 16, I_O = 16 * 16, I_C1 = 2 * 32 * 4, I_M1 = 32 * 16 * 32, I_M2 = 32 * 16 * 16, I_L = I_IN + I_UP + I_O + I_C1 + I_M1 + I_M2;
constexpr int CV_A1 = I_UP + I_O, CV_A2 = CV_A1 + I_M1 + I_M2, CV_ND = CV_A2 + I_L;
constexpr int CV_UNIT = 64, CV_NUNITS = (CV_ND + CV_UNIT - 1) / CV_UNIT;
__device__ __forceinline__ void weight_item(Frame& F0, ArgsP a, LAS float* scr, int l, int r) {
    Frame F = F0; asm volatile("" : "+v"(F.lane));

    if (r < I_IN) { const int kb = r / 201, nb = r % 201; if (nb >= 16) transpose_item(a->in[1] + (size_t)l * DM * INW, INW, WSP(bf16_t, WS_WIN + l * WIN_L), DM, scr, kb, nb, F.lane, 1); return; } r -= I_IN;
    if (r < I_UP) { const int nbr = r >> 7, rr = r & 127; transpose_item64(a->in[11] + ((size_t)l * 3 + nbr) * 512 * 1024, 1024, WSP(bf16_t, WS_WUP + l * WUP_L) + (size_t)nbr * 1024 * 512, 512, scr, rr >> 4, rr & 15, F.lane, 0); return; } r -= I_UP;
    if (r < I_O) { transpose_item64(a->in[12] + (size_t)l * DM * DM, DM, WSP(bf16_t, WS_WO + l * WO_L), DM, scr, r >> 4, r & 15, F.lane, 0); return; } r -= I_O;
    if (r < I_C1) { const int kv = r >> 7, rr = r & 127; transpose_item64(a->in[7] + (size_t)(l * 2 + kv) * 2048 * 256, 256, WSP(bf16_t, WS_WC1 + l * WC1_L) + (size_t)kv * 256 * 2048, 2048, scr, rr >> 2, rr & 3, F.lane, 0); return; } r -= I_C1;
    if (r < I_M1) { const int e = r >> 9, rr = r & 511; transpose_item64(a->in[17] + ((size_t)l * NEXP + e) * DM * 2048, 2048, WSP(bf16_t, WS_WM1 + l * WM1_L) + (size_t)e * 2048 * DM, DM, scr, rr >> 5, rr & 31, F.lane, 2); return; } r -= I_M1;
    { const int e = r >> 8, rr = r & 255; transpose_item64(a->in[19] + ((size_t)l * NEXP + e) * DM * DM, DM, WSP(bf16_t, WS_WM2 + l * WM2_L) + (size_t)e * DM * DM, DM, scr, rr >> 4, rr & 15, F.lane, 0); }
}
struct ItemP { const float* W; bf16_t* WT; int N, ld, kb, nb, mode, kind; };
__device__ __forceinline__ ItemP item_params(const Frame& F, ArgsP a, int l, int r) {
    ItemP p; p.kind = 0; p.mode = 0;
    if (r < I_IN) { p.kb = r / 201; p.nb = r % 201; p.W = a->in[1] + (size_t)l * DM * INW; p.N = INW; p.WT = WSP(bf16_t, WS_WIN + l * WIN_L); p.ld = DM; p.mode = 1; p.kind = p.nb >= 16 ? 1 : 2; return p; } r -= I_IN;
    if (r < I_UP) { const int nbr = r >> 7, rr = r & 127; p.W = a->in[11] + ((size_t)l * 3 + nbr) * 512 * 1024; p.N = 1024; p.WT = WSP(bf16_t, WS_WUP + l * WUP_L) + (size_t)nbr * 1024 * 512; p.ld = 512; p.kb = rr >> 4; p.nb = rr & 15; return p; } r -= I_UP;
    if (r < I_O) { p.W = a->in[12] + (size_t)l * DM * DM; p.N = DM; p.WT = WSP(bf16_t, WS_WO + l * WO_L); p.ld = DM; p.kb = r >> 4; p.nb = r & 15; return p; } r -= I_O;
    if (r < I_C1) { const int kv = r >> 7, rr = r & 127; p.W = a->in[7] + (size_t)(l * 2 + kv) * 2048 * 256; p.N = 256; p.WT = WSP(bf16_t, WS_WC1 + l * WC1_L) + (size_t)kv * 256 * 2048; p.ld = 2048; p.kb = rr >> 2; p.nb = rr & 3; return p; } r -= I_C1;
    if (r < I_M1) { const int e = r >> 9, rr = r & 511; p.W = a->in[17] + ((size_t)l * NEXP + e) * DM * 2048; p.N = 2048; p.WT = WSP(bf16_t, WS_WM1 + l * WM1_L) + (size_t)e * 2048 * DM; p.ld = DM; p.kb = rr >> 5; p.nb = rr & 31; p.mode = 2; return p; } r -= I_M1;
    { const int e = r >> 8, rr = r & 255; p.W = a->in[19] + ((size_t)l * NEXP + e) * DM * DM; p.N = DM; p.WT = WSP(bf16_t, WS_WM2 + l * WM2_L) + (size_t)e * DM * DM; p.ld = DM; p.kb = rr >> 4; p.nb = rr & 15; }
    return p;
}
__device__ __forceinline__ ItemP conv_item(const Frame& F, ArgsP a, int d) {
    if (d < CV_A1) return item_params(F, a, 0, I_IN + d);
    if (d < CV_A2) return item_params(F, a, 0, I_IN + I_UP + I_O + I_C1 + (d - CV_A1));
    return item_params(F, a, 1, d - CV_A2);
}
__device__ __forceinline__ void conv_unit(Frame& F0, ArgsP a, int cu) {
    Frame F = F0; asm volatile("" : "+v"(F.lane));
    LAS float* scr = (LAS float*)(F.lds + F.wave * 16640);
    int d = cu * CV_UNIT + F.wave;
    ItemP cur; cur.kind = 2; f32x4 v[16];
    if (d < CV_ND) { cur = conv_item(F, a, d); if (cur.kind == 0) t64_load(cur.W, cur.N, cur.kb, cur.nb, F.lane, v); }
#pragma unroll 1
    for (int i = 0; i < CV_UNIT / NWAVES; ++i) {
        const int dn = d + NWAVES;
        ItemP nx; nx.kind = 2; f32x4 vn[16];
        if (i + 1 < CV_UNIT / NWAVES && dn < CV_ND) { nx = conv_item(F, a, dn); if (nx.kind == 0) t64_load(nx.W, nx.N, nx.kb, nx.nb, F.lane, vn); }
        if (cur.kind == 0) t64_store(cur.WT, cur.ld, scr, cur.kb, cur.nb, F.lane, cur.mode, v);
        else if (cur.kind == 1) transpose_item(cur.W, cur.N, cur.WT, cur.ld, scr, cur.kb, cur.nb, F.lane, cur.mode);
        cur = nx; d = dn;
#pragma unroll
        for (int k = 0; k < 16; ++k) v[k] = vn[k];
    }
}
__device__ __forceinline__ void p0_phase(Frame& F, ArgsP a, const int jobs = 31) {
    if (jobs & 1) for (int task = F.bid; task < 128; task += F.G) {
        const int l = task >> 6, kv = (task >> 5) & 1, nblk = (task >> 3) & 3, sl = task & 7, n = nblk * 64 + F.lane;
        const float* pos = a->in[6] + (size_t)(l * 2 + kv) * 2048; const float* w1 = a->in[7] + (size_t)(l * 2 + kv) * 2048 * 256;
        float s = 0.f;
#pragma unroll 8
        for (int i = 0; i < 32; ++i) { const int jd = sl * 256 + F.wave * 32 + i; s += pos[jd] * w1[(size_t)jd * 256 + n]; }
        LAS float* red = (LAS float*)F.lds;
        red[F.wave * 64 + F.lane] = s;
        __syncthreads();
        if (F.wave == 0) { float t = 0.f;
            for (int w = 0; w < 8; ++w) t += red[w * 64 + F.lane];
            WSP(float, WS_BIAS)[l * 16384 + 6656 + (kv * 8 + sl) * 256 + n] = t; }
        __syncthreads();
    }
    LAS float* scr = (LAS float*)(F.lds + F.wave * 16640);
    const int gw = F.bid * NWAVES + F.wave, NGW = F.G * NWAVES;
    if (jobs & 2) for (int it = gw; it < I_IN + I_C1; it += NGW) weight_item(F, a, scr, 0, it < I_IN ? it : I_IN + I_UP + I_O + (it - I_IN));
    const int gt = F.bid * NTHREADS + F.tid, NGT = F.G * NTHREADS;
    if (jobs & 4) {
        __syncthreads();
        LAS float* sW = (LAS float*)F.lds;
        LAS float* sP = sW + 64 * 132;
        for (int task = (F.bid + 128) % F.G; task < 2 * 4 * 16; task += F.G) {
            const int l = task >> 6, g = (task >> 4) & 3, k0 = (task & 15) * 64;
            const float* wsrc = a->in[1] + ((size_t)l * DM + k0) * INW + g * 128; const float* psrc = a->in[3] + ((size_t)(l * 4 + g) * 128) * 128;
#pragma unroll
            for (int it = 0; it < 64 * 32 / NTHREADS; ++it) { const int i = F.tid + it * NTHREADS, r = i >> 5, c4 = i & 31; *(LAS f32x4*)(sW + r * 132 + 4 * c4) = *(const f32x4*)(wsrc + (size_t)r * INW + 4 * c4); }
#pragma unroll
            for (int it = 0; it < 128 * 32 / NTHREADS; ++it) { const int i = F.tid + it * NTHREADS, r = i >> 5, c4 = i & 31; *(LAS f32x4*)(sP + r * 132 + 4 * c4) = *(const f32x4*)(psrc + (size_t)r * 128 + 4 * c4); }
            __syncthreads();
            const int kq = F.tid & 15, nq = F.tid >> 4;
            f32x4 acc[4];
#pragma unroll
            for (int r = 0; r < 4; ++r) acc[r] = (f32x4){0.f, 0.f, 0.f, 0.f};
#pragma unroll 4
            for (int c = 0; c < 128; ++c) { const f32x4 pv = *(LAS const f32x4*)(sP + c * 132 + 4 * nq);
#pragma unroll
                for (int r = 0; r < 4; ++r) acc[r] = acc[r] + pv * sW[(4 * kq + r) * 132 + c]; }
            bf16_t* wt = WSP(bf16_t, WS_WIN + l * WIN_L) + (size_t)(g * 128 + 4 * nq) * DM + k0 + 4 * kq;
#pragma unroll
            for (int j = 0; j < 4; ++j) { u32x2 o; o.x = cvtpk(acc[0][j], acc[1][j]); o.y = cvtpk(acc[2][j], acc[3][j]); *(u32x2*)(wt + (size_t)j * DM) = o; }
            __syncthreads();
        }
    }
    if (jobs & 8) for (int idx = (F.G - 1 - F.bid) * NTHREADS + F.tid; idx < 2 * NINP; idx += NGT) {
        const int l = idx / NINP, n = idx - l * NINP; const float* bi = a->in[2] + (size_t)l * INW; float v = 0.f;
        if (n < 512) { const int g = n >> 7; const float* pw = a->in[3] + ((size_t)(l * 4 + g) * 128) * 128 + (n & 127);
#pragma unroll 32
            for (int c = 0; c < 128; ++c) v += bi[g * 128 + c] * pw[(size_t)c * 128]; }
        else if (n < 1792) v = bi[n];
        else if (n < 3328) v = bi[n + 24];
        else if (n < 6400) v = bi[n + 32];
        else if (n < 6424) v = bi[1792 + (n - 6400)];
        else if (n < 6432) v = bi[3352 + (n - 6424)];
        WSP(float, WS_BIAS)[l * 16384 + n] = v;
    }
    for (int idx = gt; idx < 2 * 224 * 128; idx += NGT) { const int l = idx / (224 * 128), r = idx - l * 224 * 128; *(u32x4*)(WSP(bf16_t, WS_WIN + l * WIN_L) + (size_t)6432 * DM + (size_t)r * 8) = (u32x4){0u, 0u, 0u, 0u}; }
    if (jobs & 16) for (int idx0 = gt; idx0 < NTOK * DM / 4; idx0 += 8 * NGT) {
        f32x4 t[8];
#pragma unroll
        for (int k = 0; k < 8; ++k) { const int idx = idx0 + k * NGT; t[k] = ((const f32x4*)a->in[0])[idx < NTOK * DM / 4 ? idx : idx0]; }
#pragma unroll
        for (int k = 0; k < 8; ++k) { const int idx = idx0 + k * NGT; if (idx < NTOK * DM / 4) { u32x2 w; w.x = cvtpk(t[k][0], t[k][1]); w.y = cvtpk(t[k][2], t[k][3]); ((u32x2*)WSP(bf16_t, WS_XB))[idx] = w; } }
    }
}

__device__ __forceinline__ void prep_thin(Frame& F, ArgsP a, int l) {
    if (F.bid < 128 || F.G <= 128) return;
    const int j = F.bid - 128, GJ = F.G - 128;
    LAS float* red = (LAS float*)F.lds;
    for (int seq = j; seq < 16; seq += GJ) {
        const int b = seq >> 3, h = seq & 7;
        const float* src = WSP(float, WS_S32) + ((size_t)b * SEQ + F.tid * 16) * 32 + 24 + h;
        float v[16]; float s = 0.f;
#pragma unroll
        for (int i = 0; i < 16; ++i) { v[i] = src[(size_t)i * 32]; }
#pragma unroll
        for (int i = 0; i < 16; ++i) { s += v[i]; v[i] = s; }
        float incl = s;
#pragma unroll
        for (int o = 1; o < 64; o <<= 1) { const float t = __shfl_up(incl, o); if (F.lane >= o) incl += t; }
        if (F.lane == 63) red[F.wave] = incl;
        __syncthreads();
        float base = incl - s;
        for (int w = 0; w < F.wave; ++w) base += red[w];
        float* dst = WSP(float, WS_CUM) + (size_t)seq * SEQ + F.tid * 16;
#pragma unroll
        for (int i4 = 0; i4 < 4; ++i4) *(f32x4*)(dst + 4 * i4) = (f32x4){(base + v[4 * i4]) * LOG2E, (base + v[4 * i4 + 1]) * LOG2E, (base + v[4 * i4 + 2]) * LOG2E, (base + v[4 * i4 + 3]) * LOG2E};
        __syncthreads();
    }
    {
        unsigned* KMAXU = (unsigned*)(WSP(float, WS_CUM) + 131072);
        const int b0 = (int)(((long)j * 2048) / GJ), b1 = (int)(((long)(j + 1) * 2048) / GJ);
        int blk = b0;
        while (blk < b1) {
            const int bh = blk >> 7, segend = ((bh + 1) << 7) < b1 ? ((bh + 1) << 7) : b1;
            const int strm_ = (bh >> 3) * NSTREAM + 12 + (bh & 7);
            const bf16_t* kp_ = WSP(bf16_t, WS_KV) + ((size_t)strm_ * SEQ) * 64;
            float mxs = 0.f;
            for (int q = blk; q < segend; q += 8) {
                u32x4 w[8];
#pragma unroll
                for (int i = 0; i < 8; ++i) { const int qq = q + i < segend ? q + i : segend - 1;
                    w[i] = *(const u32x4*)(kp_ + (size_t)((qq & 127) * 64 + (F.tid >> 3)) * 64 + (F.tid & 7) * 8); }
#pragma unroll
                for (int i = 0; i < 8; ++i) {
                    float s = bflo(w[i].x) * bflo(w[i].x) + bfhi(w[i].x) * bfhi(w[i].x) + bflo(w[i].y) * bflo(w[i].y) + bfhi(w[i].y) * bfhi(w[i].y) + bflo(w[i].z) * bflo(w[i].z) + bfhi(w[i].z) * bfhi(w[i].z) + bflo(w[i].w) * bflo(w[i].w) + bfhi(w[i].w) * bfhi(w[i].w);
                    s += __shfl_xor(s, 1); s += __shfl_xor(s, 2); s += __shfl_xor(s, 4);
                    mxs = fmaxf(mxs, s); }
            }
            float m = mxs;
#pragma unroll
            for (int o = 1; o < 64; o <<= 1) m = fmaxf(m, __shfl_xor(m, o));
            if (F.lane == 0) red[F.wave] = m;
            __syncthreads();
            if (F.tid == 0) { float mm = red[0]; for (int w_ = 1; w_ < 8; ++w_) mm = fmaxf(mm, red[w_]); atomicMax(KMAXU + 64 * bh, __float_as_uint(sqrtf(mm))); }
            __syncthreads();
            blk = segend;
        }
    }
}

template <int WIN> __device__ __forceinline__ void pool_pair(const bf16_t* Z, bf16_t* YS, const float* pb, const float* ps, const int n0, const int n1, const bool two, int c8) {
    u32x4 w[2][WIN];
#pragma unroll
    for (int r = 0; r < 2; ++r) { const int n = r ? n1 : n0, t = n & (SEQ - 1);
#pragma unroll
        for (int q = 0; q < WIN; ++q) { const int qq = q <= t ? q : 0; w[r][q] = *(const u32x4*)(Z + (size_t)(n - qq) * ZP + c8); } }
    const f32x4 pb0 = *(const f32x4*)(pb + c8), pb1 = *(const f32x4*)(pb + c8 + 4), ps0 = *(const f32x4*)(ps + c8), ps1 = *(const f32x4*)(ps + c8 + 4);
    const float pbv[8] = {pb0[0], pb0[1], pb0[2], pb0[3], pb1[0], pb1[1], pb1[2], pb1[3]}, psv[8] = {ps0[0], ps0[1], ps0[2], ps0[3], ps1[0], ps1[1], ps1[2], ps1[3]};
#pragma unroll
    for (int r = 0; r < 2; ++r) { const int n = r ? n1 : n0, t = n & (SEQ - 1);
        float sum[8], self[8];
#pragma unroll
        for (int i = 0; i < 8; ++i) { sum[i] = 0.f; self[i] = 0.f; }
#pragma unroll
        for (int q = 0; q < WIN; ++q) { const float m = q <= t ? 1.f : 0.f;
            const float v[8] = {bflo(w[r][q].x), bfhi(w[r][q].x), bflo(w[r][q].y), bfhi(w[r][q].y), bflo(w[r][q].z), bfhi(w[r][q].z), bflo(w[r][q].w), bfhi(w[r][q].w)};
#pragma unroll
            for (int i = 0; i < 8; ++i) { sum[i] += m * v[i]; if (q == 0) self[i] = v[i]; } }
        const int cnt = (t + 1 < WIN) ? t + 1 : WIN; const float ic = 1.f / (float)cnt; float y[8];
#pragma unroll
        for (int i = 0; i < 8; ++i) y[i] = (sum[i] * ic - self[i] + pbv[i]) * psv[i];
        u32x4 o; o.x = cvtpk(y[0], y[1]); o.y = cvtpk(y[2], y[3]); o.z = cvtpk(y[4], y[5]); o.w = cvtpk(y[6], y[7]);
        if (r == 0 || two) *(u32x4*)(YS + (size_t)n * 1536 + c8) = o; }
}
__device__ __forceinline__ void pool_phase(Frame& F, ArgsP a, int l, const int gw, const int NGW) {
    const bf16_t* Z = WSP(bf16_t, WS_Z); bf16_t* YS = WSP(bf16_t, WS_YS);
    const float* pb = a->in[4] + (size_t)l * 512; const float* ps = a->in[5] + (size_t)l * 512;
    for (int g = 0; g < 4; ++g)
        for (int idx = gw; idx < NTOK / 4; idx += 2 * NGW) {
            const bool two = idx + NGW < NTOK / 4;
            const int n0 = idx * 4 + (F.lane >> 4), n1 = (two ? idx + NGW : idx) * 4 + (F.lane >> 4), c8 = g * 128 + (F.lane & 15) * 8;
            if (g == 0) pool_pair<2>(Z, YS, pb, ps, n0, n1, two, c8); else if (g == 1) pool_pair<4>(Z, YS, pb, ps, n0, n1, two, c8);
            else if (g == 2) pool_pair<8>(Z, YS, pb, ps, n0, n1, two, c8); else pool_pair<16>(Z, YS, pb, ps, n0, n1, two, c8);
        }
}

__device__ __forceinline__ void c2_phase(Frame& F, ArgsP a, int l) {
    const int gw = F.bid * NWAVES + F.wave, NGW = F.G * NWAVES;
    LAS float* hb = (LAS float*)F.lds + F.wave * 256;
    const float* PART = WSP(float, WS_MSCR); const float* b1p = WSP(float, WS_BIAS) + l * 16384 + 6656;
    const float* cb1 = a->in[8] + (size_t)l * 512;
    LAS float* w2l = (LAS float*)F.lds + 2048;
    { const f32x4* src = (const f32x4*)(a->in[9] + (size_t)l * 2 * 256 * 64);
      f32x4 t[16];
#pragma unroll
      for (int i = 0; i < 16; ++i) t[i] = src[F.tid + NTHREADS * i];
#pragma unroll
      for (int i = 0; i < 16; ++i) *(LAS f32x4*)(w2l + 4 * (F.tid + NTHREADS * i)) = t[i]; }
    __syncthreads();
    for (int task = gw; task < 4096; task += NGW) {
        const int kv = task >> 11, row = task & 2047;
        f32x4 hs = *(const f32x4*)(cb1 + kv * 256 + 4 * F.lane);
        f32x4 tb[8], tp[8];
#pragma unroll
        for (int sl = 0; sl < 8; ++sl) tb[sl] = *(const f32x4*)(b1p + (kv * 8 + sl) * 256 + 4 * F.lane);
#pragma unroll
        for (int sp = 0; sp < 8; ++sp) tp[sp] = *(const f32x4*)(PART + ((size_t)(sp * 2 + kv) * 2048 + row) * 256 + 4 * F.lane);
        __builtin_amdgcn_sched_barrier(0);
#pragma unroll
        for (int sl = 0; sl < 8; ++sl) hs = hs + tb[sl];
#pragma unroll
        for (int sp = 0; sp < 8; ++sp) hs = hs + tp[sp];
#pragma unroll
        for (int i = 0; i < 4; ++i) hs[i] = gelu_tanhf_(hs[i]);
        *(LAS f32x4*)(hb + 4 * F.lane) = hs;
        LAS const float* w2 = w2l + kv * 256 * 64 + F.lane;
        float s = a->in[10][(l * 2 + kv) * 64 + F.lane];
#pragma unroll 16
        for (int n = 0; n < 256; ++n) s += hb[n] * w2[n * 64];
        if ((row & 511) == 511) s = 0.f;
        WSP(bf16_t, WS_KC)[((size_t)kv * 2048 + row) * 64 + F.lane] = (bf16_t)(cvtpk(s, 0.f) & 0xffffu);
    }
}

constexpr int RW_PITCH = 1028;
__device__ __forceinline__ void ln_router_phase(Frame& F, ArgsP a, int l) {
    LAS float* rwT = (LAS float*)F.lds;
    LAS int* hist = (LAS int*)(F.lds + 32 * RW_PITCH * 4);
    const float* rw = a->in[15] + (size_t)l * DM * NEXP;
    {
        f32x4 t[16];
#pragma unroll
        for (int i = 0; i < 16; ++i) t[i] = ((const f32x4*)rw)[F.tid + NTHREADS * i];
#pragma unroll
        for (int i = 0; i < 16; ++i) { const int q = F.tid + NTHREADS * i, k = q >> 3, e0 = (q & 7) * 4;
            rwT[(e0 + 0) * RW_PITCH + k] = t[i][0]; rwT[(e0 + 1) * RW_PITCH + k] = t[i][1]; rwT[(e0 + 2) * RW_PITCH + k] = t[i][2]; rwT[(e0 + 3) * RW_PITCH + k] = t[i][3]; }
    }
    const float* g1 = a->in[13] + (size_t)l * DM; const float* b1 = a->in[14] + (size_t)l * DM; const float* rb = a->in[16] + (size_t)l * NEXP;
    const bf16_t* V1 = WSP(bf16_t, WS_V1); bf16_t* XB = WSP(bf16_t, WS_XB);
    int* TOPI = (int*)(F.ws + WS_MOE + MOE_TOPI); float* TOPG = (float*)(F.ws + WS_MOE + MOE_TOPG); int* HIST = (int*)(F.ws + WS_MOE + MOE_HIST);
    LAS float* lgbuf = (LAS float*)(F.lds + 32 * RW_PITCH * 4 + 256) + F.wave * 8 * 32;
    f32x4 ggv[4], bbv[4];
#pragma unroll
    for (int j = 0; j < 4; ++j) { ggv[j] = ((const f32x4*)g1)[F.lane + 64 * j]; bbv[j] = ((const f32x4*)b1)[F.lane + 64 * j]; }
    __syncthreads();
    for (int chunk = F.bid; chunk < 256; chunk += F.G) {
        if (F.tid < 32) hist[F.tid] = 0;
        __syncthreads();
        const size_t row0 = (size_t)chunk * 64 + F.wave * 8;
        u32x2 nx[2][4];
#pragma unroll
        for (int rr = 0; rr < 2; ++rr)
#pragma unroll
            for (int j = 0; j < 4; ++j) nx[rr][j] = ((const u32x2*)(V1 + (row0 + rr) * DM))[F.lane + 64 * j];
#pragma unroll 1
        for (int rp = 0; rp < 4; ++rp) {
            f32x4 v[2][4]; float s[2] = {0.f, 0.f};
#pragma unroll
            for (int rr = 0; rr < 2; ++rr)
#pragma unroll
                for (int j = 0; j < 4; ++j) { v[rr][j] = (f32x4){bflo(nx[rr][j].x), bfhi(nx[rr][j].x), bflo(nx[rr][j].y), bfhi(nx[rr][j].y)}; s[rr] += (v[rr][j][0] + v[rr][j][1]) + (v[rr][j][2] + v[rr][j][3]); }
            if (rp < 3) {
#pragma unroll
                for (int rr = 0; rr < 2; ++rr)
#pragma unroll
                    for (int j = 0; j < 4; ++j) nx[rr][j] = ((const u32x2*)(V1 + (row0 + 2 * rp + 2 + rr) * DM))[F.lane + 64 * j];
            }
#pragma unroll
            for (int o = 1; o < 64; o <<= 1) { s[0] += __shfl_xor(s[0], o); s[1] += __shfl_xor(s[1], o); }
            float s2[2] = {0.f, 0.f};
#pragma unroll
            for (int rr = 0; rr < 2; ++rr) { const float mean = s[rr] * (1.f / DM);
#pragma unroll
                for (int j = 0; j < 4; ++j) { v[rr][j] = v[rr][j] - mean; s2[rr] += (v[rr][j][0] * v[rr][j][0] + v[rr][j][1] * v[rr][j][1]) + (v[rr][j][2] * v[rr][j][2] + v[rr][j][3] * v[rr][j][3]); } }
#pragma unroll
            for (int o = 1; o < 64; o <<= 1) { s2[0] += __shfl_xor(s2[0], o); s2[1] += __shfl_xor(s2[1], o); }
#pragma unroll
            for (int rr = 0; rr < 2; ++rr) { const float rstd = 1.f / sqrtf(s2[rr] * (1.f / DM) + LN_EPS); const size_t row = row0 + 2 * rp + rr;
#pragma unroll
                for (int j = 0; j < 4; ++j) { const f32x4 gg = ggv[j], bb = bbv[j]; v[rr][j] = v[rr][j] * rstd * gg + bb;
                    u32x2 w; w.x = cvtpk(v[rr][j][0], v[rr][j][1]); w.y = cvtpk(v[rr][j][2], v[rr][j][3]); ((u32x2*)(XB + row * DM))[F.lane + 64 * j] = w; } }
            float acc[2][32];
            f32x4 wq[2][4];
#define RW_LOAD(buf, e) do { _Pragma("unroll") for (int j = 0; j < 4; ++j) wq[buf][j] = *(LAS const f32x4*)(rwT + (e) * RW_PITCH + 4 * (F.lane + 64 * j)); } while (0)
            f32x2_t vv[4][4];
#pragma unroll
            for (int j = 0; j < 4; ++j)
#pragma unroll
                for (int i = 0; i < 4; ++i) vv[j][i] = (f32x2_t){v[0][j][i], v[1][j][i]};
#define RW_DOT(buf, e) do { f32x2_t ta = {0.f, 0.f}, tb = {0.f, 0.f}; \
                _Pragma("unroll") for (int j = 0; j < 4; ++j) { const f32x4 w = wq[buf][j]; \
                    ta += vv[j][0] * (f32x2_t){w[0], w[0]}; tb += vv[j][1] * (f32x2_t){w[1], w[1]}; ta += vv[j][2] * (f32x2_t){w[2], w[2]}; tb += vv[j][3] * (f32x2_t){w[3], w[3]}; } \
                ta += tb; acc[0][e] = ta[0]; acc[1][e] = ta[1]; } while (0)
            RW_LOAD(0, 0);
#pragma unroll
            for (int e = 0; e < 32; e += 2) {
                RW_LOAD(1, e + 1); __builtin_amdgcn_sched_barrier(0);
                RW_DOT(0, e); __builtin_amdgcn_sched_barrier(0);
                if (e + 2 < 32) RW_LOAD(0, e + 2);
                __builtin_amdgcn_sched_barrier(0);
                RW_DOT(1, e + 1); __builtin_amdgcn_sched_barrier(0);
            }
#undef RW_LOAD
#undef RW_DOT
#define RS_STEP(CNT, BIT) _Pragma("unroll") for (int i = 0; i < CNT; ++i) { const bool up = (F.lane & BIT) != 0; \
                const float send0 = up ? acc[0][i] : acc[0][i + CNT], keep0 = up ? acc[0][i + CNT] : acc[0][i]; const float send1 = up ? acc[1][i] : acc[1][i + CNT], keep1 = up ? acc[1][i + CNT] : acc[1][i]; \
                acc[0][i] = keep0 + __shfl_xor(send0, BIT); acc[1][i] = keep1 + __shfl_xor(send1, BIT); }
            RS_STEP(16, 32) RS_STEP(8, 16) RS_STEP(4, 8) RS_STEP(2, 4) RS_STEP(1, 2)
#undef RS_STEP
            const float rbe = rb[F.lane >> 1];
            const float l0 = acc[0][0] + __shfl_xor(acc[0][0], 1) + rbe, l1 = acc[1][0] + __shfl_xor(acc[1][0], 1) + rbe;
            if ((F.lane & 1) == 0) { lgbuf[(2 * rp + 0) * 32 + (F.lane >> 1)] = l0; lgbuf[(2 * rp + 1) * 32 + (F.lane >> 1)] = l1; }
        }
        {
            const int e = F.lane >> 1;
            float lg[8], tv[8][4]; int ti[8][4];
#pragma unroll
            for (int r = 0; r < 8; ++r) lg[r] = lgbuf[r * 32 + e];
#pragma unroll
            for (int k = 0; k < 4; ++k) {
                float mx[8]; int cand[8];
#pragma unroll
                for (int r = 0; r < 8; ++r) mx[r] = lg[r];
#pragma unroll
                for (int o = 1; o < 64; o <<= 1)
#pragma unroll
                    for (int r = 0; r < 8; ++r) mx[r] = fmaxf(mx[r], __shfl_xor(mx[r], o));
#pragma unroll
                for (int r = 0; r < 8; ++r) cand[r] = (lg[r] == mx[r]) ? e : 99;
#pragma unroll
                for (int o = 1; o < 64; o <<= 1)
#pragma unroll
                    for (int r = 0; r < 8; ++r) { const int t = __shfl_xor(cand[r], o); cand[r] = t < cand[r] ? t : cand[r]; }
#pragma unroll
                for (int r = 0; r < 8; ++r) { tv[r][k] = mx[r]; ti[r][k] = cand[r]; if (e == cand[r]) lg[r] = -__builtin_inff(); }
            }
            if (F.lane == 0) {
#pragma unroll
                for (int r = 0; r < 8; ++r) {
                    const float e1 = __expf(tv[r][1] - tv[r][0]), e2 = __expf(tv[r][2] - tv[r][0]), e3 = __expf(tv[r][3] - tv[r][0]); const float inv = 1.f / (1.f + e1 + e2 + e3);
                    *(int4*)(TOPI + (row0 + r) * 4) = make_int4(ti[r][0], ti[r][1], ti[r][2], ti[r][3]);
                    *(f32x4*)(TOPG + (row0 + r) * 4) = (f32x4){inv, e1 * inv, e2 * inv, e3 * inv};
#pragma unroll
                    for (int k = 0; k < 4; ++k) __hip_atomic_fetch_add(&hist[ti[r][k]], 1, __ATOMIC_RELAXED, __HIP_MEMORY_SCOPE_WORKGROUP);
                }
            }
        }
        __syncthreads();
        if (F.tid < 32) HIST[chunk * 32 + F.tid] = hist[F.tid];
        __syncthreads();
    }
}

__device__ __forceinline__ void scatter_phase(Frame& F, ArgsP a) {
    LAS int* hl = (LAS int*)F.lds;
    LAS int* segsum = hl + 8192;
    LAS int* pstart = segsum + 512;
    LAS int* total = pstart + 32;
    LAS int* padded = total + 32;
    LAS int* ea = padded + 32;
    LAS int* slotl = ea + 256;
    const int* HIST = (const int*)(F.ws + WS_MOE + MOE_HIST); const int* TOPI = (const int*)(F.ws + WS_MOE + MOE_TOPI); const float* TOPG = (const float*)(F.ws + WS_MOE + MOE_TOPG);
    int* TOKSLOT = (int*)(F.ws + WS_MOE + MOE_TOKSLOT); int* BLK = (int*)(F.ws + WS_MOE + MOE_BLK); int* SLOTTOK = (int*)(F.ws + WS_MOE + MOE_SLOTTOK); float* SLOTG = (float*)(F.ws + WS_MOE + MOE_SLOTG);
    { u32x4 t[4];
#pragma unroll
      for (int i = 0; i < 4; ++i) t[i] = ((const u32x4*)HIST)[F.tid + NTHREADS * i];
#pragma unroll
      for (int i = 0; i < 4; ++i) *(LAS u32x4*)(hl + 4 * (F.tid + NTHREADS * i)) = t[i]; }
    __syncthreads();
    { const int e = F.tid & 31, seg = F.tid >> 5; int s = 0; for (int i = 0; i < 16; ++i) s += hl[(seg * 16 + i) * 32 + e]; segsum[seg * 32 + e] = s; }
    __syncthreads();
    if (F.tid < 32) { int run = 0; for (int seg = 0; seg < 16; ++seg) { const int t = segsum[seg * 32 + F.tid]; segsum[seg * 32 + F.tid] = run; run += t; } total[F.tid] = run; padded[F.tid] = (run + 255) & ~255; }
    __syncthreads();
    { const int e = F.tid & 31, seg = F.tid >> 5; int run = segsum[seg * 32 + e]; for (int i = 0; i < 16; ++i) { const int t = hl[(seg * 16 + i) * 32 + e]; hl[(seg * 16 + i) * 32 + e] = run; run += t; } }
    if (F.tid == 0) { int run = 0; for (int e = 0; e < 32; ++e) { pstart[e] = run; run += padded[e]; } }
    __syncthreads();
    if (F.bid == 0) {
        for (int b = F.tid; b < NBLK; b += NTHREADS) { int ex = -1; for (int e = 0; e < 32; ++e) if (b * 256 >= pstart[e] && b * 256 < pstart[e] + padded[e]) ex = e; BLK[b] = ex; }
        if (F.tid == 0) BLK[NBLK] = (pstart[31] + padded[31]) >> 8;
    }
    for (int e = F.bid; e < 32; e += F.G)
        for (int s = pstart[e] + total[e] + F.tid; s < pstart[e] + padded[e]; s += NTHREADS) { SLOTG[s] = 0.f; SLOTTOK[s] = -1; }
    const bf16_t* XB = WSP(bf16_t, WS_XB); bf16_t* XS = WSP(bf16_t, WS_XS);
    for (int chunk = F.bid; chunk < 256; chunk += F.G) {
        int e = 0, tok = 0;
        u32x4 r0[8], r1[8];
#pragma unroll
        for (int m = 0; m < 8; ++m) { const u32x4* src = (const u32x4*)(XB + (size_t)(chunk * 64 + F.wave * 8 + m) * DM); r0[m] = src[F.lane]; r1[m] = src[F.lane + 64]; }
        if (F.tid < 256) { tok = chunk * 64 + (F.tid >> 2); e = TOPI[tok * 4 + (F.tid & 3)]; ea[F.tid] = e; }
        __syncthreads();
        if (F.tid < 256) { int cnt = 0; for (int q = 0; q < F.tid; ++q) cnt += (ea[q] == e) ? 1 : 0;
            const int slot = pstart[e] + hl[chunk * 32 + e] + cnt; slotl[F.tid] = slot;
            TOKSLOT[tok * 4 + (F.tid & 3)] = slot; SLOTTOK[slot] = tok; SLOTG[slot] = TOPG[tok * 4 + (F.tid & 3)]; }
        __syncthreads();
#pragma unroll
        for (int m = 0; m < 8; ++m)
#pragma unroll
            for (int k = 0; k < 4; ++k) { const int slot = slotl[F.wave * 32 + 4 * m + k]; u32x4* dst = (u32x4*)(XS + (size_t)slot * DM); dst[F.lane] = r0[m]; dst[F.lane + 64] = r1[m]; }
        __syncthreads();
    }
}

__device__ __forceinline__ void combine_phase(Frame& F, ArgsP a, int l) {
    const int gw = F.bid * NWAVES + F.wave, NGW = F.G * NWAVES;
    const float* g2 = a->in[21] + (size_t)l * DM; const float* b2 = a->in[22] + (size_t)l * DM;
    const int* TOKSLOT = (const int*)(F.ws + WS_MOE + MOE_TOKSLOT); const bf16_t* YB = WSP(bf16_t, WS_YB);
    float* X = a->out; bf16_t* XB = WSP(bf16_t, WS_XB);
    f32x4 ggv[4], bbv[4];
#pragma unroll
    for (int j = 0; j < 4; ++j) { ggv[j] = ((const f32x4*)g2)[F.lane + 64 * j]; bbv[j] = ((const f32x4*)b2)[F.lane + 64 * j]; }
    for (int row0 = gw; row0 < NTOK; row0 += 2 * NGW) {
        int4 sl[2];
#pragma unroll
        for (int r = 0; r < 2; ++r) sl[r] = *(const int4*)(TOKSLOT + (size_t)(row0 + r * NGW < NTOK ? row0 + r * NGW : row0) * 4);
        u32x2 xw[2][4], yw[2][4][4];
#pragma unroll
        for (int r = 0; r < 2; ++r) { const int row = row0 + r * NGW < NTOK ? row0 + r * NGW : row0;
#pragma unroll
            for (int j = 0; j < 4; ++j) {
                xw[r][j] = ((const u32x2*)(XB + (size_t)row * DM))[F.lane + 64 * j];
                yw[r][0][j] = ((const u32x2*)(YB + (size_t)sl[r].x * DM))[F.lane + 64 * j]; yw[r][1][j] = ((const u32x2*)(YB + (size_t)sl[r].y * DM))[F.lane + 64 * j];
                yw[r][2][j] = ((const u32x2*)(YB + (size_t)sl[r].z * DM))[F.lane + 64 * j]; yw[r][3][j] = ((const u32x2*)(YB + (size_t)sl[r].w * DM))[F.lane + 64 * j]; } }
        __builtin_amdgcn_sched_barrier(0);
#pragma unroll
        for (int r = 0; r < 2; ++r) { const int row = row0 + r * NGW < NTOK ? row0 + r * NGW : row0;
            f32x4 v[4]; float s = 0.f;
#pragma unroll
            for (int j = 0; j < 4; ++j) {
                const u32x2 xw_ = xw[r][j]; const f32x4 x = (f32x4){bflo(xw_.x), bfhi(xw_.x), bflo(xw_.y), bfhi(xw_.y)};
                const u32x2 y0 = yw[r][0][j], y1 = yw[r][1][j], y2 = yw[r][2][j], y3 = yw[r][3][j];
                f32x4 y;
                y[0] = ((bflo(y0.x) + bflo(y1.x)) + bflo(y2.x)) + bflo(y3.x); y[1] = ((bfhi(y0.x) + bfhi(y1.x)) + bfhi(y2.x)) + bfhi(y3.x);
                y[2] = ((bflo(y0.y) + bflo(y1.y)) + bflo(y2.y)) + bflo(y3.y); y[3] = ((bfhi(y0.y) + bfhi(y1.y)) + bfhi(y2.y)) + bfhi(y3.y);
                v[j] = x * ALPHA + y; s += (v[j][0] + v[j][1]) + (v[j][2] + v[j][3]);
            }
            const float mean = wave_sum(s) * (1.f / DM); float s2 = 0.f;
#pragma unroll
            for (int j = 0; j < 4; ++j) { v[j] = v[j] - mean; s2 += (v[j][0] * v[j][0] + v[j][1] * v[j][1]) + (v[j][2] * v[j][2] + v[j][3] * v[j][3]); }
            const float rstd = 1.f / sqrtf(wave_sum(s2) * (1.f / DM) + LN_EPS);
#pragma unroll
            for (int j = 0; j < 4; ++j) { const f32x4 gg = ggv[j], bb = bbv[j]; v[j] = v[j] * rstd * gg + bb;
                if (l + 1 == NLAYER) ((f32x4*)(X + (size_t)row * DM))[F.lane + 64 * j] = v[j];
                if (l + 1 < NLAYER) { u32x2 w; w.x = cvtpk(v[j][0], v[j][1]); w.y = cvtpk(v[j][2], v[j][3]); ((u32x2*)(XB + (size_t)row * DM))[F.lane + 64 * j] = w; } }
        }
    }
}
constexpr int PH_PER_LAYER = 14, N_PHASES = 1 + NLAYER * PH_PER_LAYER;

template <int MODE> __device__ __forceinline__ void attn_phase_nsa(Frame& F, const att::P& AP) {
    for (int u0 = F.bid; u0 < 256; u0 += F.G) {
        const int u = (F.G == 256) ? ((u0 & 7) * 32 + (u0 >> 3)) : u0;
        const int bg = u >> 6, s = u & 63;
        att::attn_unit<MODE>(F.lds, AP, bg >> 1, bg & 1, s);
        att::attn_unit<MODE>(F.lds, AP, bg >> 1, bg & 1, 127 - s);
    }
}

template <int SP> __device__ __forceinline__ void run_phase(LAS unsigned char* lds, const int l) {
    ArgsP args = opaque_args();
    Frame F; F.lds = lds; F.tid = opaque_tid(); F.lane = F.tid & 63; F.wave = __builtin_amdgcn_readfirstlane(F.tid >> 6); F.G = gridDim.x; F.bid = blockIdx.x; F.ws = args->ws;
    const float* BIASL = WSP(float, WS_BIAS) + l * 16384;
    att::P AP{WSP(bf16_t, WS_Z), WSP(bf16_t, WS_KV), WSP(float, WS_S32), WSP(float, WS_CUM), WSP(bf16_t, WS_KC), WSP(bf16_t, WS_KC) + 2048 * 64, WSP(unsigned, WS_SEL), WSP(float, WS_ONSA), WSP(bf16_t, WS_YS)};
    if constexpr (SP == 99) { p0_phase(F, args); }
    else if constexpr (SP == 0) {
        pg8::Gemm g{WSP(bf16_t, WS_XB), WSP(bf16_t, WS_WIN + l * WIN_L), DM, DM, DM, 128};
        if (F.bid == 0 && F.tid < 20) (WSP(float, WS_CUM) + 131072)[64 * F.tid] = 0.f;
        SchedInProj S; S.o.init(NTOK / 256, NINP / 256, F.G, F.bid);
        constexpr int NWG_IN = (NTOK / 256) * (NINP / 256);
        const int tail = NWG_IN % F.G;
        unsigned* arrive = (unsigned*)(F.ws + WS_CTL) + 9216 + l * 64 + 16;
        EpiInProjT E{EpiInProj{WSP(bf16_t, WS_Z), WSP(float, WS_S32), BIASL, WSP(bf16_t, WS_KV)}, arrive, tail > 0};
        pg8::gemm_phase(F.lds, g, S, E);
        if (tail > 0 && F.bid >= tail) {
            unsigned sp = 0u;
            while ((unsigned)__builtin_amdgcn_readfirstlane((int)__hip_atomic_load(arrive, __ATOMIC_RELAXED, __HIP_MEMORY_SCOPE_AGENT)) < 2u * (NTOK / 256)) { __builtin_amdgcn_s_sleep(1); if (++sp > (1u << 24)) break; }
            __builtin_amdgcn_fence(__ATOMIC_ACQUIRE, "agent");
            pool_phase(F, args, l, (F.bid - tail) * NWAVES + F.wave, (F.G - tail) * NWAVES);
        }
    } else if constexpr (SP == 1) {
        pg8::Gemm g{WSP(bf16_t, WS_KV), WSP(bf16_t, WS_WC1 + l * WC1_L), 16 * 64, 2048, 256, 128};
        SchedC1 S{F.bid};
        EpiC1 E{WSP(float, WS_MSCR)};
        pg8::gemm_phase(F.lds, g, S, E);
        prep_thin(F, args, l);
        if (((NTOK / 256) * (NINP / 256)) % F.G == 0) pool_phase(F, args, l, F.bid * NWAVES + F.wave, F.G * NWAVES);
    } else if constexpr (SP == 2) { c2_phase(F, args, l); }
    else if constexpr (SP == 4) {
        attc::P APC{WSP(bf16_t, WS_Z), WSP(bf16_t, WS_KV), WSP(float, WS_S32), WSP(float, WS_CUM), WSP(bf16_t, WS_KC), WSP(bf16_t, WS_KC) + 2048 * 64, WSP(unsigned, WS_SEL), WSP(float, WS_ONSA), WSP(bf16_t, WS_YS)};
        unsigned* ctr = (unsigned*)(F.ws + WS_CTL) + 8192 + l * 64;
        volatile LAS int* slot = (volatile LAS int*)(F.lds + LDS_BYTES - 512);
        const int ncv = (l == 0) ? CV_NUNITS : 0;
        for (;;) {
            if (F.tid == 0) *slot = (int)atomicAdd(ctr, 1u);
            __syncthreads();
            const int e = __builtin_amdgcn_readfirstlane(*slot);
            __syncthreads();
            if (e >= 1024 + ncv) break;
            int u;
            if (e < 2 * ncv) { if (e & 1) { conv_unit(F, args, e >> 1); continue; } u = e >> 1; } else u = e - ncv;
            const int r = u >> 5, w = u & 31;
#ifdef PROBE_FOXONLY
            if (l >= 2 && w >= 16) continue;
#endif
            if (w < 16) {
                att::attn_unit<att::M_FOX>(F.lds, AP, w >> 3, w & 7, 31 - r);
            } else {
                const int w2 = w - 16, bg = w2 & 3, qb = 127 - 4 * r - (w2 >> 2);
                attc::attn_unit<attc::M_CMP>(F.lds, APC, bg >> 1, bg & 1, qb);
                __syncthreads();
                att::attn_unit<att::M_SLC>(F.lds, AP, bg >> 1, bg & 1, qb);
                att::attn_unit<att::M_WIN>(F.lds, AP, bg >> 1, bg & 1, qb);
            }
        }
    } else if constexpr (SP == 7) {
        pg8::Gemm g{WSP(bf16_t, WS_YS), WSP(bf16_t, WS_WUP + l * WUP_L), 1536, 512, 512, 128};
        SchedUp S; S.o.init(NTOK / 256, DM / 256, F.G, F.bid);
        EpiUp E{WSP(bf16_t, WS_Z), WSP(float, WS_MSCR), WSP(bf16_t, WS_MRG)};
        pg8::gemm_phase(F.lds, g, S, E);
    } else if constexpr (SP == 8) {
        pg8::Gemm g{WSP(bf16_t, WS_MRG), WSP(bf16_t, WS_WO + l * WO_L), DM, DM, DM, 128};
        SchedWo S; S.o.init(NTOK / 256, DM / 256, F.G, F.bid);
        EpiWo E{l == 0 ? args->in[0] : (const float*)nullptr, WSP(bf16_t, WS_XB), WSP(bf16_t, WS_V1)};
        pg8::gemm_phase(F.lds, g, S, E);
    } else if constexpr (SP == 9) { ln_router_phase(F, args, l); }
    else if constexpr (SP == 10) { scatter_phase(F, args); }
    else if constexpr (SP == 11) {
        const int* BLK = (const int*)(F.ws + WS_MOE + MOE_BLK);
        pg8::Gemm g{(const bf16_t*)F.ws, (const bf16_t*)F.ws, DM, DM, DM, 128};
        const int nblk = BLK[NBLK];
        unsigned* arrive = (unsigned*)(F.ws + WS_CTL) + 9216 + l * 64;
        SchedMoeT S{BLK, nblk, F.G, F.bid, l, arrive};
        EpiMoeT E{EpiMoe1{WSP(bf16_t, WS_ACT), args->in[18] + (size_t)l * NEXP * 2048},
                  EpiMoe2{WSP(bf16_t, WS_YB), args->in[20] + (size_t)l * NEXP * DM, (const float*)(F.ws + WS_MOE + MOE_SLOTG)}, arrive, (nblk * 8) % F.G != 0};
        pg8::gemm_phase(F.lds, g, S, E);
    } else if constexpr (SP == 12) {
        const int* BLK = (const int*)(F.ws + WS_MOE + MOE_BLK);
        pg8::Gemm g{WSP(bf16_t, WS_ACT), WSP(bf16_t, WS_WM2 + l * WM2_L), DM, DM, DM, 128};
        const int nblk = BLK[NBLK], tail = (nblk * 8) % F.G;
        SchedMoe S{BLK, nblk, F.G, F.bid, 4, 1024, tail ? F.G - tail : 0};
        EpiMoe2 E{WSP(bf16_t, WS_YB), args->in[20] + (size_t)l * NEXP * DM, (const float*)(F.ws + WS_MOE + MOE_SLOTG)};
        pg8::gemm_phase(F.lds, g, S, E);
    } else if constexpr (SP == 13) { combine_phase(F, args, l); }
}

#define XB_TMO      128
#define XB_XCNT(j)  (256  + 64 * (j))
#define XB_XSUB(j)  (1280 + 64 * (j))
#define XB_XGEN(j)  (2304 + 64 * (j))
#define XB_TOP      3328
#define XB_TOPGEN   3392
#define XCD_BAR_WORDS 3456
#define XB_SPIN_CAP (1u << 22)
__device__ __forceinline__ unsigned xb_ld(unsigned* p)              { return __hip_atomic_load(p, __ATOMIC_RELAXED, __HIP_MEMORY_SCOPE_AGENT); }
__device__ __forceinline__ unsigned xb_add(unsigned* p, unsigned v) { return __hip_atomic_fetch_add(p, v, __ATOMIC_RELAXED, __HIP_MEMORY_SCOPE_AGENT); }
__device__ __forceinline__ unsigned xb_xcc_id() { return (unsigned)__builtin_amdgcn_s_getreg((3 << 11) | 20) & 0xFu; }
#define XB_SPIN(cond, bar) do { unsigned _sp = 0; while (cond) { __builtin_amdgcn_s_sleep(1); \
    if ((++_sp & 255u) == 0u) { if (xb_ld(&(bar)[XB_TMO])) break; if (_sp > XB_SPIN_CAP) { atomicAdd(&(bar)[XB_TMO], 1u); break; } } } } while (0)
struct XcdBarrier { unsigned* bar; unsigned x; volatile LAS unsigned* st; };
__device__ __forceinline__ XcdBarrier xcd_barrier_post(unsigned* bar, volatile LAS unsigned* st) {
    XcdBarrier b; b.bar = bar; b.x = xb_xcc_id(); b.st = st;
    if (threadIdx.x == 0) (void)xb_add(&bar[XB_XCNT(b.x)], 1u);
    return b;
}
__device__ __forceinline__ void xcd_barrier_complete(unsigned* bar, unsigned x, unsigned& nloc, unsigned& nx) {
    const unsigned G = gridDim.x * gridDim.y * gridDim.z;
    unsigned sum, cnt, mine, sp = 0u;
    for (;;) {
        sum = 0u; cnt = 0u; mine = 0u;
#pragma unroll
        for (unsigned j = 0; j < 16; ++j) { const unsigned c = xb_ld(&bar[XB_XCNT(j)]); sum += c; cnt += (c > 0u) ? 1u : 0u; mine = (j == x) ? c : mine; }
        if (sum == G) break;
        __builtin_amdgcn_s_sleep(1);
        if ((++sp & 255u) == 0u) { if (xb_ld(&bar[XB_TMO])) break; if (sp > XB_SPIN_CAP) { atomicAdd(&bar[XB_TMO], 1u); break; } }
    }
    nloc = mine > 0u ? mine : 1u; nx = cnt > 0u ? cnt : 1u;
}
__device__ __forceinline__ void xcd_barrier(const XcdBarrier& b) {
    asm volatile("s_waitcnt vmcnt(0)" ::: "memory");
    __syncthreads();
    if (threadIdx.x == 0) {
        unsigned* bar = b.bar;
        __builtin_amdgcn_s_waitcnt(0);
        unsigned nloc = b.st[0], nx = b.st[1];
        if (nloc == 0u) { xcd_barrier_complete(bar, b.x, nloc, nx); b.st[0] = nloc; b.st[1] = nx; }
        const unsigned old = xb_add(&bar[XB_XSUB(b.x)], 1u);
        const unsigned gen = old / nloc;
        if (old + 1u == (gen + 1u) * nloc) {
            __builtin_amdgcn_fence(__ATOMIC_RELEASE, "agent");
            asm volatile("s_waitcnt vmcnt(0)" ::: "memory");
            const unsigned og = xb_add(&bar[XB_TOP], 1u);
            const unsigned tg = og / nx;
            if (og + 1u == (tg + 1u) * nx) xb_add(&bar[XB_TOPGEN], 1u);
            else XB_SPIN(xb_ld(&bar[XB_TOPGEN]) == tg, bar);
            __builtin_amdgcn_fence(__ATOMIC_ACQUIRE, "agent");
            xb_add(&bar[XB_XGEN(b.x)], 1u);
            asm volatile("s_waitcnt vmcnt(0)" ::: "memory");
        } else {
            XB_SPIN(xb_ld(&bar[XB_XGEN(b.x)]) == gen, bar);
            __builtin_amdgcn_fence(__ATOMIC_ACQUIRE, "agent");
            asm volatile("s_waitcnt vmcnt(0)" ::: "memory");
        }
    }
    __syncthreads();
}
constexpr int LDS_BARST = LDS_BYTES - 256;

template <int SP> __global__ void __launch_bounds__(NTHREADS, 2) mk_phase(Args args) {
    extern __shared__ __attribute__((aligned(16))) unsigned char lds_raw[];
    run_phase<SP>((LAS unsigned char*)lds_raw, args.ph_lo);
}
#ifndef REP_0
#define REP_0 1
#endif
#ifndef REP_1
#define REP_1 1
#endif
#ifndef REP_2
#define REP_2 1
#endif
#ifndef REP_3
#define REP_3 1
#endif
#ifndef REP_4
#define REP_4 1
#endif
#ifndef REP_5
#define REP_5 1
#endif
#ifndef REP_6
#define REP_6 1
#endif
#ifndef REP_7
#define REP_7 1
#endif
#ifndef REP_8
#define REP_8 1
#endif
#ifndef REP_9
#define REP_9 1
#endif
#ifndef REP_10
#define REP_10 1
#endif
#ifndef REP_11
#define REP_11 1
#endif
#ifndef REP_12
#define REP_12 1
#endif
__global__ void __launch_bounds__(NTHREADS, 2) mk_fwd(Args args) {
    extern __shared__ __attribute__((aligned(16))) unsigned char lds_raw[];
    LAS unsigned char* lds = (LAS unsigned char*)lds_raw;
    cg::grid_group grid = cg::this_grid();
    volatile LAS unsigned* bst = (volatile LAS unsigned*)(lds + LDS_BARST);
    if (threadIdx.x < 2) bst[threadIdx.x] = 0u;
    __syncthreads();
    (void)xcd_barrier_post((unsigned*)(args.ws + WS_CTL) + 1024, bst);
#define SEAM() do { XcdBarrier bar_; bar_.bar = (unsigned*)(opaque_args()->ws + WS_CTL) + 1024; bar_.x = xb_xcc_id(); bar_.st = (volatile LAS unsigned*)(lds + LDS_BARST); xcd_barrier(bar_); } while (0)
#ifndef REP_34
#define REP_34 1
#endif
#ifndef REP_PRO
#define REP_PRO 1
#endif
#ifndef REP_BAR
#define REP_BAR 0
#endif
#define REPN(N, SPX) for (int rep_ = 0; rep_ < (N); ++rep_) { run_phase<SPX>(lds, l); SEAM(); }
#ifdef PRO_JOBS
    { Frame F; F.lds = lds; F.tid = opaque_tid(); F.lane = F.tid & 63; F.wave = __builtin_amdgcn_readfirstlane(F.tid >> 6); F.G = gridDim.x; F.bid = blockIdx.x; F.ws = args.ws; p0_phase(F, opaque_args(), PRO_JOBS); grid.sync(); }
#endif
    for (int rep_ = 0; rep_ < REP_PRO; ++rep_) { run_phase<99>(lds, 0); grid.sync(); }
    for (int l = 0; l < NLAYER; ++l) {
        REPN(REP_0, 0)
        REPN(REP_1, 1)
        REPN(REP_2, 2)
        for (int rep2_ = 0; rep2_ < REP_34; ++rep2_) {
        for (int rep_ = 0; rep_ < REP_4; ++rep_) { run_phase<4>(lds, l + 2 * rep_); SEAM(); }
        }
        REPN(REP_7, 7)
        REPN(REP_8, 8)
        REPN(REP_9, 9)
        REPN(REP_10, 10)
        REPN(REP_11, 11)
        REPN(REP_12, 12)
        run_phase<13>(lds, l); if (l + 1 < NLAYER) SEAM();
        for (int rep_ = 0; rep_ < REP_BAR; ++rep_) SEAM();
    }
#undef SEAM
}

#ifndef MK_ONE_LAUNCH
#define MK_ONE_LAUNCH 1
#endif
#define SET_ATTR1(SP) (void)hipFuncSetAttribute((const void*)mk_phase<SP>, hipFuncAttributeMaxDynamicSharedMemorySize, LDS_BYTES)
#define SET_ATTRS() do { SET_ATTR1(99); SET_ATTR1(0); SET_ATTR1(1); SET_ATTR1(2); SET_ATTR1(3); SET_ATTR1(4); SET_ATTR1(5); SET_ATTR1(6); SET_ATTR1(7); SET_ATTR1(8); SET_ATTR1(9); SET_ATTR1(10); SET_ATTR1(11); SET_ATTR1(12); SET_ATTR1(13); } while (0)
extern "C" void kernel_launch(void* const* d_in, const int* in_sizes, int n_in, void* d_out, int out_size, void* d_ws, size_t ws_size, hipStream_t stream) {
    static int grid = 0;
    if (grid == 0) {
        if (n_in != 23 || out_size != NTOK * DM || ws_size < WS_END) { fprintf(stderr, "kernel_launch: unexpected problem (n_in %d out %d ws %zu)\n", n_in, out_size, ws_size); grid = -1; return; }
        int dev = 0, cus = 0, per_cu = 0;
        (void)hipGetDevice(&dev); (void)hipDeviceGetAttribute(&cus, hipDeviceAttributeMultiprocessorCount, dev);
#if MK_ONE_LAUNCH
        (void)hipFuncSetAttribute((const void*)mk_fwd, hipFuncAttributeMaxDynamicSharedMemorySize, LDS_BYTES);
        (void)hipOccupancyMaxActiveBlocksPerMultiprocessor(&per_cu, (const void*)mk_fwd, NTHREADS, LDS_BYTES);
#else
        SET_ATTRS();
        (void)hipOccupancyMaxActiveBlocksPerMultiprocessor(&per_cu, (const void*)mk_phase<0>, NTHREADS, LDS_BYTES);
#endif
        (void)hipGetLastError();
        if (per_cu < 1) { fprintf(stderr, "kernel_launch: occupancy query reports %d blocks per CU\n", per_cu); per_cu = 1; }
        grid = cus;
    }
    if (grid < 0) return;
    Args a{};
    for (int i = 0; i < 23; ++i) a.in[i] = (const float*)d_in[i];
    a.out = (float*)d_out; a.ws = (unsigned char*)d_ws;
#if MK_ONE_LAUNCH
    a.ph_lo = 0; a.ph_hi = 0;
    (void)hipMemsetAsync((char*)d_ws + WS_CTL, 0, 64 * 1024, stream);
    void* kargs[] = {&a};
    hipError_t e = hipLaunchCooperativeKernel((const void*)mk_fwd, dim3(grid), dim3(NTHREADS), kargs, LDS_BYTES, stream);
    if (e != hipSuccess) fprintf(stderr, "cooperative launch failed: %s (grid %d)\n", hipGetErrorString(e), grid);
#else
#define LAUNCH_PH(SP, L) do { a.ph_lo = (L); a.ph_hi = 0; hipLaunchKernelGGL(mk_phase<SP>, dim3(grid), dim3(NTHREADS), LDS_BYTES, stream, a); } while (0)
    LAUNCH_PH(99, 0);
    for (int l = 0; l < NLAYER; ++l) {
        LAUNCH_PH(0, l); LAUNCH_PH(1, l); LAUNCH_PH(2, l); LAUNCH_PH(3, l); LAUNCH_PH(4, l); LAUNCH_PH(5, l); LAUNCH_PH(6, l);
        LAUNCH_PH(7, l); LAUNCH_PH(8, l); LAUNCH_PH(9, l); LAUNCH_PH(10, l); LAUNCH_PH(11, l); LAUNCH_PH(12, l); LAUNCH_PH(13, l);
    }
#endif
}
```

```cpp
#include <hip/hip_runtime.h>
#include <hip/hip_cooperative_groups.h>
#include <cstdio>
#include <cstdint>
namespace cg = cooperative_groups;

constexpr int NTOK = 16384, SEQ = 8192, DM = 1024, NLAYER = 2;
constexpr int INW = 6432;
constexpr int ZP = 6400;
constexpr int NINP = 6656;
constexpr int NEXP = 32, PSLOTS = 73728, NBLK = 288;
constexpr float LN_EPS = 1e-5f;
constexpr float QSCALE = 0.125f * 1.4426950408889634f;
constexpr float LOG2E = 1.4426950408889634f;
constexpr float ALPHA = 1.4142135623730951f;
constexpr int ZC_POOL = 0, ZC_QN = 512, ZC_KVN = 1024, ZC_FOX = 1792, ZC_GM = 3328;

constexpr size_t MiB = 1u << 20;
constexpr size_t WS_CTL = 0;
constexpr size_t WS_BIAS = 1 * MiB;
constexpr size_t WS_WIN = 2 * MiB, WIN_L = 13 * MiB;
constexpr size_t WS_WUP = 28 * MiB, WUP_L = 3 * MiB;
constexpr size_t WS_WO = 34 * MiB, WO_L = 2 * MiB;
constexpr size_t WS_WC1 = 38 * MiB, WC1_L = 2 * MiB;
constexpr size_t WS_WM1 = 48 * MiB, WM1_L = 128 * MiB;
constexpr size_t WS_WM2 = 304 * MiB, WM2_L = 64 * MiB;
constexpr size_t WS_Z = 432 * MiB;
constexpr size_t WS_S32 = 640 * MiB;
constexpr size_t WS_CUM = 642 * MiB;
constexpr size_t WS_H1 = 643 * MiB;
constexpr size_t WS_KC = 645 * MiB;
constexpr size_t WS_SEL = 646 * MiB;
constexpr size_t WS_YS = 648 * MiB;
constexpr size_t WS_ONSA = 696 * MiB;
constexpr size_t WS_MSCR = 728 * MiB;
constexpr size_t WS_MRG = 792 * MiB;
constexpr size_t WS_V1 = 824 * MiB;
constexpr size_t WS_XB = 888 * MiB;
constexpr size_t WS_MOE = 920 * MiB;
constexpr size_t MOE_TOPI = 0, MOE_TOPG = 256 * 1024, MOE_TOKSLOT = 512 * 1024, MOE_HIST = 768 * 1024, MOE_BLK = 832 * 1024,
                 MOE_SLOTTOK = 1024 * 1024, MOE_SLOTG = 1536 * 1024;
constexpr size_t WS_XS = 924 * MiB;
constexpr size_t WS_ACT = 1068 * MiB;
constexpr size_t WS_YB = 1212 * MiB;
constexpr size_t WS_KV = 1356 * MiB;
constexpr size_t WS_END = 1420 * MiB;
constexpr int NSTREAM = 28;

constexpr int NWAVES = 8, NTHREADS = 512;
constexpr int LDS_BYTES = 147456;

#define LAS __attribute__((address_space(3)))
typedef unsigned short bf16_t;
typedef short bf16x8 __attribute__((ext_vector_type(8)));
typedef float f32x4 __attribute__((ext_vector_type(4)));
typedef float f32x16 __attribute__((ext_vector_type(16)));
typedef unsigned u32x4 __attribute__((ext_vector_type(4)));
typedef unsigned u32x2 __attribute__((ext_vector_type(2)));
typedef float f32x2_t __attribute__((ext_vector_type(2)));
typedef __bf16 bf16x2_t __attribute__((ext_vector_type(2)));

__device__ __forceinline__ unsigned cvtpk(float lo, float hi) { f32x2_t v = {lo, hi}; bf16x2_t b = __builtin_convertvector(v, bf16x2_t); return __builtin_bit_cast(unsigned, b); }
__device__ __forceinline__ float bf2f(bf16_t v) { return __uint_as_float((unsigned)v << 16); }
__device__ __forceinline__ float bflo(unsigned w) { return __uint_as_float(w << 16); }
__device__ __forceinline__ float bfhi(unsigned w) { return __uint_as_float(w & 0xffff0000u); }
__device__ __forceinline__ float wave_sum(float v) {
#pragma unroll
    for (int o = 1; o < 64; o <<= 1) v += __shfl_xor(v, o);
    return v;
}
__device__ __forceinline__ float sigmoidf_(float x) { return __builtin_amdgcn_rcpf(1.f + __builtin_amdgcn_exp2f(-1.4426950408889634f * x)); }

__device__ __forceinline__ int opaque_tid() { int t = threadIdx.x; asm volatile("" : "+v"(t)); return t; }

struct Args {
    const float* in[23];
    float* out;
    unsigned char* ws;
    int ph_lo, ph_hi;
};
typedef const __attribute__((address_space(4))) Args* ArgsP;
__device__ __forceinline__ ArgsP opaque_args() { ArgsP p = (ArgsP)__builtin_amdgcn_kernarg_segment_ptr(); asm volatile("" : "+s"(p)); return p; }
namespace pg8 {
constexpr int BM = 256, BK = 64, HALF = 128, HTB = HALF * BK * 2  , STAGE_BYTES = 8 * HTB;

__host__ __device__ __forceinline__ int lds_byte(int r, int c) { const int st = (r >> 4) * 2 + (c >> 5), rr = r & 15, cc = c & 31, ob = rr * 64 + cc * 2; return st * 1024 + (ob ^ (((ob >> 9) & 1) << 5)); }
__host__ __device__ __forceinline__ void stage_rc(int b, int& R, int& C) { const int st = b / 1024, sb = b % 1024, swz = sb ^ (((sb >> 9) & 1) << 5); R = (st >> 1) * 16 + swz / 64; C = (st & 1) * 32 + (swz % 64) / 2; }
__host__ __device__ __forceinline__ int perm32(int rho) { const int n = rho >> 4, i = rho & 15; return 8 * (i >> 2) + 4 * n + (i & 3); }

struct Unit { int pm, pn, aux, idx; size_t aoff, boff; };
struct Gemm { const bf16_t* A; const bf16_t* Bt; int lda, ldb, K; int kstepA; };

template <class Epi, class Sched>
__device__ __forceinline__ void gemm_phase(LAS unsigned char* lds, const Gemm g, const Sched& S, const Epi& E) {
    const int tid = opaque_tid(), wid = __builtin_amdgcn_readfirstlane(tid >> 6), lane = tid & 63, wr = wid >> 2, wc = wid & 3, fr = lane & 15, fq = lane >> 4;
    const int K = g.K, nt = K / BK;
    unsigned voffA[2], voffB[2];
#pragma unroll
    for (int i = 0; i < 2; ++i) { int R, C; stage_rc(tid * 16 + i * 8192, R, C); const int Rb = (R & ~31) + perm32(R & 31);
        voffA[i] = (unsigned)(R * g.lda + C) * 2u; voffB[i] = (unsigned)(Rb * g.ldb + C) * 2u; }
    const size_t kstepA = (size_t)g.kstepA, kstepB = (size_t)(BK * 2);
    const size_t hstepA = (size_t)HALF * g.lda * 2, hstepB = (size_t)HALF * g.ldb * 2;
    const unsigned ldsw = (unsigned)wid * 1024u;
    const int aoff = lds_byte(wr * 64 + fr, fq * 8), boff = lds_byte(wc * 32 + fr, fq * 8);
#define PG8_SA(b, h) (((b) * 2 + (h)) * HTB)
#define PG8_SB(b, h) ((4 + (b) * 2 + (h)) * HTB)
#define PG8_STAGE(bufoff, gbase, voff) do { _Pragma("unroll") for (int _i = 0; _i < 2; ++_i) \
        __builtin_amdgcn_global_load_lds((const unsigned*)((const char*)(gbase) + (voff)[_i]), (LAS unsigned*)(lds + (bufoff) + ldsw + _i * 8192), 16, 0, 0); } while (0)
#define PG8_LDA(dst, b, h) do { _Pragma("unroll") for (int m = 0; m < 4; ++m) _Pragma("unroll") for (int k = 0; k < 2; ++k) dst[m][k] = *(const LAS bf16x8*)(lds + PG8_SA(b, h) + aoff + m * 2048 + k * 1024); } while (0)
#define PG8_LDB(dst, b, h) do { _Pragma("unroll") for (int n = 0; n < 2; ++n) _Pragma("unroll") for (int k = 0; k < 2; ++k) dst[n][k] = *(const LAS bf16x8*)(lds + PG8_SB(b, h) + boff + n * 2048 + k * 1024); } while (0)
#define PG8_MMA(ai, bj, At, Bt) do { __builtin_amdgcn_s_setprio(1); _Pragma("unroll") for (int m = 0; m < 4; ++m) _Pragma("unroll") for (int n = 0; n < 2; ++n) _Pragma("unroll") for (int k = 0; k < 2; ++k) \
        acc[ai][bj][m][n] = __builtin_amdgcn_mfma_f32_16x16x32_bf16(Bt[n][k], At[m][k], acc[ai][bj][m][n], 0, 0, 0); __builtin_amdgcn_s_setprio(0); } while (0)
#define PG8_WAIT_V(n) asm volatile("s_waitcnt vmcnt(" #n ")" ::: "memory")
#define PG8_WAIT_L(n) asm volatile("s_waitcnt lgkmcnt(" #n ")" ::: "memory")
#define PG8_BAR __builtin_amdgcn_s_barrier()
#define PG8_SCHED __builtin_amdgcn_sched_barrier(0)
    Unit cur, nxt; int ui = 0;
    if (!S.next(0, cur)) return;
    f32x4 acc[2][2][4][2];
#pragma unroll
    for (int a = 0; a < 2; ++a)
#pragma unroll
        for (int b = 0; b < 2; ++b)
#pragma unroll
            for (int m = 0; m < 4; ++m)
#pragma unroll
                for (int n = 0; n < 2; ++n) acc[a][b][m][n] = (f32x4){0.f, 0.f, 0.f, 0.f};
    bf16x8 At[4][2], B0[2][2], B1[2][2];
    const char* cA = (const char*)g.A + cur.aoff; const char* cB = (const char*)g.Bt + cur.boff;
    PG8_STAGE(PG8_SB(0, 0), cB, voffB); PG8_STAGE(PG8_SB(0, 1), cB + hstepB, voffB); PG8_STAGE(PG8_SA(0, 0), cA, voffA); PG8_STAGE(PG8_SA(0, 1), cA + hstepA, voffA);
    if (wr == 1) PG8_BAR;
    PG8_WAIT_V(2); PG8_BAR;
    PG8_STAGE(PG8_SB(1, 0), cB + kstepB, voffB); PG8_STAGE(PG8_SA(1, 0), cA + kstepA, voffA); PG8_STAGE(PG8_SB(1, 1), cB + hstepB + kstepB, voffB);
    PG8_WAIT_V(6); PG8_BAR;
    for (;;) {
        const bool has_next = S.next(ui + 1, nxt);
        const char* nA = has_next ? (const char*)g.A + nxt.aoff : cA; const char* nB = has_next ? (const char*)g.Bt + nxt.boff : cB;
#pragma unroll 1
        for (int t = 0; t < nt; t += 2) {
            const bool last = (t == nt - 2);
            const char* a1 = cA + (size_t)(t + 1) * kstepA;
            const char* a2 = last ? nA : cA + (size_t)(t + 2) * kstepA; const char* b2 = last ? nB : cB + (size_t)(t + 2) * kstepB;
            const char* a3 = a2 + kstepA; const char* b3 = b2 + kstepB;
            PG8_LDB(B0, 0, 0); PG8_LDB(B1, 0, 1); PG8_SCHED; PG8_LDA(At, 0, 0); PG8_STAGE(PG8_SA(1, 1), a1 + hstepA, voffA);
            PG8_WAIT_V(8); PG8_WAIT_L(0); PG8_BAR; PG8_MMA(0, 0, At, B0); PG8_MMA(0, 1, At, B1); PG8_BAR; PG8_SCHED;
            PG8_LDA(At, 0, 1); PG8_STAGE(PG8_SB(0, 0), b2, voffB); PG8_STAGE(PG8_SB(0, 1), b2 + hstepB, voffB); PG8_STAGE(PG8_SA(0, 0), a2, voffA);
            PG8_WAIT_V(8); PG8_WAIT_L(0); PG8_BAR; PG8_MMA(1, 0, At, B0); PG8_MMA(1, 1, At, B1); PG8_BAR; PG8_SCHED;
            PG8_LDB(B0, 1, 0); PG8_LDB(B1, 1, 1); PG8_SCHED; PG8_LDA(At, 1, 0); PG8_STAGE(PG8_SA(0, 1), a2 + hstepA, voffA);
            PG8_WAIT_V(8); PG8_WAIT_L(0); PG8_BAR; PG8_MMA(0, 0, At, B0); PG8_MMA(0, 1, At, B1); PG8_BAR; PG8_SCHED;
            PG8_LDA(At, 1, 1); PG8_STAGE(PG8_SB(1, 0), b3, voffB); PG8_STAGE(PG8_SB(1, 1), b3 + hstepB, voffB); PG8_STAGE(PG8_SA(1, 0), a3, voffA);
            PG8_WAIT_V(8); PG8_WAIT_L(0); PG8_BAR; PG8_MMA(1, 0, At, B0); PG8_MMA(1, 1, At, B1); PG8_BAR; PG8_SCHED;
        }
        if (wr == 0) PG8_BAR;
        E(acc, cur, wr, wc, fr, fq);
        if (!has_next) break;
#pragma unroll
        for (int a = 0; a < 2; ++a)
#pragma unroll
            for (int b = 0; b < 2; ++b)
#pragma unroll
                for (int m = 0; m < 4; ++m)
#pragma unroll
                    for (int n = 0; n < 2; ++n) acc[a][b][m][n] = (f32x4){0.f, 0.f, 0.f, 0.f};
        cur = nxt; cA = nA; cB = nB; ++ui;
        if (wr == 1) PG8_BAR;
    }
    PG8_WAIT_V(0);
    PG8_BAR;
#undef PG8_SA
#undef PG8_SB
#undef PG8_STAGE
#undef PG8_LDA
#undef PG8_LDB
#undef PG8_MMA
#undef PG8_WAIT_V
#undef PG8_WAIT_L
#undef PG8_BAR
#undef PG8_SCHED
}

struct TileOrder {
    int nM, nN, nwg, G, c;
    __device__ __forceinline__ void init(int nM_, int nN_, int G_, int c_) { nM = nM_; nN = nN_; nwg = nM * nN; G = G_; c = c_; }
    __device__ __forceinline__ bool tile(int i, int& pm, int& pn) const {
        const long L = (long)i * G + c; if (L >= nwg) return false;
        int wgid = (int)L; { const int q = nwg / 8, r = nwg % 8, xcd = wgid % 8, off = wgid / 8; wgid = (xcd < r ? xcd * (q + 1) : r * (q + 1) + (xcd - r) * q) + off; }
        const int nig = 8 * nN, gid = wgid / nig, fm = gid * 8, gsz = (nM - fm) < 8 ? (nM - fm) : 8;
        pm = fm + ((wgid % nig) % gsz); pn = (wgid % nig) / gsz; return true;
    }
};
}
using pg8::Unit;
typedef const f32x4 (&AccT)[2][2][4][2];

__device__ __forceinline__ float log_sigmoidf_(float x) { return fminf(x, 0.f) - log1pf(__expf(-fabsf(x))); }
__device__ __forceinline__ float gelu_tanhf_(float x) { const float y = 0.7978845608028654f * (x + 0.044715f * x * x * x); const float t = 1.f - 2.f * __builtin_amdgcn_rcpf(__builtin_amdgcn_exp2f(2.8853900817779268f * y) + 1.f); return 0.5f * x * (1.f + t); }
__device__ __forceinline__ u32x4 pack8(const f32x4 a, const f32x4 b) { u32x4 w; w.x = cvtpk(a[0], a[1]); w.y = cvtpk(a[2], a[3]); w.z = cvtpk(b[0], b[1]); w.w = cvtpk(b[2], b[3]); return w; }

struct SchedInProj {
    pg8::TileOrder o;
    __device__ __forceinline__ bool next(int i, Unit& u) const { int pm, pn; if (!o.tile(i, pm, pn)) return false; u.pm = pm; u.pn = pn; u.aux = 0;
        u.aoff = (size_t)pm * 256 * DM * 2; u.boff = (size_t)pn * 256 * DM * 2; return true; }
};
struct EpiInProj {
    bf16_t* Z; float* S32; const float* bias; bf16_t* KV;
    __device__ __forceinline__ void operator()(AccT acc, const Unit& u, int wr, int wc, int fr, int fq) const {
        const int pn = u.pn, row0 = u.pm * 256 + wr * 64 + fr;
        const int st0 = (pn >= 4 && pn <= 6) ? (pn - 4) * 4 : (pn == 9 || pn == 10) ? 12 + (pn - 9) * 4 : (pn == 11 || pn == 12) ? 20 + (pn - 11) * 4 : -1;
        if (st0 >= 0) {
            const int lc = wc * 32 + 8 * fq, col0 = pn * 256 + lc;
            f32x4 bv[2][2];
#pragma unroll
            for (int bj = 0; bj < 2; ++bj)
#pragma unroll
                for (int n = 0; n < 2; ++n) bv[bj][n] = *(const f32x4*)(bias + col0 + bj * 128 + 4 * n);
#pragma unroll
            for (int ai = 0; ai < 2; ++ai)
#pragma unroll
                for (int m = 0; m < 4; ++m) { const int row = row0 + ai * 128 + m * 16, bb = row >> 13, t = row & (SEQ - 1);
#pragma unroll
                    for (int bj = 0; bj < 2; ++bj) { const int l2 = lc + bj * 128; const f32x4 v0 = acc[ai][bj][m][0] + bv[bj][0], v1 = acc[ai][bj][m][1] + bv[bj][1];
                        *(u32x4*)(KV + (((size_t)(bb * NSTREAM + st0 + (l2 >> 6)) * SEQ + t) * 64) + (l2 & 63)) = pack8(v0, v1); } }
        } else if (pn < 25) {
            const bool isq = (pn == 2 || pn == 3 || pn == 7 || pn == 8), issig = pn >= 13;
            const int col0 = pn * 256 + wc * 32 + 8 * fq;
            f32x4 bv[2][2];
#pragma unroll
            for (int bj = 0; bj < 2; ++bj)
#pragma unroll
                for (int n = 0; n < 2; ++n) bv[bj][n] = *(const f32x4*)(bias + col0 + bj * 128 + 4 * n);
#pragma unroll
            for (int ai = 0; ai < 2; ++ai)
#pragma unroll
                for (int m = 0; m < 4; ++m) { bf16_t* rowp = Z + (size_t)(row0 + ai * 128 + m * 16) * ZP + col0;
#pragma unroll
                    for (int bj = 0; bj < 2; ++bj) { f32x4 v0 = acc[ai][bj][m][0] + bv[bj][0], v1 = acc[ai][bj][m][1] + bv[bj][1];
                        if (isq) { v0 = v0 * QSCALE; v1 = v1 * QSCALE; }
                        if (issig) {
#pragma unroll
                            for (int i = 0; i < 4; ++i) { v0[i] = sigmoidf_(v0[i]); v1[i] = sigmoidf_(v1[i]); } }
                        *(u32x4*)(rowp + bj * 128) = pack8(v0, v1); } }
        } else if (wc == 0) {
            const int c0 = 8 * fq;
            const f32x4 b0 = *(const f32x4*)(bias + 6400 + c0), b1 = *(const f32x4*)(bias + 6400 + c0 + 4);
#pragma unroll
            for (int ai = 0; ai < 2; ++ai)
#pragma unroll
                for (int m = 0; m < 4; ++m) { float* rowp = S32 + (size_t)(row0 + ai * 128 + m * 16) * 32 + c0;
                    f32x4 v0 = acc[ai][0][m][0] + b0, v1 = acc[ai][0][m][1] + b1;
#pragma unroll
                    for (int i = 0; i < 4; ++i) { v0[i] = (fq < 3) ? sigmoidf_(v0[i]) : log_sigmoidf_(v0[i]); v1[i] = (fq < 3) ? sigmoidf_(v1[i]) : log_sigmoidf_(v1[i]); }
                    *(f32x4*)(rowp) = v0; *(f32x4*)(rowp + 4) = v1; }
        }
    }
};

struct SchedC1 {
    int c;
    __device__ __forceinline__ bool next(int i, Unit& u) const { if (i > 0 || c >= 128) return false; const int split = c & 7, idx = c >> 3, kv = idx >> 3, pm = idx & 7, bg = pm >> 1, half = pm & 1, b = bg >> 1, gq = bg & 1;
        u.pm = pm; u.pn = 0; u.aux = kv * 8 + split;
        u.aoff = (((size_t)(b * NSTREAM + kv * 2 + gq) * SEQ + 16 * 256 * half + 4 * split) * 64) * 2; u.boff = ((size_t)kv * 256 * 2048 + split * 256) * 2; return true; }
};
struct EpiC1 {
    float* PART;
    __device__ __forceinline__ void operator()(AccT acc, const Unit& u, int wr, int wc, int fr, int fq) const {
        const int kv = u.aux >> 3, split = u.aux & 7, row0 = u.pm * 256 + wr * 64 + fr, col0 = wc * 32 + 8 * fq;
#pragma unroll
        for (int ai = 0; ai < 2; ++ai)
#pragma unroll
            for (int m = 0; m < 4; ++m) { float* rowp = PART + ((size_t)(split * 2 + kv) * 2048 + row0 + ai * 128 + m * 16) * 256 + col0;
#pragma unroll
                for (int bj = 0; bj < 2; ++bj) { *(f32x4*)(rowp + bj * 128) = acc[ai][bj][m][0]; *(f32x4*)(rowp + bj * 128 + 4) = acc[ai][bj][m][1]; } }
    }
};

struct SchedUp {
    pg8::TileOrder o;
    __device__ __forceinline__ bool next(int i, Unit& u) const { int pm, pn; const int ti = i / 3, nb = i - 3 * ti; if (!o.tile(ti, pm, pn)) return false; u.pm = pm; u.pn = pn; u.aux = nb;
        u.aoff = ((size_t)pm * 256 * 1536 + nb * 512) * 2; u.boff = ((size_t)(nb * 1024 + pn * 256) * 512) * 2; return true; }
};
struct EpiUp {
    const bf16_t* Z; float* scr; bf16_t* MRG;
    __device__ __forceinline__ void operator()(AccT acc, const Unit& u, int wr, int wc, int fr, int fq) const {
        const int nb = u.aux, row0 = u.pm * 256 + wr * 64 + fr, col0 = u.pn * 256 + wc * 32 + 8 * fq;
#pragma unroll
        for (int ai = 0; ai < 2; ++ai) {
            u32x4 gw[4][2], pw[4][2];
#pragma unroll
            for (int m = 0; m < 4; ++m)
#pragma unroll
                for (int bj = 0; bj < 2; ++bj) gw[m][bj] = *(const u32x4*)(Z + (size_t)(row0 + ai * 128 + m * 16) * ZP + ZC_GM + nb * 1024 + col0 + bj * 128);
            if (nb > 0) {
#pragma unroll
                for (int m = 0; m < 4; ++m)
#pragma unroll
                    for (int bj = 0; bj < 2; ++bj) pw[m][bj] = *(const u32x4*)(MRG + (size_t)(row0 + ai * 128 + m * 16) * DM + col0 + bj * 128);
            } else {
#pragma unroll
                for (int m = 0; m < 4; ++m)
#pragma unroll
                    for (int bj = 0; bj < 2; ++bj) pw[m][bj] = (u32x4){0u, 0u, 0u, 0u};
            }
#pragma unroll
            for (int m = 0; m < 4; ++m) { const size_t row = (size_t)(row0 + ai * 128 + m * 16);
#pragma unroll
                for (int bj = 0; bj < 2; ++bj) { const int col = col0 + bj * 128; const u32x4 g = gw[m][bj], p = pw[m][bj];
                    f32x4 v0 = acc[ai][bj][m][0], v1 = acc[ai][bj][m][1];
                    v0[0] *= bflo(g.x); v0[1] *= bfhi(g.x); v0[2] *= bflo(g.y); v0[3] *= bfhi(g.y); v1[0] *= bflo(g.z); v1[1] *= bfhi(g.z); v1[2] *= bflo(g.w); v1[3] *= bfhi(g.w);
                    v0[0] += bflo(p.x); v0[1] += bfhi(p.x); v0[2] += bflo(p.y); v0[3] += bfhi(p.y); v1[0] += bflo(p.z); v1[1] += bfhi(p.z); v1[2] += bflo(p.w); v1[3] += bfhi(p.w);
                    *(u32x4*)(MRG + row * DM + col) = pack8(v0, v1); } }
        }
    }
};

struct SchedWo {
    pg8::TileOrder o;
    __device__ __forceinline__ bool next(int i, Unit& u) const { int pm, pn; if (!o.tile(i, pm, pn)) return false; u.pm = pm; u.pn = pn; u.aux = 0;
        u.aoff = (size_t)pm * 256 * DM * 2; u.boff = (size_t)pn * 256 * DM * 2; return true; }
};
struct EpiWo {
    const float* X; const bf16_t* Xb; bf16_t* V1;
    __device__ __forceinline__ void operator()(AccT acc, const Unit& u, int wr, int wc, int fr, int fq) const {
        const int row0 = u.pm * 256 + wr * 64 + fr, col0 = u.pn * 256 + wc * 32 + 8 * fq;
#pragma unroll
        for (int ai = 0; ai < 2; ++ai) {
            f32x4 xr[4][2][2];
#pragma unroll
            for (int m = 0; m < 4; ++m) { const size_t off = (size_t)(row0 + ai * 128 + m * 16) * DM + col0;
#pragma unroll
                for (int bj = 0; bj < 2; ++bj) {
                    if (X) { xr[m][bj][0] = *(const f32x4*)(X + off + bj * 128); xr[m][bj][1] = *(const f32x4*)(X + off + bj * 128 + 4); }
                    else { const u32x4 w = *(const u32x4*)(Xb + off + bj * 128); xr[m][bj][0] = (f32x4){bflo(w.x), bfhi(w.x), bflo(w.y), bfhi(w.y)}; xr[m][bj][1] = (f32x4){bflo(w.z), bfhi(w.z), bflo(w.w), bfhi(w.w)}; } } }
#pragma unroll
            for (int m = 0; m < 4; ++m) { const size_t off = (size_t)(row0 + ai * 128 + m * 16) * DM + col0;
#pragma unroll
                for (int bj = 0; bj < 2; ++bj) *(u32x4*)(V1 + off + bj * 128) = pack8(xr[m][bj][0] * ALPHA + acc[ai][bj][m][0], xr[m][bj][1] * ALPHA + acc[ai][bj][m][1]); }
        }
    }
};

struct SchedMoe {
    const int* blk; int nblk, G, c, ntn, nrowB, first;
    __device__ __forceinline__ bool next(int i, Unit& u) const { const long L = (long)first + (long)i * G + c; const int b = (int)(L / ntn), tn = (int)(L % ntn); if (b >= nblk) return false; const int e = blk[b];
        u.pm = b; u.pn = tn; u.aux = e; u.aoff = (size_t)b * 256 * DM * 2; u.boff = ((size_t)e * nrowB + tn * 256) * DM * 2; return true; }
};
struct EpiMoe1 {
    bf16_t* ACT; const float* b1;
    __device__ __forceinline__ void operator()(AccT acc, const Unit& u, int wr, int wc, int fr, int fq) const {
        const int e = u.aux, row0 = u.pm * 256 + wr * 64 + fr, cg0 = u.pn * 128 + wc * 32 + 8 * fq;
        const float* bp = b1 + (size_t)e * 2048 + cg0;
        const f32x4 bg0 = *(const f32x4*)bp, bg1 = *(const f32x4*)(bp + 4), bu0 = *(const f32x4*)(bp + 1024), bu1 = *(const f32x4*)(bp + 1028);
#pragma unroll
        for (int ai = 0; ai < 2; ++ai)
#pragma unroll
            for (int m = 0; m < 4; ++m) { const size_t row = (size_t)(row0 + ai * 128 + m * 16);
                f32x4 g0 = acc[ai][0][m][0] + bg0, g1 = acc[ai][0][m][1] + bg1, u0 = acc[ai][1][m][0] + bu0, u1 = acc[ai][1][m][1] + bu1, a0, a1;
#pragma unroll
                for (int i = 0; i < 4; ++i) {
                    float gg = fminf(g0[i], 7.f), uu = fminf(fmaxf(u0[i], -7.f), 7.f); a0[i] = (uu + 1.f) * (gg * sigmoidf_(1.702f * gg));
                    gg = fminf(g1[i], 7.f); uu = fminf(fmaxf(u1[i], -7.f), 7.f); a1[i] = (uu + 1.f) * (gg * sigmoidf_(1.702f * gg)); }
                *(u32x4*)(ACT + row * DM + cg0) = pack8(a0, a1); }
    }
};
struct EpiMoe2 {
    bf16_t* YB; const float* b2; const float* sg;
    __device__ __forceinline__ void operator()(AccT acc, const Unit& u, int wr, int wc, int fr, int fq) const {
        const int e = u.aux, row0 = u.pm * 256 + wr * 64 + fr, col0 = u.pn * 256 + wc * 32 + 8 * fq;
        f32x4 bv[2][2]; float gtv[2][4];
#pragma unroll
        for (int bj = 0; bj < 2; ++bj) { const float* bp = b2 + (size_t)e * DM + col0 + bj * 128; bv[bj][0] = *(const f32x4*)bp; bv[bj][1] = *(const f32x4*)(bp + 4); }
#pragma unroll
        for (int ai = 0; ai < 2; ++ai)
#pragma unroll
            for (int m = 0; m < 4; ++m) gtv[ai][m] = sg[(size_t)(row0 + ai * 128 + m * 16)];
#pragma unroll
        for (int ai = 0; ai < 2; ++ai)
#pragma unroll
            for (int m = 0; m < 4; ++m) { const size_t row = (size_t)(row0 + ai * 128 + m * 16); const float gt = gtv[ai][m];
#pragma unroll
                for (int bj = 0; bj < 2; ++bj) {
                    const f32x4 v0 = (acc[ai][bj][m][0] + bv[bj][0]) * gt, v1 = (acc[ai][bj][m][1] + bv[bj][1]) * gt;
                    *(u32x4*)(YB + row * DM + col0 + bj * 128) = pack8(v0, v1); } }
    }
};

struct SchedMoeT {
    const int* blk; int nblk, G, c, l; unsigned* arrive;
    __device__ __forceinline__ bool next(int i, Unit& u) const {
        const int L = i * G + c, N1 = nblk * 8, tail = N1 % G; u.idx = i;
        if (L < N1) { const int b = L >> 3, tn = L & 7, e = blk[b]; u.pm = b; u.pn = tn; u.aux = e;
            u.aoff = WS_XS + (size_t)b * 256 * DM * 2; u.boff = WS_WM1 + (size_t)l * WM1_L + ((size_t)e * 2048 + tn * 256) * DM * 2; return true; }
        if (tail == 0 || i != N1 / G || i < 2) return false;
        const int j = c - tail, b = j >> 2, tn = j & 3; if (j < 0 || b >= nblk) return false;
        const int e = blk[b]; u.pm = b; u.pn = 8 + tn; u.aux = e;
        u.aoff = WS_ACT + (size_t)b * 256 * DM * 2; u.boff = WS_WM2 + (size_t)l * WM2_L + ((size_t)e * 1024 + tn * 256) * DM * 2;
        unsigned sp = 0u;
        while ((unsigned)__builtin_amdgcn_readfirstlane((int)__hip_atomic_load(arrive, __ATOMIC_RELAXED, __HIP_MEMORY_SCOPE_AGENT)) < (unsigned)G) { __builtin_amdgcn_s_sleep(1); if (++sp > (1u << 24)) break; }
        __builtin_amdgcn_fence(__ATOMIC_ACQUIRE, "agent");
        return true;
    }
};
struct EpiMoeT {
    EpiMoe1 e1; EpiMoe2 e2; unsigned* arrive; bool publish;
    __device__ __forceinline__ void operator()(AccT acc, const Unit& u, int wr, int wc, int fr, int fq) const {
        if (u.pn < 8) {
            e1(acc, u, wr, wc, fr, fq);
            if (publish && u.idx == 1) {
                asm volatile("s_waitcnt vmcnt(0)" ::: "memory");
                __builtin_amdgcn_s_barrier();
                if (wr == 0 && wc == 0 && (fr | fq) == 0) { __builtin_amdgcn_fence(__ATOMIC_RELEASE, "agent"); asm volatile("s_waitcnt vmcnt(0)" ::: "memory"); (void)__hip_atomic_fetch_add(arrive, 1u, __ATOMIC_RELAXED, __HIP_MEMORY_SCOPE_AGENT); }
            }
        } else { Unit v = u; v.pn = u.pn - 8; e2(acc, v, wr, wc, fr, fq); }
    }
};
namespace attc {
enum { M_FOX = 0, M_WIN = 1, M_SLC = 2, M_CMP = 3 };
constexpr int KB0 = 0, KBSZ = 8448  , VB0 = 2 * KBSZ, VBSZ = 8192;
constexpr int IMP_OFF = VB0 + 2 * VBSZ;
constexpr int IMP_W = 132;
constexpr int KEY_OFF = IMP_OFF + 8 * 8 * IMP_W * 4;
constexpr int LDS_NEED = KEY_OFF + 8 * 8 * 128 * 4;
typedef short v4i16_t __attribute__((ext_vector_type(4)));
typedef short s16x4 __attribute__((ext_vector_type(4)));

struct P { const bf16_t* Z; const bf16_t* KV; const float* S32; const float* cum; const bf16_t* KC; const bf16_t* VC; unsigned* sel; float* onsa; bf16_t* YS; };

__device__ __forceinline__ s16x4 vtr(LAS const unsigned char* p) { return __builtin_bit_cast(s16x4, __builtin_amdgcn_ds_read_tr16_b64_v4i16((LAS v4i16_t*)p)); }
#define MFMA32C(a, b, c) __builtin_amdgcn_mfma_f32_32x32x16_bf16((a), (b), (c), 0, 0, 0)

#define LDS_BARC() asm volatile("s_waitcnt lgkmcnt(0)\n\ts_barrier" ::: "memory")

template <int MODE, int PASS>
__device__ __forceinline__ void attn_steps(LAS unsigned char* lds, f32x16& o0, f32x16& o1, float& m_run, float& lsum, bool& shifted, const float inv_l, const bf16x8 (&qf)[4],
                                           const bf16_t* kld, const bf16_t* vld, const float* cumk, const int kp,
                                           const int t_lo, const int nT, const int qb, const int tq, const float cq, const unsigned sel0, const unsigned sel1, const unsigned sel2, const unsigned sel3,
                                           LAS float* impw, const int tid, const int lane, const int wid) {
#ifndef HALF_EXPR
#define HALF_EXPR (wid >> 2)
#endif
    const int r32 = lane & 31, hi = lane >> 5, half = HALF_EXPR;
    const float NEG_INF = -__builtin_inff();
    const unsigned kst = (unsigned)(wid * 1024 + lane * 16);
    const int vrow = (tid >> 2) & 63, vch = (tid & 3) | ((tid >> 8) << 2);
    const unsigned vst = (unsigned)(1024 * (vrow >> 3) + 512 * (vch >> 2) + 64 * (vrow & 7) + 16 * (vch & 3));
    const unsigned kfb = (unsigned)(hi * 1024 + r32 * 16);
    const unsigned vfb = (unsigned)(256 * hi + 64 * ((lane & 15) >> 2) + 32 * ((lane >> 4) & 1) + 8 * (lane & 3));
    u32x4 kr = {0u, 0u, 0u, 0u}, vr = {0u, 0u, 0u, 0u}; float br = 0.f;
    f32x16 p0, p1; bf16x8 pk00, pk01, pk10, pk11;
#define SELBIT(tt) ((((tt) < 64) ? (((tt) < 32) ? sel0 : sel1) : (((tt) < 96) ? sel2 : sel3)) >> ((tt) & 31)) & 1u
#define LOAD_SET(w) do { if ((w) + 1 < nT) { kr = *(const u32x4*)(kld + (size_t)(t_lo + (w) + 1) * 64 * kp); if (MODE == M_FOX) { if (tid < 64) br = cumk[(t_lo + (w) + 1) * 64 + tid]; } } \
        if (PASS != 0) { if ((w) < nT) vr = *(const u32x4*)(vld + (size_t)(t_lo + (w)) * 64 * kp); } } while (0)
#define WRITE_SET(w) do { if ((w) + 1 < nT) { LAS unsigned char* kb_ = lds + KB0 + (((w) + 1) & 1) * KBSZ; *(LAS u32x4*)(kb_ + kst) = kr; if (MODE == M_FOX) { if (tid < 64) *(LAS float*)(kb_ + 8192 + tid * 4) = br; } } \
        if (PASS != 0) { if ((w) < nT) *(LAS u32x4*)(lds + VB0 + ((w) & 1) * VBSZ + vst) = vr; } } while (0)
#define QK_TILE(j) do { LAS const unsigned char* kbuf_ = lds + KB0 + ((j) & 1) * KBSZ; \
        if (MODE == M_FOX) { LAS const float* bs_ = (LAS const float*)(kbuf_ + 8192); const float cqm_ = cq - m_run; \
            _Pragma("unroll") for (int g4 = 0; g4 < 4; ++g4) { const f32x4 c0_ = *(LAS const f32x4*)(bs_ + 8 * g4 + 4 * hi), c1_ = *(LAS const f32x4*)(bs_ + 32 + 8 * g4 + 4 * hi); \
                _Pragma("unroll") for (int i = 0; i < 4; ++i) { p0[4 * g4 + i] = cqm_ - c0_[i]; p1[4 * g4 + i] = cqm_ - c1_[i]; } } \
        } else { _Pragma("unroll") for (int r = 0; r < 16; ++r) { p0[r] = 0.f; p1[r] = 0.f; } } \
        _Pragma("unroll") for (int ds = 0; ds < 4; ++ds) { const bf16x8 k0_ = *(LAS const bf16x8*)(kbuf_ + kfb + ds * 2048), k1_ = *(LAS const bf16x8*)(kbuf_ + kfb + ds * 2048 + 512); \
            p0 = MFMA32C(k0_, qf[ds], p0); p1 = MFMA32C(k1_, qf[ds], p1); } } while (0)

    {
        const u32x4 kr0 = *(const u32x4*)(kld + (size_t)t_lo * 64 * kp);
        float br0 = 0.f; if (MODE == M_FOX) { if (tid < 64) br0 = cumk[t_lo * 64 + tid]; }
        LOAD_SET(0);
        *(LAS u32x4*)(lds + KB0 + kst) = kr0;
        if (MODE == M_FOX) { if (tid < 64) *(LAS float*)(lds + KB0 + 8192 + tid * 4) = br0; }
    }
    LDS_BARC();
    if (half == 1) LDS_BARC();
    { bool act0 = true; if (MODE == M_SLC) { const bool mine0 = SELBIT(t_lo); act0 = __any(mine0); }
      if (act0) QK_TILE(0); }
    if (half == 1) { WRITE_SET(0); LOAD_SET(1); }
    LDS_BARC();
#pragma unroll 1
    for (int it = 0; it < nT; ++it) {
        const int t = t_lo + it;
        bool act = true, mine = true;
        if (MODE == M_SLC) { mine = SELBIT(t); act = __any(mine); }
        if (act) {
            if (MODE != M_FOX && shifted) {
#pragma unroll
                for (int r = 0; r < 16; ++r) { p0[r] -= m_run; p1[r] -= m_run; } }
            const int kv0 = t * 64 + 4 * hi;
            if (MODE == M_FOX) {
                if (t >= 4 * qb) {
#pragma unroll
                    for (int r = 0; r < 16; ++r) { const int kv = kv0 + (r & 3) + 8 * (r >> 2); if (kv > tq) p0[r] = NEG_INF; if (kv + 32 > tq) p1[r] = NEG_INF; } }
            } else if (MODE == M_WIN) {
                if (t == qb || t == qb - 8) {
#pragma unroll
                    for (int r = 0; r < 16; ++r) { const int kv = kv0 + (r & 3) + 8 * (r >> 2); if (kv > tq || kv <= tq - 512) p0[r] = NEG_INF; if (kv + 32 > tq || kv + 32 <= tq - 512) p1[r] = NEG_INF; } }
            } else if (MODE == M_SLC) {
                if (t == qb || !mine) {
#pragma unroll
                    for (int r = 0; r < 16; ++r) { const int kv = kv0 + (r & 3) + 8 * (r >> 2); if (!mine || kv > tq) p0[r] = NEG_INF; if (!mine || kv + 32 > tq) p1[r] = NEG_INF; } }
            } else {
#pragma unroll
                for (int r = 0; r < 16; ++r) { const int c = kv0 + (r & 3) + 8 * (r >> 2); if (16 * c + 31 > tq) p0[r] = NEG_INF; if (16 * (c + 32) + 31 > tq) p1[r] = NEG_INF; }
            }
#pragma unroll
            for (int r = 0; r < 16; ++r) { p0[r] = __builtin_amdgcn_exp2f(p0[r]); p1[r] = __builtin_amdgcn_exp2f(p1[r]); }
            if (PASS != 1) {
                float mx = fmaxf(p0[0], p1[0]);
#pragma unroll
                for (int r = 1; r < 16; ++r) mx = fmaxf(mx, fmaxf(p0[r], p1[r]));
                { const auto rr = __builtin_amdgcn_permlane32_swap(__float_as_uint(mx), __float_as_uint(mx), false, false); mx = fmaxf(__uint_as_float(rr[0]), __uint_as_float(rr[1])); }
                if (__any(mx > 256.f)) {
                    const float dl = mx > 1.f ? __builtin_amdgcn_logf(mx) : 0.f;
                    const float scl = __builtin_amdgcn_exp2f(-dl);
                    m_run += dl; shifted = true; lsum *= scl;
#pragma unroll
                    for (int r = 0; r < 16; ++r) { p0[r] *= scl; p1[r] *= scl; }
                    if (PASS == 2) {
#pragma unroll
                        for (int r = 0; r < 16; ++r) { o0[r] *= scl; o1[r] *= scl; } }
                }
                float ls = 0.f;
#pragma unroll
                for (int r = 0; r < 16; ++r) ls += p0[r] + p1[r];
                lsum += ls;
            }
            if (PASS != 0) {
                if (PASS == 1) {
#pragma unroll
                    for (int r = 0; r < 16; ++r) { p0[r] *= inv_l; p1[r] *= inv_l; } }
                u32x4 w;
                w.x = cvtpk(p0[0], p0[1]); w.y = cvtpk(p0[2], p0[3]); w.z = cvtpk(p0[4], p0[5]); w.w = cvtpk(p0[6], p0[7]); pk00 = __builtin_bit_cast(bf16x8, w);
                w.x = cvtpk(p0[8], p0[9]); w.y = cvtpk(p0[10], p0[11]); w.z = cvtpk(p0[12], p0[13]); w.w = cvtpk(p0[14], p0[15]); pk01 = __builtin_bit_cast(bf16x8, w);
                w.x = cvtpk(p1[0], p1[1]); w.y = cvtpk(p1[2], p1[3]); w.z = cvtpk(p1[4], p1[5]); w.w = cvtpk(p1[6], p1[7]); pk10 = __builtin_bit_cast(bf16x8, w);
                w.x = cvtpk(p1[8], p1[9]); w.y = cvtpk(p1[10], p1[11]); w.z = cvtpk(p1[12], p1[13]); w.w = cvtpk(p1[14], p1[15]); pk11 = __builtin_bit_cast(bf16x8, w);
            }
        }
#ifdef PROBE_VALU
        if (MODE == M_FOX) { float acc_ = 0.f;
#pragma unroll
            for (int r = 0; r < 16; ++r) { float x0_ = p0[r], x1_ = p1[r]; asm volatile("v_exp_f32 %0, %0\n\tv_exp_f32 %1, %1" : "+v"(x0_), "+v"(x1_)); acc_ += x0_ + x1_; }
            asm volatile("" :: "v"(acc_)); }
#endif
        if (PASS != 0) asm volatile("" : "+v"(pk00), "+v"(pk01), "+v"(pk10), "+v"(pk11));
        asm volatile("" : "+v"(lsum));
        { const int w = it + half; WRITE_SET(w); LOAD_SET(w + 1); }
        LDS_BARC();
#ifdef PROBE_BAR
        LDS_BARC(); LDS_BARC();
#endif
        const bool doPV = (PASS != 0) && act;
        bool doQK = it + 1 < nT;
        if (MODE == M_SLC) { if (doQK) { const bool minen = SELBIT(t + 1); doQK = __any(minen); } }
        bf16x8 vf[4][2], kf[8]; f32x4 bc[8];
        if (doPV) {
            LAS const unsigned char* vb = lds + VB0 + (it & 1) * VBSZ + vfb;
#pragma unroll
            for (int q4 = 0; q4 < 4; ++q4) { const s16x4 a0_ = vtr(vb + 2048 * q4), a1_ = vtr(vb + 2048 * q4 + 1024), c0_ = vtr(vb + 2048 * q4 + 512), c1_ = vtr(vb + 2048 * q4 + 1536);
                vf[q4][0] = (bf16x8){a0_[0], a0_[1], a0_[2], a0_[3], a1_[0], a1_[1], a1_[2], a1_[3]}; vf[q4][1] = (bf16x8){c0_[0], c0_[1], c0_[2], c0_[3], c1_[0], c1_[1], c1_[2], c1_[3]}; }
        }
        if (doQK) {
            LAS const unsigned char* kbuf_ = lds + KB0 + ((it + 1) & 1) * KBSZ;
#pragma unroll
            for (int ds = 0; ds < 4; ++ds) { kf[2 * ds] = *(LAS const bf16x8*)(kbuf_ + kfb + ds * 2048); kf[2 * ds + 1] = *(LAS const bf16x8*)(kbuf_ + kfb + ds * 2048 + 512); }
            if (MODE == M_FOX) { LAS const float* bs_ = (LAS const float*)(kbuf_ + 8192);
#pragma unroll
                for (int g4 = 0; g4 < 4; ++g4) { bc[2 * g4] = *(LAS const f32x4*)(bs_ + 8 * g4 + 4 * hi); bc[2 * g4 + 1] = *(LAS const f32x4*)(bs_ + 32 + 8 * g4 + 4 * hi); } }
        }
        __builtin_amdgcn_sched_barrier(0);
        if (doPV) {
            o0 = MFMA32C(vf[0][0], pk00, o0); o1 = MFMA32C(vf[0][1], pk00, o1);
            o0 = MFMA32C(vf[1][0], pk01, o0); o1 = MFMA32C(vf[1][1], pk01, o1);
            o0 = MFMA32C(vf[2][0], pk10, o0); o1 = MFMA32C(vf[2][1], pk10, o1);
            o0 = MFMA32C(vf[3][0], pk11, o0); o1 = MFMA32C(vf[3][1], pk11, o1);
            if (MODE == M_CMP) {
                f32x16 di;
                int r32o = r32, hio = hi; asm volatile("" : "+v"(r32o), "+v"(hio));
#pragma unroll
                for (int r = 0; r < 16; ++r) di[r] = 0.f;
#define IMP_STEP(KB, SS, PKX) do { bf16x8 ov_; _Pragma("unroll") for (int j = 0; j < 8; ++j) { const int cl_ = 32 * (KB) + 16 * (SS) + 8 * (j >> 2) + 4 * hio + (j & 3); ov_[j] = (cl_ >= 4 * r32o - 1 && cl_ <= 4 * r32o + 3) ? (short)0x3F80 : (short)0; } \
                di = MFMA32C(PKX, ov_, di); } while (0)
                IMP_STEP(0, 0, pk00); IMP_STEP(0, 1, pk01); IMP_STEP(1, 0, pk10); IMP_STEP(1, 1, pk11);
#undef IMP_STEP
                if (r32 <= 16) {
#pragma unroll
                    for (int j = 0; j < 4; ++j) { const float v = (di[j] + di[j + 4]) + (di[j + 8] + di[j + 12]); LAS float* ip = impw + (4 * hi + j) * IMP_W + 16 * t + r32; *ip = *ip + v; }
                }
            }
        }
        if (doQK) {
            if (MODE == M_FOX) { const float cqm_ = cq - m_run;
#pragma unroll
                for (int g4 = 0; g4 < 4; ++g4)
#pragma unroll
                    for (int i = 0; i < 4; ++i) { p0[4 * g4 + i] = cqm_ - bc[2 * g4][i]; p1[4 * g4 + i] = cqm_ - bc[2 * g4 + 1][i]; }
            } else {
#pragma unroll
                for (int r = 0; r < 16; ++r) { p0[r] = 0.f; p1[r] = 0.f; } }
#pragma unroll
            for (int ds = 0; ds < 4; ++ds) { p0 = MFMA32C(kf[2 * ds], qf[ds], p0); p1 = MFMA32C(kf[2 * ds + 1], qf[ds], p1); }
        }
        LDS_BARC();
    }
    if (half == 0) LDS_BARC();
#undef SELBIT
#undef LOAD_SET
#undef WRITE_SET
#undef QK_TILE
}

template <int MODE>
__device__ __forceinline__ void attn_unit(LAS unsigned char* lds, const P& A, const int b, const int hg, const int qb) {
    const int tid = opaque_tid(), lane = tid & 63, wid = __builtin_amdgcn_readfirstlane(tid >> 6), r32 = lane & 31, hi = lane >> 5;
    int tq, qcol, hh = 0;
    if (MODE == M_FOX) { tq = qb * 256 + wid * 32 + r32; qcol = ZC_FOX + hg * 64; }
    else { hh = r32 >> 3; tq = qb * 64 + wid * 8 + (r32 & 7); qcol = ZC_QN + (hg * 4 + hh) * 64; }
    const size_t tokrow = (size_t)b * SEQ + tq;
    bf16x8 qf[4];
    { const bf16_t* qp = A.Z + tokrow * ZP + qcol + hi * 8;
#pragma unroll
      for (int ds = 0; ds < 4; ++ds) qf[ds] = *(const bf16x8*)(qp + ds * 16); }
    const bf16_t *Kg, *Vg; int kp, t_lo, t_hi;
    const bf16_t* KVb = A.KV + (size_t)b * NSTREAM * SEQ * 64;
    if (MODE == M_FOX) { Kg = KVb + (size_t)(12 + hg) * SEQ * 64; Vg = KVb + (size_t)(20 + hg) * SEQ * 64; kp = 64; t_lo = 0; t_hi = 4 * qb + 3; }
    else if (MODE == M_WIN) { Kg = KVb + (size_t)(8 + hg) * SEQ * 64; Vg = KVb + (size_t)(10 + hg) * SEQ * 64; kp = 64; t_lo = qb > 8 ? qb - 8 : 0; t_hi = qb; }
    else if (MODE == M_SLC) { Kg = KVb + (size_t)(4 + hg) * SEQ * 64; Vg = KVb + (size_t)(6 + hg) * SEQ * 64; kp = 64; t_lo = 0; t_hi = qb; }
    else { Kg = A.KC + (size_t)(b * 2 + hg) * 512 * 64; Vg = A.VC + (size_t)(b * 2 + hg) * 512 * 64; kp = 64; t_lo = 0; t_hi = (4 * qb + 2) >> 6; if (t_hi > 7) t_hi = 7; }
    const int nT = t_hi - t_lo + 1;
    const bf16_t* kld = Kg + (size_t)lane * kp + wid * 8;
    const int vrow = (tid >> 2) & 63, vch = (tid & 3) | ((tid >> 8) << 2);
    const bf16_t* vld = Vg + (size_t)vrow * kp + vch * 8;
    const float* cumk = nullptr; float cq = 0.f;
    if (MODE == M_FOX) { cumk = A.cum + (size_t)(b * 8 + hg) * SEQ; cq = cumk[tq]; }
    unsigned sel0 = 0u, sel1 = 0u, sel2 = 0u, sel3 = 0u;
    if (MODE == M_SLC) { const u32x4 s4 = *(const u32x4*)(A.sel + ((size_t)(b * 2 + hg) * SEQ + tq) * 4); sel0 = s4.x; sel1 = s4.y; sel2 = s4.z; sel3 = s4.w; }

    asm volatile("" : "+v"(qf[0]), "+v"(qf[1]), "+v"(qf[2]), "+v"(qf[3]));
    asm volatile("" : "+v"(cq), "+v"(sel0), "+v"(sel1), "+v"(sel2), "+v"(sel3));
    f32x16 o0, o1;
#pragma unroll
    for (int r = 0; r < 16; ++r) { o0[r] = 0.f; o1[r] = 0.f; }
    float m_run = 0.f, lsum = 0.f; bool shifted = false;
    LAS float* impw = (LAS float*)(lds + IMP_OFF) + wid * 8 * IMP_W;
    float sc;
    if (MODE == M_CMP) {
        for (int i = lane; i < 8 * IMP_W; i += 64) impw[i] = 0.f;
        attn_steps<MODE, 0>(lds, o0, o1, m_run, lsum, shifted, 0.f, qf, kld, vld, cumk, kp, t_lo, nT, qb, tq, cq, sel0, sel1, sel2, sel3, impw, tid, lane, wid);
        float inv_l;
        { const auto rr = __builtin_amdgcn_permlane32_swap(__float_as_uint(lsum), __float_as_uint(lsum), false, false); const float lt = __uint_as_float(rr[0]) + __uint_as_float(rr[1]); inv_l = lt > 0.f ? 1.f / lt : 0.f; }
        attn_steps<MODE, 1>(lds, o0, o1, m_run, lsum, shifted, inv_l, qf, kld, vld, cumk, kp, t_lo, nT, qb, tq, cq, sel0, sel1, sel2, sel3, impw, tid, lane, wid);
        sc = 1.f;
    } else {
        attn_steps<MODE, 2>(lds, o0, o1, m_run, lsum, shifted, 0.f, qf, kld, vld, cumk, kp, t_lo, nT, qb, tq, cq, sel0, sel1, sel2, sel3, impw, tid, lane, wid);
        const auto rr = __builtin_amdgcn_permlane32_swap(__float_as_uint(lsum), __float_as_uint(lsum), false, false); const float lt = __uint_as_float(rr[0]) + __uint_as_float(rr[1]);
        sc = lt > 0.f ? 1.f / lt : 0.f;
    }
    if (MODE == M_FOX) {
        bf16_t* op = A.YS + tokrow * 1536 + 1024 + hg * 64 + 4 * hi;
#pragma unroll
        for (int g4 = 0; g4 < 4; ++g4) {
            u32x2 w; w.x = cvtpk(o0[4 * g4] * sc, o0[4 * g4 + 1] * sc); w.y = cvtpk(o0[4 * g4 + 2] * sc, o0[4 * g4 + 3] * sc); *(u32x2*)(op + 8 * g4) = w;
            w.x = cvtpk(o1[4 * g4] * sc, o1[4 * g4 + 1] * sc); w.y = cvtpk(o1[4 * g4 + 2] * sc, o1[4 * g4 + 3] * sc); *(u32x2*)(op + 32 + 8 * g4) = w;
        }
    } else {
        const int br = (MODE == M_CMP) ? 0 : (MODE == M_SLC) ? 1 : 2;
        const float gsc = sc * A.S32[tokrow * 32 + (hg * 4 + hh) * 3 + br];
        bf16_t* np = (bf16_t*)A.onsa + tokrow * 512 + (hg * 4 + hh) * 64 + 4 * hi;
        bf16_t* op = A.YS + tokrow * 1536 + 512 + (hg * 4 + hh) * 64 + 4 * hi;
#pragma unroll
        for (int g4 = 0; g4 < 4; ++g4) {
            f32x4 v0 = {o0[4 * g4] * gsc, o0[4 * g4 + 1] * gsc, o0[4 * g4 + 2] * gsc, o0[4 * g4 + 3] * gsc};
            f32x4 v1 = {o1[4 * g4] * gsc, o1[4 * g4 + 1] * gsc, o1[4 * g4 + 2] * gsc, o1[4 * g4 + 3] * gsc};
            if (MODE != M_CMP) { const u32x2 a0_ = *(const u32x2*)(np + 8 * g4), a1_ = *(const u32x2*)(np + 32 + 8 * g4);
                v0[0] += bflo(a0_.x); v0[1] += bfhi(a0_.x); v0[2] += bflo(a0_.y); v0[3] += bfhi(a0_.y); v1[0] += bflo(a1_.x); v1[1] += bfhi(a1_.x); v1[2] += bflo(a1_.y); v1[3] += bfhi(a1_.y); }
            if (MODE != M_WIN) { u32x2 w_; w_.x = cvtpk(v0[0], v0[1]); w_.y = cvtpk(v0[2], v0[3]); *(u32x2*)(np + 8 * g4) = w_; w_.x = cvtpk(v1[0], v1[1]); w_.y = cvtpk(v1[2], v1[3]); *(u32x2*)(np + 32 + 8 * g4) = w_; }
            else { u32x2 w; w.x = cvtpk(v0[0], v0[1]); w.y = cvtpk(v0[2], v0[3]); *(u32x2*)(op + 8 * g4) = w; w.x = cvtpk(v1[0], v1[1]); w.y = cvtpk(v1[2], v1[3]); *(u32x2*)(op + 32 + 8 * g4) = w; }
        }
    }
    if (MODE == M_CMP) {
        const int ql = lane >> 3, sub = lane & 7, cur = qb;
        LAS const float* row = impw + ql * IMP_W;
        LAS unsigned* keys = (LAS unsigned*)(lds + KEY_OFF) + wid * 8 * 128 + ql * 128;
#pragma unroll
        for (int i4 = 0; i4 < 4; ++i4) { u32x4 kq;
#pragma unroll
            for (int i = 0; i < 4; ++i) { const int s = sub * 16 + i4 * 4 + i; float v = row[s]; if (s == 0 || s == cur || s == cur - 1) v = 1e6f;
                kq[i] = (s <= cur) ? (((__float_as_uint(v) & ~0x7Fu) | (unsigned)(127 - s)) | 0x80000000u) : 0u; }
            *(LAS u32x4*)(keys + sub * 16 + i4 * 4) = kq; }
        unsigned bits = 0u;
#pragma unroll 1
        for (int half = 0; half < 2; ++half) {
            unsigned kown[8]; int rank[8];
            { const u32x4 k0 = *(LAS const u32x4*)(keys + sub * 16 + half * 8), k1 = *(LAS const u32x4*)(keys + sub * 16 + half * 8 + 4);
              kown[0] = k0.x; kown[1] = k0.y; kown[2] = k0.z; kown[3] = k0.w; kown[4] = k1.x; kown[5] = k1.y; kown[6] = k1.z; kown[7] = k1.w; }
#pragma unroll
            for (int i = 0; i < 8; ++i) rank[i] = 0;
#pragma unroll 2
            for (int sp4 = 0; sp4 <= (cur >> 2); ++sp4) {
                const u32x4 kk = *(LAS const u32x4*)(keys + sp4 * 4);
#pragma unroll
                for (int i = 0; i < 8; ++i) rank[i] += (kk.x > kown[i] ? 1 : 0) + (kk.y > kown[i] ? 1 : 0) + (kk.z > kown[i] ? 1 : 0) + (kk.w > kown[i] ? 1 : 0);
            }
#pragma unroll
            for (int i = 0; i < 8; ++i) { if (kown[i] != 0u && rank[i] < 16) bits |= (1u << (half * 8 + i)); }
        }
        unsigned w = bits << (16 * (sub & 1));
        w |= __shfl_xor(w, 1);
        if ((sub & 1) == 0) A.sel[((size_t)(b * 2 + hg) * SEQ + qb * 64 + wid * 8 + ql) * 4 + (sub >> 1)] = w;
    }
    __syncthreads();
}

constexpr int CK_OFF = 0, CV_OFF = 8 * 8192, CV_SLOTS = 5, CIMP_OFF = CV_OFF + CV_SLOTS * 8192;
__device__ __forceinline__ void cmp_unit(LAS unsigned char* lds, const P& A, const int b, const int hg, const int qb) {
    const int tid = opaque_tid(), lane = tid & 63, wid = __builtin_amdgcn_readfirstlane(tid >> 6), r32 = lane & 31, hi = lane >> 5;
    const int hh = r32 >> 3, tq = qb * 64 + wid * 8 + (r32 & 7), qcol = ZC_QN + (hg * 4 + hh) * 64;
    const size_t tokrow = (size_t)b * SEQ + tq;
    bf16x8 qf[4];
    { const bf16_t* qp = A.Z + tokrow * ZP + qcol + hi * 8;
#pragma unroll
      for (int ds = 0; ds < 4; ++ds) qf[ds] = *(const bf16x8*)(qp + ds * 16); }
    const bf16_t* Kg = A.KC + (size_t)(b * 2 + hg) * 512 * 64; const bf16_t* Vg = A.VC + (size_t)(b * 2 + hg) * 512 * 64;
    int t_hi = (4 * qb + 2) >> 6; if (t_hi > 7) t_hi = 7;
    const int nT = t_hi + 1;
    const bf16_t* kld = Kg + (size_t)lane * 64 + wid * 8;
    const bf16_t* vld = Vg + (size_t)(wid * 8 + ((lane >> 2) & 7)) * 64 + ((((lane >> 5) << 2) | (lane & 3)) * 8);
#pragma unroll
    for (int j = 0; j < 8; ++j) if (j < nT) __builtin_amdgcn_global_load_lds((const unsigned*)(kld + (size_t)j * 64 * 64), (LAS unsigned*)(lds + CK_OFF + j * 8192 + wid * 1024), 16, 0, 0);
#pragma unroll
    for (int j = 0; j < CV_SLOTS; ++j) if (j < nT) __builtin_amdgcn_global_load_lds((const unsigned*)(vld + (size_t)j * 64 * 64), (LAS unsigned*)(lds + CV_OFF + j * 8192 + wid * 1024), 16, 0, 0);
    LAS float* impw = (LAS float*)(lds + CIMP_OFF) + wid * 8 * IMP_W;
    for (int i = lane; i < 8 * IMP_W; i += 64) impw[i] = 0.f;
    asm volatile("" : "+v"(qf[0]), "+v"(qf[1]), "+v"(qf[2]), "+v"(qf[3]));
    asm volatile("s_waitcnt vmcnt(0)" ::: "memory");
    LDS_BARC();
    const float NEG_INF = -__builtin_inff();
    const unsigned kfb = (unsigned)(hi * 1024 + r32 * 16);
    const unsigned vfb = (unsigned)(256 * hi + 64 * ((lane & 15) >> 2) + 32 * ((lane >> 4) & 1) + 8 * (lane & 3));
    f32x16 p0, p1;
    float m_run = 0.f, lsum = 0.f; bool shifted = false;
    const int tq0w = qb * 64 + wid * 8;
#define CMP_SCORES(j, pinit) do { LAS const unsigned char* kbuf_ = lds + CK_OFF + (j) * 8192; bf16x8 kf[8]; const float pi_ = (pinit); \
        _Pragma("unroll") for (int ds = 0; ds < 4; ++ds) { kf[2 * ds] = *(LAS const bf16x8*)(kbuf_ + kfb + ds * 2048); kf[2 * ds + 1] = *(LAS const bf16x8*)(kbuf_ + kfb + ds * 2048 + 512); } \
        _Pragma("unroll") for (int r = 0; r < 16; ++r) { p0[r] = pi_; p1[r] = pi_; }     \
        __builtin_amdgcn_sched_barrier(0); \
        _Pragma("unroll") for (int ds = 0; ds < 4; ++ds) { p0 = MFMA32C(kf[2 * ds], qf[ds], p0); p1 = MFMA32C(kf[2 * ds + 1], qf[ds], p1); } \
        if (1024 * (j) + 1039 > tq0w) {     \
          const int kv0 = (j) * 64 + 4 * hi; \
          _Pragma("unroll") for (int r = 0; r < 16; ++r) { const int c = kv0 + (r & 3) + 8 * (r >> 2); if (16 * c + 31 > tq) p0[r] = NEG_INF; if (16 * (c + 32) + 31 > tq) p1[r] = NEG_INF; } } \
        _Pragma("unroll") for (int r = 0; r < 16; ++r) { p0[r] = __builtin_amdgcn_exp2f(p0[r]); p1[r] = __builtin_amdgcn_exp2f(p1[r]); } } while (0)
#pragma unroll 1
    for (int j = 0; j < nT; ++j) {
        CMP_SCORES(j, -m_run);
        float mx = fmaxf(p0[0], p1[0]);
#pragma unroll
        for (int r = 1; r < 16; ++r) mx = fmaxf(mx, fmaxf(p0[r], p1[r]));
        { const auto rr = __builtin_amdgcn_permlane32_swap(__float_as_uint(mx), __float_as_uint(mx), false, false); mx = fmaxf(__uint_as_float(rr[0]), __uint_as_float(rr[1])); }
        if (__any(mx > 256.f)) {
            const float dl = mx > 1.f ? __builtin_amdgcn_logf(mx) : 0.f;
            const float scl = __builtin_amdgcn_exp2f(-dl);
            m_run += dl; shifted = true; lsum *= scl;
#pragma unroll
            for (int r = 0; r < 16; ++r) { p0[r] *= scl; p1[r] *= scl; }
        }
        float ls = 0.f;
#pragma unroll
        for (int r = 0; r < 16; ++r) ls += p0[r] + p1[r];
        lsum += ls;
    }
    float inv_l;
    { const auto rr = __builtin_amdgcn_permlane32_swap(__float_as_uint(lsum), __float_as_uint(lsum), false, false); const float lt = __uint_as_float(rr[0]) + __uint_as_float(rr[1]); inv_l = lt > 0.f ? 1.f / lt : 0.f; }
    bf16x8 ov00, ov01, ov10, ov11;
#pragma unroll
    for (int jj = 0; jj < 8; ++jj) { const int cb = 8 * (jj >> 2) + 4 * hi + (jj & 3) - 4 * r32;
        ov00[jj] = (cb >= -1 && cb <= 3) ? (short)0x3F80 : (short)0; ov01[jj] = (cb + 16 >= -1 && cb + 16 <= 3) ? (short)0x3F80 : (short)0;
        ov10[jj] = (cb + 32 >= -1 && cb + 32 <= 3) ? (short)0x3F80 : (short)0; ov11[jj] = (cb + 48 >= -1 && cb + 48 <= 3) ? (short)0x3F80 : (short)0; }
    asm volatile("" : "+v"(ov00), "+v"(ov01), "+v"(ov10), "+v"(ov11));
    f32x16 o0, o1;
#pragma unroll
    for (int r = 0; r < 16; ++r) { o0[r] = 0.f; o1[r] = 0.f; }
    const float pshift1 = __builtin_amdgcn_logf(inv_l) - m_run;
#pragma unroll 1
    for (int j = 0; j < nT; ++j) {
        if (nT > CV_SLOTS) {
            if (j == 3) { LDS_BARC();
#pragma unroll
                for (int q = 0; q < 3; ++q) if (CV_SLOTS + q < nT) __builtin_amdgcn_global_load_lds((const unsigned*)(vld + (size_t)(CV_SLOTS + q) * 64 * 64), (LAS unsigned*)(lds + CV_OFF + q * 8192 + wid * 1024), 16, 0, 0); }
            if (j == CV_SLOTS) { asm volatile("s_waitcnt vmcnt(0)" ::: "memory"); LDS_BARC(); }
        }
        CMP_SCORES(j, pshift1);
        bf16x8 pk00, pk01, pk10, pk11;
        { u32x4 w;
          w.x = cvtpk(p0[0], p0[1]); w.y = cvtpk(p0[2], p0[3]); w.z = cvtpk(p0[4], p0[5]); w.w = cvtpk(p0[6], p0[7]); pk00 = __builtin_bit_cast(bf16x8, w);
          w.x = cvtpk(p0[8], p0[9]); w.y = cvtpk(p0[10], p0[11]); w.z = cvtpk(p0[12], p0[13]); w.w = cvtpk(p0[14], p0[15]); pk01 = __builtin_bit_cast(bf16x8, w);
          w.x = cvtpk(p1[0], p1[1]); w.y = cvtpk(p1[2], p1[3]); w.z = cvtpk(p1[4], p1[5]); w.w = cvtpk(p1[6], p1[7]); pk10 = __builtin_bit_cast(bf16x8, w);
          w.x = cvtpk(p1[8], p1[9]); w.y = cvtpk(p1[10], p1[11]); w.z = cvtpk(p1[12], p1[13]); w.w = cvtpk(p1[14], p1[15]); pk11 = __builtin_bit_cast(bf16x8, w); }
        { bf16x8 vf[4][2];
          LAS const unsigned char* vb = lds + CV_OFF + (j < CV_SLOTS ? j : j - CV_SLOTS) * 8192 + vfb;
#pragma unroll
          for (int q4 = 0; q4 < 4; ++q4) { const s16x4 a0_ = vtr(vb + 2048 * q4), a1_ = vtr(vb + 2048 * q4 + 1024), c0_ = vtr(vb + 2048 * q4 + 512), c1_ = vtr(vb + 2048 * q4 + 1536);
              vf[q4][0] = (bf16x8){a0_[0], a0_[1], a0_[2], a0_[3], a1_[0], a1_[1], a1_[2], a1_[3]}; vf[q4][1] = (bf16x8){c0_[0], c0_[1], c0_[2], c0_[3], c1_[0], c1_[1], c1_[2], c1_[3]}; }
          __builtin_amdgcn_sched_barrier(0);
          o0 = MFMA32C(vf[0][0], pk00, o0); o1 = MFMA32C(vf[0][1], pk00, o1);
          o0 = MFMA32C(vf[1][0], pk01, o0); o1 = MFMA32C(vf[1][1], pk01, o1);
          o0 = MFMA32C(vf[2][0], pk10, o0); o1 = MFMA32C(vf[2][1], pk10, o1);
          o0 = MFMA32C(vf[3][0], pk11, o0); o1 = MFMA32C(vf[3][1], pk11, o1); }
        {
            f32x16 di;
#pragma unroll
            for (int r = 0; r < 16; ++r) di[r] = 0.f;
            di = MFMA32C(pk00, ov00, di); di = MFMA32C(pk01, ov01, di); di = MFMA32C(pk10, ov10, di); di = MFMA32C(pk11, ov11, di);
            if (r32 <= 16) {
#pragma unroll
                for (int jj = 0; jj < 4; ++jj) { const float v = (di[jj] + di[jj + 4]) + (di[jj + 8] + di[jj + 12]); LAS float* ip = impw + (4 * hi + jj) * IMP_W + 16 * j + r32; *ip = *ip + v; }
            }
        }
    }
#undef CMP_SCORES
    {
        const float gsc = A.S32[tokrow * 32 + (hg * 4 + hh) * 3 + 0];
        bf16_t* np = (bf16_t*)A.onsa + tokrow * 512 + (hg * 4 + hh) * 64 + 4 * hi;
#pragma unroll
        for (int g4 = 0; g4 < 4; ++g4) {
            u32x2 w_; w_.x = cvtpk(o0[4 * g4] * gsc, o0[4 * g4 + 1] * gsc); w_.y = cvtpk(o0[4 * g4 + 2] * gsc, o0[4 * g4 + 3] * gsc); *(u32x2*)(np + 8 * g4) = w_;
            w_.x = cvtpk(o1[4 * g4] * gsc, o1[4 * g4 + 1] * gsc); w_.y = cvtpk(o1[4 * g4 + 2] * gsc, o1[4 * g4 + 3] * gsc); *(u32x2*)(np + 32 + 8 * g4) = w_;
        }
    }
    {
        const int ql = lane >> 3, sub = lane & 7, cur = qb;
        LAS const float* row = impw + ql * IMP_W;
        LAS unsigned* keys = (LAS unsigned*)(impw + ql * IMP_W);
        u32x4 kq[4];
#pragma unroll
        for (int i4 = 0; i4 < 4; ++i4) {
#pragma unroll
            for (int i = 0; i < 4; ++i) { const int s = sub * 16 + i4 * 4 + i; float v = row[s]; if (s == 0 || s == cur || s == cur - 1) v = 1e6f;
                kq[i4][i] = (s <= cur) ? (((__float_as_uint(v) & ~0x7Fu) | (unsigned)(127 - s)) | 0x80000000u) : 0u; } }
        asm volatile("s_waitcnt lgkmcnt(0)" ::: "memory");
#pragma unroll
        for (int i4 = 0; i4 < 4; ++i4) *(LAS u32x4*)(keys + sub * 16 + i4 * 4) = kq[i4];
        asm volatile("s_waitcnt lgkmcnt(0)" ::: "memory");
        unsigned bits = 0u;
#pragma unroll 2
        for (int it = 0; it < 16; ++it) {
            const u32x4 k0 = *(LAS const u32x4*)(keys + sub * 16), k1 = *(LAS const u32x4*)(keys + sub * 16 + 4), k2 = *(LAS const u32x4*)(keys + sub * 16 + 8), k3 = *(LAS const u32x4*)(keys + sub * 16 + 12);
            unsigned m = max(max(max(k0.x, k0.y), max(k0.z, k0.w)), max(max(k1.x, k1.y), max(k1.z, k1.w)));
            m = max(m, max(max(max(k2.x, k2.y), max(k2.z, k2.w)), max(max(k3.x, k3.y), max(k3.z, k3.w))));
            m = max(m, (unsigned)__builtin_amdgcn_update_dpp(0, (int)m, 0xB1, 0xF, 0xF, true));
            m = max(m, (unsigned)__builtin_amdgcn_update_dpp(0, (int)m, 0x4E, 0xF, 0xF, true));
            m = max(m, (unsigned)__builtin_amdgcn_update_dpp(0, (int)m, 0x141, 0xF, 0xF, true));
            const int sblk = 127 - (int)(m & 127u);
            if (m != 0u && (sblk >> 4) == sub) { bits |= 1u << (sblk & 15); keys[sblk] = 0u; }
            asm volatile("s_waitcnt lgkmcnt(0)" ::: "memory");
        }
        unsigned w = bits << (16 * (sub & 1));
        w |= __shfl_xor(w, 1);
        if ((sub & 1) == 0) A.sel[((size_t)(b * 2 + hg) * SEQ + qb * 64 + wid * 8 + ql) * 4 + (sub >> 1)] = w;
    }
    __syncthreads();
}
#undef MFMA32C
}
namespace att {
enum { M_FOX = 0, M_WIN = 1, M_SLC = 2, M_CMP = 3 };
#ifndef SLC_TWO_BURST
#define SLC_TWO_BURST 1
#endif
#ifndef NB_FOX
#define NB_FOX 2
#endif
#ifndef NB_SLC
#define NB_SLC 2
#endif
#ifndef NB_WIN
#define NB_WIN 2
#endif
constexpr int KB0 = 0, KBSZ = 8448  , NSL = 5, VB0 = NSL * KBSZ, VBSZ = 8192;
__device__ __forceinline__ int ring_wrap(int x) { return x < 0 ? x + NSL : (x >= NSL ? x - NSL : x); }
constexpr int IMP_OFF = VB0 + NSL * VBSZ;
constexpr int IMP_W = 132;
constexpr int KEY_OFF = IMP_OFF + 8 * 8 * IMP_W * 4;
constexpr int LDS_NEED = KEY_OFF + 8 * 8 * 128 * 4;
typedef short v4i16_t __attribute__((ext_vector_type(4)));
typedef short s16x4 __attribute__((ext_vector_type(4)));

struct P { const bf16_t* Z; const bf16_t* KV; const float* S32; const float* cum; const bf16_t* KC; const bf16_t* VC; unsigned* sel; float* onsa; bf16_t* YS; };

__device__ __forceinline__ s16x4 vtr(LAS const unsigned char* p) { return __builtin_bit_cast(s16x4, __builtin_amdgcn_ds_read_tr16_b64_v4i16((LAS v4i16_t*)p)); }
#define MFMA32(a, b, c) __builtin_amdgcn_mfma_f32_32x32x16_bf16((a), (b), (c), 0, 0, 0)

#define LDS_BAR() asm volatile("s_waitcnt lgkmcnt(0)\n\ts_barrier" ::: "memory")

template <int MODE, int PASS>
__device__ __forceinline__ void attn_steps(LAS unsigned char* lds, f32x16& o0, f32x16& o1, float& m_run, float& lsum, bool& shifted, const float inv_l, const bf16x8 (&qf_in)[4],
                                           const bf16_t* kld, const bf16_t* vld, const float* cumk, const int kp,
                                           const int t_lo, const int nT, const int qb, const int tq, const float cq_in, const unsigned sel0_in, const unsigned sel1_in, const unsigned sel2_in, const unsigned sel3_in,
                                           LAS float* impw, const int tid, const int lane, const int wid) {
    const int r32 = lane & 31, hi = lane >> 5, half = (MODE == M_CMP) ? 0 : (wid >> 2);
    const int wtmax = (MODE == M_FOX) ? qb * 256 + wid * 32 + 31 : 0x7fffffff;
    bf16x8 qf[4] = {qf_in[0], qf_in[1], qf_in[2], qf_in[3]}; float cq = cq_in; unsigned sel0 = sel0_in, sel1 = sel1_in, sel2 = sel2_in, sel3 = sel3_in;
    const float NEG_INF = -__builtin_inff();
    const unsigned kst = (unsigned)(wid * 1024 + lane * 16);
    const int vrow = (tid >> 2) & 63, vch = (tid & 3) | ((tid >> 8) << 2);
    const unsigned vst = (unsigned)(1024 * (vrow >> 3) + 512 * (vch >> 2) + 64 * (vrow & 7) + 16 * (vch & 3));
    const unsigned kfb = (unsigned)(hi * 1024 + r32 * 16);
    const unsigned vfb = (unsigned)(256 * hi + 64 * ((lane & 15) >> 2) + 32 * ((lane >> 4) & 1) + 8 * (lane & 3));
    u32x4 kr = {0u, 0u, 0u, 0u}, vr = {0u, 0u, 0u, 0u}; float br = 0.f;
    f32x16 p0, p1; bf16x8 pk00, pk01, pk10, pk11;
#pragma unroll
    for (int r = 0; r < 16; ++r) { p0[r] = 0.f; p1[r] = 0.f; }
    pk00 = (bf16x8){0, 0, 0, 0, 0, 0, 0, 0}; pk01 = pk00; pk10 = pk00; pk11 = pk00;
#define SELBIT(tt) ((((tt) < 64) ? (((tt) < 32) ? sel0 : sel1) : (((tt) < 96) ? sel2 : sel3)) >> ((tt) & 31)) & 1u
#define RSLOT(j) ring_wrap(sk + ((j) - i))
#define KSLOT(j) (lds + KB0 + RSLOT(j) * KBSZ)
#define VSLOT(j) (lds + VB0 + RSLOT(j) * VBSZ)
#define LOAD_KV(jk, jv) do { if ((jk) < nT) { __builtin_amdgcn_global_load_lds((const unsigned*)(kld + (size_t)(t_lo + (jk)) * 64 * kp), (LAS unsigned*)(KSLOT(jk) + wid * 1024), 16, 0, 0); \
            if (MODE == M_FOX) { if (tid < 64) br = cumk[(t_lo + (jk)) * 64 + tid]; } } \
        if (PASS != 0) { if ((jv) < nT) __builtin_amdgcn_global_load_lds((const unsigned*)(vld + (size_t)(t_lo + (jv)) * 64 * kp), (LAS unsigned*)(VSLOT(jv) + wid * 1024), 16, 0, 0); } } while (0)
#define WRITE_KV(jk, jv) do { if (MODE == M_FOX) { if ((jk) < nT) { if (tid < 64) *(LAS float*)(KSLOT(jk) + 8192 + tid * 4) = br; } } \
        asm volatile("s_waitcnt vmcnt(0)" ::: "memory"); } while (0)

#define SOFTMAX_SEG(j) do { const int t = t_lo + (j); bool mine = true, act = true; if (MODE == M_SLC) { mine = SELBIT(t); act = __any(mine); } if (MODE == M_FOX) act = (t * 64 <= wtmax);     \
    if (act) { \
        if (MODE != M_FOX && shifted) { _Pragma("unroll") for (int r = 0; r < 16; ++r) { p0[r] -= m_run; p1[r] -= m_run; } } \
        const int kv0 = t * 64 + 4 * hi; \
        if (MODE == M_FOX) { if (t >= 4 * qb) { _Pragma("unroll") for (int r = 0; r < 16; ++r) { const int kv = kv0 + (r & 3) + 8 * (r >> 2); if (kv > tq) p0[r] = NEG_INF; if (kv + 32 > tq) p1[r] = NEG_INF; } } } \
        else if (MODE == M_WIN) { if (t == qb || t == qb - 8) { _Pragma("unroll") for (int r = 0; r < 16; ++r) { const int kv = kv0 + (r & 3) + 8 * (r >> 2); if (kv > tq || kv <= tq - 512) p0[r] = NEG_INF; if (kv + 32 > tq || kv + 32 <= tq - 512) p1[r] = NEG_INF; } } } \
        else if (MODE == M_SLC) { if (t == qb) { _Pragma("unroll") for (int r = 0; r < 16; ++r) { const int kv = kv0 + (r & 3) + 8 * (r >> 2); if (kv > tq) p0[r] = NEG_INF; if (kv + 32 > tq) p1[r] = NEG_INF; } } }     \
        else { _Pragma("unroll") for (int r = 0; r < 16; ++r) { const int c = kv0 + (r & 3) + 8 * (r >> 2); if (16 * c + 31 > tq) p0[r] = NEG_INF; if (16 * (c + 32) + 31 > tq) p1[r] = NEG_INF; } } \
        _Pragma("unroll") for (int r = 0; r < 16; ++r) { p0[r] = __builtin_amdgcn_exp2f(p0[r]); p1[r] = __builtin_amdgcn_exp2f(p1[r]); } \
        if (PASS != 1) { \
            float mxa = fmaxf(p0[0], p1[0]), mxb = fmaxf(p0[1], p1[1]), mxc = fmaxf(p0[2], p1[2]), mxd = fmaxf(p0[3], p1[3]);     \
            _Pragma("unroll") for (int r = 4; r < 16; r += 4) { mxa = fmaxf(mxa, fmaxf(p0[r], p1[r])); mxb = fmaxf(mxb, fmaxf(p0[r + 1], p1[r + 1])); mxc = fmaxf(mxc, fmaxf(p0[r + 2], p1[r + 2])); mxd = fmaxf(mxd, fmaxf(p0[r + 3], p1[r + 3])); } \
            float mx = fmaxf(fmaxf(mxa, mxb), fmaxf(mxc, mxd)); \
            { const auto rr = __builtin_amdgcn_permlane32_swap(__float_as_uint(mx), __float_as_uint(mx), false, false); mx = fmaxf(__uint_as_float(rr[0]), __uint_as_float(rr[1])); } \
            if (__any(mx > 256.f)) {     \
                const float dl = mx > 1.f ? __builtin_amdgcn_logf(mx) : 0.f; const float scl = __builtin_amdgcn_exp2f(-dl); \
                m_run += dl; shifted = true; lsum *= scl; \
                _Pragma("unroll") for (int r = 0; r < 16; ++r) { p0[r] *= scl; p1[r] *= scl; } \
                if (PASS == 2) { _Pragma("unroll") for (int r = 0; r < 16; ++r) { o0[r] *= scl; o1[r] *= scl; } } \
            } \
            float lsa = 0.f, lsb = 0.f, lsc = 0.f, lsd = 0.f;     \
            _Pragma("unroll") for (int r = 0; r < 16; r += 4) { lsa += p0[r] + p1[r]; lsb += p0[r + 1] + p1[r + 1]; lsc += p0[r + 2] + p1[r + 2]; lsd += p0[r + 3] + p1[r + 3]; } \
            lsum += (lsa + lsb) + (lsc + lsd); \
        } \
        if (PASS != 0) { \
            if (PASS == 1) { _Pragma("unroll") for (int r = 0; r < 16; ++r) { p0[r] *= inv_l; p1[r] *= inv_l; } } \
            u32x4 w; \
            w.x = cvtpk(p0[0], p0[1]); w.y = cvtpk(p0[2], p0[3]); w.z = cvtpk(p0[4], p0[5]); w.w = cvtpk(p0[6], p0[7]); pk00 = __builtin_bit_cast(bf16x8, w); \
            w.x = cvtpk(p0[8], p0[9]); w.y = cvtpk(p0[10], p0[11]); w.z = cvtpk(p0[12], p0[13]); w.w = cvtpk(p0[14], p0[15]); pk01 = __builtin_bit_cast(bf16x8, w); \
            w.x = cvtpk(p1[0], p1[1]); w.y = cvtpk(p1[2], p1[3]); w.z = cvtpk(p1[4], p1[5]); w.w = cvtpk(p1[6], p1[7]); pk10 = __builtin_bit_cast(bf16x8, w); \
            w.x = cvtpk(p1[8], p1[9]); w.y = cvtpk(p1[10], p1[11]); w.z = cvtpk(p1[12], p1[13]); w.w = cvtpk(p1[14], p1[15]); pk11 = __builtin_bit_cast(bf16x8, w); \
        } \
    } \
    if (PASS != 0) asm volatile("" : "+v"(pk00), "+v"(pk01), "+v"(pk10), "+v"(pk11)); \
    asm volatile("" : "+v"(lsum)); \
    __builtin_amdgcn_sched_barrier(0); } while (0)

#define KFRAG_LOAD(jqk) do { LAS const unsigned char* kbuf_ = KSLOT(jqk); \
        _Pragma("unroll") for (int ds = 0; ds < 4; ++ds) { kf[2 * ds] = *(LAS const bf16x8*)(kbuf_ + kfb + ds * 2048); kf[2 * ds + 1] = *(LAS const bf16x8*)(kbuf_ + kfb + ds * 2048 + 512); } \
 } while (0)
#define VFRAG_LOAD(jpv) do { LAS const unsigned char* vb = VSLOT(jpv) + vfb; \
        _Pragma("unroll") for (int q4 = 0; q4 < 4; ++q4) { const s16x4 a0_ = vtr(vb + 2048 * q4), a1_ = vtr(vb + 2048 * q4 + 1024), c0_ = vtr(vb + 2048 * q4 + 512), c1_ = vtr(vb + 2048 * q4 + 1536); \
            vf[q4][0] = (bf16x8){a0_[0], a0_[1], a0_[2], a0_[3], a1_[0], a1_[1], a1_[2], a1_[3]}; vf[q4][1] = (bf16x8){c0_[0], c0_[1], c0_[2], c0_[3], c1_[0], c1_[1], c1_[2], c1_[3]}; } } while (0)
#define PV_MFMAS() do { \
        o0 = MFMA32(vf[0][0], pk00, o0); o1 = MFMA32(vf[0][1], pk00, o1); o0 = MFMA32(vf[1][0], pk01, o0); o1 = MFMA32(vf[1][1], pk01, o1); \
        o0 = MFMA32(vf[2][0], pk10, o0); o1 = MFMA32(vf[2][1], pk10, o1); o0 = MFMA32(vf[3][0], pk11, o0); o1 = MFMA32(vf[3][1], pk11, o1); } while (0)
#define MFMA_SEG(jpv, jqk) do { \
    bool doPV = (PASS != 0) && ((jpv) >= 0) && ((jpv) < nT), doQK = (jqk) < nT; \
    if (MODE == M_FOX) { doPV = doPV && ((t_lo + (jpv)) * 64 <= wtmax); doQK = doQK && ((t_lo + (jqk)) * 64 <= wtmax); } \
    if (MODE == M_SLC) { \
        if (doPV) { const bool m1_ = SELBIT(t_lo + (jpv)); doPV = __any(m1_); } if (doQK) { const bool m2_ = SELBIT(t_lo + (jqk)); doQK = __any(m2_); } \
        if (doPV) { bf16x8 vf[4][2]; VFRAG_LOAD(jpv); __builtin_amdgcn_sched_barrier(0); PV_MFMAS(); } \
        __builtin_amdgcn_sched_barrier(0); \
        if (doQK) { bf16x8 kf[8]; KFRAG_LOAD(jqk); \
            const bool mn_ = SELBIT(t_lo + (jqk)); const float cv_ = mn_ ? 0.f : NEG_INF;     \
            _Pragma("unroll") for (int r = 0; r < 16; ++r) { p0[r] = cv_; p1[r] = cv_; } \
            __builtin_amdgcn_sched_barrier(0); \
            _Pragma("unroll") for (int ds = 0; ds < 4; ++ds) { p0 = MFMA32(kf[2 * ds], qf[ds], p0); p1 = MFMA32(kf[2 * ds + 1], qf[ds], p1); } } \
    } else { \
        bf16x8 vf[4][2], kf[8]; f32x4 bc[4]; \
        if (PASS != 0) VFRAG_LOAD(jpv); \
        KFRAG_LOAD(jqk); \
        __builtin_amdgcn_sched_barrier(0); \
        if (doPV) PV_MFMAS(); \
        if (MODE == M_FOX) { __builtin_amdgcn_sched_barrier(0); LAS const float* bs_ = (LAS const float*)(KSLOT(jqk) + 8192);     \
            _Pragma("unroll") for (int g4 = 0; g4 < 4; ++g4) bc[g4] = *(LAS const f32x4*)(bs_ + 8 * g4 + 4 * hi); } \
        if (doQK) { \
            if (MODE == M_FOX) { const float cqm_ = cq - m_run; LAS const float* bs_ = (LAS const float*)(KSLOT(jqk) + 8192); \
                _Pragma("unroll") for (int g4 = 0; g4 < 4; ++g4) _Pragma("unroll") for (int i_ = 0; i_ < 4; ++i_) p0[4 * g4 + i_] = cqm_ - bc[g4][i_]; \
                __builtin_amdgcn_sched_barrier(0); \
                _Pragma("unroll") for (int g4 = 0; g4 < 4; ++g4) bc[g4] = *(LAS const f32x4*)(bs_ + 32 + 8 * g4 + 4 * hi); \
                _Pragma("unroll") for (int ds = 0; ds < 4; ++ds) p0 = MFMA32(kf[2 * ds], qf[ds], p0); \
                __builtin_amdgcn_sched_barrier(0); \
                _Pragma("unroll") for (int g4 = 0; g4 < 4; ++g4) _Pragma("unroll") for (int i_ = 0; i_ < 4; ++i_) p1[4 * g4 + i_] = cqm_ - bc[g4][i_]; \
                _Pragma("unroll") for (int ds = 0; ds < 4; ++ds) p1 = MFMA32(kf[2 * ds + 1], qf[ds], p1); \
            } else { \
                _Pragma("unroll") for (int r = 0; r < 16; ++r) { p0[r] = 0.f; p1[r] = 0.f; } \
                _Pragma("unroll") for (int ds = 0; ds < 4; ++ds) { p0 = MFMA32(kf[2 * ds], qf[ds], p0); p1 = MFMA32(kf[2 * ds + 1], qf[ds], p1); } } } \
    } \
    __builtin_amdgcn_sched_barrier(0); } while (0)
    bf16x8 ov00 = pk00, ov01 = pk00, ov10 = pk00, ov11 = pk00;
    if (MODE == M_CMP && PASS == 1) {
#pragma unroll
        for (int j = 0; j < 8; ++j) { const int cb = 8 * (j >> 2) + 4 * hi + (j & 3) - 4 * r32;
            ov00[j] = (cb >= -1 && cb <= 3) ? (short)0x3F80 : (short)0; ov01[j] = (cb + 16 >= -1 && cb + 16 <= 3) ? (short)0x3F80 : (short)0;
            ov10[j] = (cb + 32 >= -1 && cb + 32 <= 3) ? (short)0x3F80 : (short)0; ov11[j] = (cb + 48 >= -1 && cb + 48 <= 3) ? (short)0x3F80 : (short)0; }
        asm volatile("" : "+v"(ov00), "+v"(ov01), "+v"(ov10), "+v"(ov11));
    }

    constexpr int NB = (MODE == M_FOX) ? NB_FOX : (MODE == M_SLC) ? NB_SLC : NB_WIN;
    int sk = 0;
    { const int i = 0;
      float brp[NB + 1];
#pragma unroll
      for (int j = 0; j <= NB; ++j) { brp[j] = 0.f; LOAD_KV(j, (j < NB ? j : nT)); brp[j] = br; }
      if (MODE == M_FOX) { if (tid < 64) {
#pragma unroll
          for (int j = 0; j <= NB; ++j) if (j < nT) *(LAS float*)(KSLOT(j) + 8192 + tid * 4) = brp[j]; } }
      asm volatile("" : "+v"(qf[0]), "+v"(qf[1]), "+v"(qf[2]), "+v"(qf[3]));
      asm volatile("" : "+v"(cq), "+v"(sel0), "+v"(sel1), "+v"(sel2), "+v"(sel3));
      asm volatile("s_waitcnt vmcnt(0)" ::: "memory"); }
    LDS_BAR();
#define END_STEP(i) do { if (MODE == M_FOX) { if ((i) + NB + 1 < nT) { if (tid < 64) *(LAS float*)(KSLOT((i) + NB + 1) + 8192 + tid * 4) = br; } } \
        if (((i) + 1) % NB == 0) { asm volatile("s_waitcnt vmcnt(0)" ::: "memory"); LDS_BAR(); } } while (0)
    if (half == 0) {
#pragma unroll 1
        for (int i = 0; i <= nT; ++i) {
            LOAD_KV(i + NB + 1, i + NB);
            MFMA_SEG(i - 1, i);
            if (i < nT) SOFTMAX_SEG(i);
            END_STEP(i);
            sk = (sk + 1 == NSL) ? 0 : sk + 1;
        }
    } else {
        { const int i = 0; MFMA_SEG(-1, 0); }
#pragma unroll 1
        for (int i = 0; i <= nT; ++i) {
            LOAD_KV(i + NB + 1, i + NB);
            if (i < nT) { SOFTMAX_SEG(i); MFMA_SEG(i, i + 1); }
            END_STEP(i);
            sk = (sk + 1 == NSL) ? 0 : sk + 1;
        }
    }
    if ((nT + 1) % NB != 0) { asm volatile("s_waitcnt vmcnt(0)" ::: "memory"); LDS_BAR(); }
#undef END_STEP
#undef SELBIT
#undef KSLOT
#undef RSLOT
#undef VSLOT
#undef LOAD_KV
#undef WRITE_KV
#undef SOFTMAX_SEG
#undef MFMA_SEG
#undef KFRAG_LOAD
#undef VFRAG_LOAD
#undef PV_MFMAS
#undef VFRAG_LOAD
#undef PV_MFMAS
#undef BIAS_LOAD
}

template <int MODE>
__device__ __forceinline__ void attn_unit(LAS unsigned char* lds, const P& A, const int b, const int hg, const int qb) {
    const int tid = opaque_tid(), lane = tid & 63, wid = __builtin_amdgcn_readfirstlane(tid >> 6), r32 = lane & 31, hi = lane >> 5;
    int tq, qcol, hh = 0;
    if (MODE == M_FOX) { tq = qb * 256 + wid * 32 + r32; qcol = ZC_FOX + hg * 64; }
    else { hh = r32 >> 3; tq = qb * 64 + wid * 8 + (r32 & 7); qcol = ZC_QN + (hg * 4 + hh) * 64; }
    const size_t tokrow = (size_t)b * SEQ + tq;
    bf16x8 qf[4];
    { const bf16_t* qp = A.Z + tokrow * ZP + qcol + hi * 8;
#pragma unroll
      for (int ds = 0; ds < 4; ++ds) qf[ds] = *(const bf16x8*)(qp + ds * 16); }
    const bf16_t *Kg, *Vg; int kp, t_lo, t_hi;
    const float* cumk = nullptr; float cq = 0.f;
    if (MODE == M_FOX) { cumk = A.cum + (size_t)(b * 8 + hg) * SEQ; cq = cumk[tq]; }
    const bf16_t* KVb = A.KV + (size_t)b * NSTREAM * SEQ * 64;
    if (MODE == M_FOX) { Kg = KVb + (size_t)(12 + hg) * SEQ * 64; Vg = KVb + (size_t)(20 + hg) * SEQ * 64; kp = 64; t_lo = 0; t_hi = 4 * qb + 3; }
    else if (MODE == M_WIN) { Kg = KVb + (size_t)(8 + hg) * SEQ * 64; Vg = KVb + (size_t)(10 + hg) * SEQ * 64; kp = 64; t_lo = qb > 8 ? qb - 8 : 0; t_hi = qb; }
    else if (MODE == M_SLC) { Kg = KVb + (size_t)(4 + hg) * SEQ * 64; Vg = KVb + (size_t)(6 + hg) * SEQ * 64; kp = 64; t_lo = 0; t_hi = qb; }
    else { Kg = A.KC + (size_t)(b * 2 + hg) * 512 * 64; Vg = A.VC + (size_t)(b * 2 + hg) * 512 * 64; kp = 64; t_lo = 0; t_hi = (4 * qb + 2) >> 6; if (t_hi > 7) t_hi = 7; }
    int nT = t_hi - t_lo + 1;
    if (MODE == M_FOX) {
        float qs = 0.f;
#pragma unroll
        for (int ds = 0; ds < 4; ++ds)
#pragma unroll
            for (int jj = 0; jj < 8; ++jj) { const float v = __uint_as_float((unsigned)(unsigned short)qf[ds][jj] << 16); qs += v * v; }
        { const auto rr = __builtin_amdgcn_permlane32_swap(__float_as_uint(qs), __float_as_uint(qs), false, false); qs = __uint_as_float(rr[0]) + __uint_as_float(rr[1]); }
#pragma unroll
        for (int o = 1; o < 32; o <<= 1) qs = fmaxf(qs, __shfl_xor(qs, o));
        LAS float* red = (LAS float*)(lds + IMP_OFF);
        if (lane == 0) red[wid] = qs;
        __syncthreads();
        float qn2 = red[0];
#pragma unroll
        for (int w = 1; w < 8; ++w) qn2 = fmaxf(qn2, red[w]);
        const float kmax = (A.cum + 131072)[64 * (b * 8 + hg)];
        const float bound = cumk[qb * 256] + 2.f * sqrtf(qn2) * kmax + 40.f;
        const bool needed = (tid < nT) && (cumk[tid * 64 + 63] < bound);
        const int wc_ = __popcll(__ballot(needed));
        __syncthreads();
        if (lane == 0) ((LAS int*)red)[wid] = wc_;
        __syncthreads();
        int cnt = 0;
#pragma unroll
        for (int w = 0; w < 8; ++w) cnt += ((LAS const int*)red)[w];
        t_lo = nT - cnt; nT = cnt;
        __syncthreads();
    }
    const bf16_t* kld = Kg + (size_t)lane * kp + wid * 8;
    const int vrow = wid * 8 + ((lane >> 2) & 7), vch = ((lane >> 5) << 2) | (lane & 3);
    const bf16_t* vld = Vg + (size_t)vrow * kp + vch * 8;
    unsigned sel0 = 0u, sel1 = 0u, sel2 = 0u, sel3 = 0u;
    if (MODE == M_SLC) { const u32x4 s4 = *(const u32x4*)(A.sel + ((size_t)(b * 2 + hg) * SEQ + tq) * 4); sel0 = s4.x; sel1 = s4.y; sel2 = s4.z; sel3 = s4.w; }

    f32x16 o0, o1;
#pragma unroll
    for (int r = 0; r < 16; ++r) { o0[r] = 0.f; o1[r] = 0.f; }
    float m_run = 0.f, lsum = 0.f; bool shifted = false;
    LAS float* impw = (LAS float*)(lds + IMP_OFF) + wid * 8 * IMP_W;
    float sc;
    if (MODE == M_CMP) {
        for (int i = lane; i < 8 * IMP_W; i += 64) impw[i] = 0.f;
        attn_steps<MODE, 0>(lds, o0, o1, m_run, lsum, shifted, 0.f, qf, kld, vld, cumk, kp, t_lo, nT, qb, tq, cq, sel0, sel1, sel2, sel3, impw, tid, lane, wid);
        float inv_l;
        { const auto rr = __builtin_amdgcn_permlane32_swap(__float_as_uint(lsum), __float_as_uint(lsum), false, false); const float lt = __uint_as_float(rr[0]) + __uint_as_float(rr[1]); inv_l = lt > 0.f ? 1.f / lt : 0.f; }
        attn_steps<MODE, 1>(lds, o0, o1, m_run, lsum, shifted, inv_l, qf, kld, vld, cumk, kp, t_lo, nT, qb, tq, cq, sel0, sel1, sel2, sel3, impw, tid, lane, wid);
        sc = 1.f;
    } else {
        attn_steps<MODE, 2>(lds, o0, o1, m_run, lsum, shifted, 0.f, qf, kld, vld, cumk, kp, t_lo, nT, qb, tq, cq, sel0, sel1, sel2, sel3, impw, tid, lane, wid);
        const auto rr = __builtin_amdgcn_permlane32_swap(__float_as_uint(lsum), __float_as_uint(lsum), false, false); const float lt = __uint_as_float(rr[0]) + __uint_as_float(rr[1]);
        sc = lt > 0.f ? 1.f / lt : 0.f;
    }
    if (MODE == M_FOX) {
        bf16_t* op = A.YS + tokrow * 1536 + 1024 + hg * 64 + 4 * hi;
#pragma unroll
        for (int g4 = 0; g4 < 4; ++g4) {
            u32x2 w; w.x = cvtpk(o0[4 * g4] * sc, o0[4 * g4 + 1] * sc); w.y = cvtpk(o0[4 * g4 + 2] * sc, o0[4 * g4 + 3] * sc); *(u32x2*)(op + 8 * g4) = w;
            w.x = cvtpk(o1[4 * g4] * sc, o1[4 * g4 + 1] * sc); w.y = cvtpk(o1[4 * g4 + 2] * sc, o1[4 * g4 + 3] * sc); *(u32x2*)(op + 32 + 8 * g4) = w;
        }
    } else {
        const int br = (MODE == M_CMP) ? 0 : (MODE == M_SLC) ? 1 : 2;
        const float gsc = sc * A.S32[tokrow * 32 + (hg * 4 + hh) * 3 + br];
        bf16_t* np = (bf16_t*)A.onsa + tokrow * 512 + (hg * 4 + hh) * 64 + 4 * hi;
        bf16_t* op = A.YS + tokrow * 1536 + 512 + (hg * 4 + hh) * 64 + 4 * hi;
        u32x2 pa0[4], pa1[4];
        if (MODE != M_CMP) {
#pragma unroll
            for (int g4 = 0; g4 < 4; ++g4) { pa0[g4] = *(const u32x2*)(np + 8 * g4); pa1[g4] = *(const u32x2*)(np + 32 + 8 * g4); }
        }
#pragma unroll
        for (int g4 = 0; g4 < 4; ++g4) {
            f32x4 v0 = {o0[4 * g4] * gsc, o0[4 * g4 + 1] * gsc, o0[4 * g4 + 2] * gsc, o0[4 * g4 + 3] * gsc};
            f32x4 v1 = {o1[4 * g4] * gsc, o1[4 * g4 + 1] * gsc, o1[4 * g4 + 2] * gsc, o1[4 * g4 + 3] * gsc};
            if (MODE != M_CMP) { const u32x2 a0_ = pa0[g4], a1_ = pa1[g4];
                v0[0] += bflo(a0_.x); v0[1] += bfhi(a0_.x); v0[2] += bflo(a0_.y); v0[3] += bfhi(a0_.y); v1[0] += bflo(a1_.x); v1[1] += bfhi(a1_.x); v1[2] += bflo(a1_.y); v1[3] += bfhi(a1_.y); }
            if (MODE != M_WIN) { u32x2 w_; w_.x = cvtpk(v0[0], v0[1]); w_.y = cvtpk(v0[2], v0[3]); *(u32x2*)(np + 8 * g4) = w_; w_.x = cvtpk(v1[0], v1[1]); w_.y = cvtpk(v1[2], v1[3]); *(u32x2*)(np + 32 + 8 * g4) = w_; }
            else { u32x2 w; w.x = cvtpk(v0[0], v0[1]); w.y = cvtpk(v0[2], v0[3]); *(u32x2*)(op + 8 * g4) = w; w.x = cvtpk(v1[0], v1[1]); w.y = cvtpk(v1[2], v1[3]); *(u32x2*)(op + 32 + 8 * g4) = w; }
        }
    }
    if (MODE == M_CMP) {
        const int ql = lane >> 3, sub = lane & 7, cur = qb;
        LAS const float* row = impw + ql * IMP_W;
        LAS unsigned* keys = (LAS unsigned*)(lds + KEY_OFF) + wid * 8 * 128 + ql * 128;
#pragma unroll
        for (int i4 = 0; i4 < 4; ++i4) { u32x4 kq;
#pragma unroll
            for (int i = 0; i < 4; ++i) { const int s = sub * 16 + i4 * 4 + i; float v = row[s]; if (s == 0 || s == cur || s == cur - 1) v = 1e6f;
                kq[i] = (s <= cur) ? (((__float_as_uint(v) & ~0x7Fu) | (unsigned)(127 - s)) | 0x80000000u) : 0u; }
            *(LAS u32x4*)(keys + sub * 16 + i4 * 4) = kq; }
        unsigned bits = 0u;
#pragma unroll 1
        for (int half = 0; half < 2; ++half) {
            unsigned kown[8]; int rank[8];
            { const u32x4 k0 = *(LAS const u32x4*)(keys + sub * 16 + half * 8), k1 = *(LAS const u32x4*)(keys + sub * 16 + half * 8 + 4);
              kown[0] = k0.x; kown[1] = k0.y; kown[2] = k0.z; kown[3] = k0.w; kown[4] = k1.x; kown[5] = k1.y; kown[6] = k1.z; kown[7] = k1.w; }
#pragma unroll
            for (int i = 0; i < 8; ++i) rank[i] = 0;
#pragma unroll 2
            for (int sp4 = 0; sp4 < 32; ++sp4) {
                const u32x4 kk = *(LAS const u32x4*)(keys + sp4 * 4);
#pragma unroll
                for (int i = 0; i < 8; ++i) rank[i] += (kk.x > kown[i] ? 1 : 0) + (kk.y > kown[i] ? 1 : 0) + (kk.z > kown[i] ? 1 : 0) + (kk.w > kown[i] ? 1 : 0);
            }
#pragma unroll
            for (int i = 0; i < 8; ++i) { if (kown[i] != 0u && rank[i] < 16) bits |= (1u << (half * 8 + i)); }
        }
        unsigned w = bits << (16 * (sub & 1));
        w |= __shfl_xor(w, 1);
        if ((sub & 1) == 0) A.sel[((size_t)(b * 2 + hg) * SEQ + qb * 64 + wid * 8 + ql) * 4 + (sub >> 1)] = w;
    }
    __syncthreads();
}
#undef MFMA32
}
struct Frame {
    LAS unsigned char* lds;
    int tid, lane, wave, G, bid;
    unsigned char* ws;
};
#define WSP(T, off) ((T*)(F.ws + (off)))

__device__ __forceinline__ int maprow(int mode, int n) {
    if (mode == 0) return n;
    if (mode == 1) {
        if (n < 512) return -1;
        if (n < 1792) return n;
        if (n < 1816) return 6400 + (n - 1792);
        if (n < 3352) return n - 24;
        if (n < 3360) return 6424 + (n - 3352);
        return n - 32;
    }
    return n < 1024 ? ((n >> 7) * 256 + (n & 127)) : (((n - 1024) >> 7) * 256 + 128 + (n & 127));
}
__device__ __forceinline__ void transpose_item(const float* W, int N, bf16_t* WT, int ld, LAS float* scr, int kb, int nb, int lane, int mode) {
    const int k0 = 64 * kb, n0 = 32 * nb;
    { float t[32];
#pragma unroll
      for (int i = 0; i < 32; ++i) { const int kk = 2 * i + (lane >> 5); t[i] = W[(size_t)(k0 + kk) * N + n0 + (lane & 31)]; }
#pragma unroll
      for (int i = 0; i < 32; ++i) { const int kk = 2 * i + (lane >> 5); scr[kk * 33 + (lane & 31)] = t[i]; } }
    asm volatile("s_waitcnt lgkmcnt(0)" ::: "memory");
    const int c = lane & 7;
#pragma unroll
    for (int j = 0; j < 4; ++j) { const int n = (lane >> 3) + 8 * j; const LAS float* s = scr + (8 * c) * 33 + n;
        u32x4 o; o.x = cvtpk(s[0 * 33], s[1 * 33]); o.y = cvtpk(s[2 * 33], s[3 * 33]); o.z = cvtpk(s[4 * 33], s[5 * 33]); o.w = cvtpk(s[6 * 33], s[7 * 33]);
        const int dr = maprow(mode, n0 + n);
        if (dr >= 0) *(u32x4*)(WT + (size_t)dr * ld + k0 + 8 * c) = o; }
    asm volatile("s_waitcnt lgkmcnt(0)" ::: "memory");
}
__device__ __forceinline__ void t64_load(const float* W, int N, int kb, int nb, int lane, f32x4 (&v)[16]) {
    const int k0 = 64 * kb, n0 = 64 * nb, kr = lane >> 4, c4 = lane & 15;
#pragma unroll
    for (int i = 0; i < 16; ++i) v[i] = *(const f32x4*)(W + (size_t)(k0 + 4 * i + kr) * N + n0 + 4 * c4);
}
__device__ __forceinline__ void t64_store(bf16_t* WT, int ld, LAS float* scr, int kb, int nb, int lane, int mode, const f32x4 (&v)[16]) {
    const int k0 = 64 * kb, n0 = 64 * nb, kr = lane >> 4, c4 = lane & 15;
#pragma unroll
    for (int i = 0; i < 16; ++i) { LAS float* d = scr + (4 * i + kr) * 65 + 4 * c4; d[0] = v[i][0]; d[1] = v[i][1]; d[2] = v[i][2]; d[3] = v[i][3]; }
    asm volatile("s_waitcnt lgkmcnt(0)" ::: "memory");
    const int c = lane & 7;
#pragma unroll
    for (int j = 0; j < 8; ++j) { const int n = (lane >> 3) + 8 * j; const LAS float* s = scr + (8 * c) * 65 + n;
        u32x4 o; o.x = cvtpk(s[0 * 65], s[1 * 65]); o.y = cvtpk(s[2 * 65], s[3 * 65]); o.z = cvtpk(s[4 * 65], s[5 * 65]); o.w = cvtpk(s[6 * 65], s[7 * 65]);
        const int dr = maprow(mode, n0 + n);
        *(u32x4*)(WT + (size_t)dr * ld + k0 + 8 * c) = o; }
    asm volatile("s_waitcnt lgkmcnt(0)" ::: "memory");
}
__device__ __forceinline__ void transpose_item64(const float* W, int N, bf16_t* WT, int ld, LAS float* scr, int kb, int nb, int lane, int mode) {
    f32x4 v[16];
    t64_load(W, N, kb, nb, lane, v);
    t64_store(WT, ld, scr, kb, nb, lane, mode, v);
}
constexpr int I_IN = 16 * 201, I_UP = 3 * 8 * 16, I_O = 16 * 16, I_C1 = 2 * 32 * 4, I_M1 = 32 * 16 * 32, I_M2 = 32 * 16 * 16, I_L = I_IN + I_UP + I_O + I_C1 + I_M1 + I_M2;
constexpr int CV_A1 = I_UP + I_O, CV_A2 = CV_A1 + I_M1 + I_M2, CV_ND = CV_A2 + I_L;
constexpr int CV_UNIT = 64, CV_NUNITS = (CV_ND + CV_UNIT - 1) / CV_UNIT;
constexpr int CV_D1 = CV_ND - (I_M1 + I_M2), CV_N0 = (CV_D1 + CV_UNIT - 1) / CV_UNIT, CV_N1 = (I_M1 + I_M2 + CV_UNIT - 1) / CV_UNIT;
static_assert(2 * CV_N0 <= 1024 && 2 * CV_N1 <= 1024, "two attention units per conversion unit");
__device__ __forceinline__ void weight_item(Frame& F0, ArgsP a, LAS float* scr, int l, int r) {
    Frame F = F0; asm volatile("" : "+v"(F.lane));

    if (r < I_IN) { const int kb = r / 201, nb = r % 201; if (nb >= 16) transpose_item(a->in[1] + (size_t)l * DM * INW, INW, WSP(bf16_t, WS_WIN + l * WIN_L), DM, scr, kb, nb, F.lane, 1); return; } r -= I_IN;
    if (r < I_UP) { const int nbr = r >> 7, rr = r & 127; transpose_item64(a->in[11] + ((size_t)l * 3 + nbr) * 512 * 1024, 1024, WSP(bf16_t, WS_WUP + l * WUP_L) + (size_t)nbr * 1024 * 512, 512, scr, rr >> 4, rr & 15, F.lane, 0); return; } r -= I_UP;
    if (r < I_O) { transpose_item64(a->in[12] + (size_t)l * DM * DM, DM, WSP(bf16_t, WS_WO + l * WO_L), DM, scr, r >> 4, r & 15, F.lane, 0); return; } r -= I_O;
    if (r < I_C1) { const int kv = r >> 7, rr = r & 127; transpose_item64(a->in[7] + (size_t)(l * 2 + kv) * 2048 * 256, 256, WSP(bf16_t, WS_WC1 + l * WC1_L) + (size_t)kv * 256 * 2048, 2048, scr, rr >> 2, rr & 3, F.lane, 0); return; } r -= I_C1;
    if (r < I_M1) { const int e = r >> 9, rr = r & 511; transpose_item64(a->in[17] + ((size_t)l * NEXP + e) * DM * 2048, 2048, WSP(bf16_t, WS_WM1 + l * WM1_L) + (size_t)e * 2048 * DM, DM, scr, rr >> 5, rr & 31, F.lane, 2); return; } r -= I_M1;
    { const int e = r >> 8, rr = r & 255; transpose_item64(a->in[19] + ((size_t)l * NEXP + e) * DM * DM, DM, WSP(bf16_t, WS_WM2 + l * WM2_L) + (size_t)e * DM * DM, DM, scr, rr >> 4, rr & 15, F.lane, 0); }
}
struct ItemP { const float* W; bf16_t* WT; int N, ld, kb, nb, mode, kind; };
__device__ __forceinline__ ItemP item_params(const Frame& F, ArgsP a, int l, int r) {
    ItemP p; p.kind = 0; p.mode = 0;
    if (r < I_IN) { p.kb = r / 201; p.nb = r % 201; p.W = a->in[1] + (size_t)l * DM * INW; p.N = INW; p.WT = WSP(bf16_t, WS_WIN + l * WIN_L); p.ld = DM; p.mode = 1; p.kind = p.nb >= 16 ? 1 : 2; return p; } r -= I_IN;
    if (r < I_UP) { const int nbr = r >> 7, rr = r & 127; p.W = a->in[11] + ((size_t)l * 3 + nbr) * 512 * 1024; p.N = 1024; p.WT = WSP(bf16_t, WS_WUP + l * WUP_L) + (size_t)nbr * 1024 * 512; p.ld = 512; p.kb = rr >> 4; p.nb = rr & 15; return p; } r -= I_UP;
    if (r < I_O) { p.W = a->in[12] + (size_t)l * DM * DM; p.N = DM; p.WT = WSP(bf16_t, WS_WO + l * WO_L); p.ld = DM; p.kb = r >> 4; p.nb = r & 15; return p; } r -= I_O;
    if (r < I_C1) { const int kv = r >> 7, rr = r & 127; p.W = a->in[7] + (size_t)(l * 2 + kv) * 2048 * 256; p.N = 256; p.WT = WSP(bf16_t, WS_WC1 + l * WC1_L) + (size_t)kv * 256 * 2048; p.ld = 2048; p.kb = rr >> 2; p.nb = rr & 3; return p; } r -= I_C1;
    if (r < I_M1) { const int e = r >> 9, rr = r & 511; p.W = a->in[17] + ((size_t)l * NEXP + e) * DM * 2048; p.N = 2048; p.WT = WSP(bf16_t, WS_WM1 + l * WM1_L) + (size_t)e * 2048 * DM; p.ld = DM; p.kb = rr >> 5; p.nb = rr & 31; p.mode = 2; return p; } r -= I_M1;
    { const int e = r >> 8, rr = r & 255; p.W = a->in[19] + ((size_t)l * NEXP + e) * DM * DM; p.N = DM; p.WT = WSP(bf16_t, WS_WM2 + l * WM2_L) + (size_t)e * DM * DM; p.ld = DM; p.kb = rr >> 4; p.nb = rr & 15; }
    return p;
}
__device__ __forceinline__ ItemP conv_item(const Frame& F, ArgsP a, int d) {
    if (d < CV_A1) return item_params(F, a, 0, I_IN + d);
    if (d < CV_A2) return item_params(F, a, 0, I_IN + I_UP + I_O + I_C1 + (d - CV_A1));
    return item_params(F, a, 1, d - CV_A2);
}
__device__ __forceinline__ void conv_unit(Frame& F0, ArgsP a, const int d0, const int CV_LIM) {
    Frame F = F0; asm volatile("" : "+v"(F.lane));
    LAS float* scr = (LAS float*)(F.lds + F.wave * 16640);
    int d = d0 + F.wave;
    ItemP cur; cur.kind = 2; f32x4 v[16];
    if (d < CV_LIM) { cur = conv_item(F, a, d); if (cur.kind == 0) t64_load(cur.W, cur.N, cur.kb, cur.nb, F.lane, v); }
#pragma unroll 1
    for (int i = 0; i < CV_UNIT / NWAVES; ++i) {
        const int dn = d + NWAVES;
        ItemP nx; nx.kind = 2; f32x4 vn[16];
        if (i + 1 < CV_UNIT / NWAVES && dn < CV_LIM) { nx = conv_item(F, a, dn); if (nx.kind == 0) t64_load(nx.W, nx.N, nx.kb, nx.nb, F.lane, vn); }
        if (cur.kind == 0) t64_store(cur.WT, cur.ld, scr, cur.kb, cur.nb, F.lane, cur.mode, v);
        else if (cur.kind == 1) transpose_item(cur.W, cur.N, cur.WT, cur.ld, scr, cur.kb, cur.nb, F.lane, cur.mode);
        cur = nx; d = dn;
#pragma unroll
        for (int k = 0; k < 16; ++k) v[k] = vn[k];
    }
}
__device__ __forceinline__ void p0_phase(Frame& F, ArgsP a, const int jobs = 31) {
    if (jobs & 1) for (int task = F.bid; task < 128; task += F.G) {
        const int l = task >> 6, kv = (task >> 5) & 1, nblk = (task >> 3) & 3, sl = task & 7, n = nblk * 64 + F.lane;
        const float* pos = a->in[6] + (size_t)(l * 2 + kv) * 2048; const float* w1 = a->in[7] + (size_t)(l * 2 + kv) * 2048 * 256;
        float s = 0.f;
#pragma unroll 8
        for (int i = 0; i < 32; ++i) { const int jd = sl * 256 + F.wave * 32 + i; s += pos[jd] * w1[(size_t)jd * 256 + n]; }
        LAS float* red = (LAS float*)F.lds;
        red[F.wave * 64 + F.lane] = s;
        __syncthreads();
        if (F.wave == 0) { float t = 0.f;
            for (int w = 0; w < 8; ++w) t += red[w * 64 + F.lane];
            WSP(float, WS_BIAS)[l * 16384 + 6656 + (kv * 8 + sl) * 256 + n] = t; }
        __syncthreads();
    }
    LAS float* scr = (LAS float*)(F.lds + F.wave * 16640);
    const int gw = F.bid * NWAVES + F.wave, NGW = F.G * NWAVES;
#define P0_XB_JOB() do { for (int idx0 = gt; idx0 < NTOK * DM / 4; idx0 += 8 * NGT) { f32x4 t[8]; _Pragma("unroll") for (int k = 0; k < 8; ++k) { const int idx = idx0 + k * NGT; t[k] = ((const f32x4*)a->in[0])[idx < NTOK * DM / 4 ? idx : idx0]; } _Pragma("unroll") for (int k = 0; k < 8; ++k) { const int idx = idx0 + k * NGT; if (idx < NTOK * DM / 4) { u32x2 w; w.x = cvtpk(t[k][0], t[k][1]); w.y = cvtpk(t[k][2], t[k][3]); ((u32x2*)WSP(bf16_t, WS_XB))[idx] = w; } } } } while (0)
    const int gt = F.bid * NTHREADS + F.tid, NGT = F.G * NTHREADS;
    if ((jobs & 16) && (F.bid & 1)) P0_XB_JOB();
    if (jobs & 2) for (int it = gw; it < I_IN + I_C1; it += NGW) weight_item(F, a, scr, 0, it < I_IN ? it : I_IN + I_UP + I_O + (it - I_IN));
    if (jobs & 4) {
        __syncthreads();
        LAS float* sW = (LAS float*)F.lds;
        LAS float* sP = sW + 64 * 132;
        for (int task = (F.bid + 128) % F.G; task < 2 * 4 * 16; task += F.G) {
            const int l = task >> 6, g = (task >> 4) & 3, k0 = (task & 15) * 64;
            const float* wsrc = a->in[1] + ((size_t)l * DM + k0) * INW + g * 128; const float* psrc = a->in[3] + ((size_t)(l * 4 + g) * 128) * 128;
#pragma unroll
            for (int it = 0; it < 64 * 32 / NTHREADS; ++it) { const int i = F.tid + it * NTHREADS, r = i >> 5, c4 = i & 31; *(LAS f32x4*)(sW + r * 132 + 4 * c4) = *(const f32x4*)(wsrc + (size_t)r * INW + 4 * c4); }
#pragma unroll
            for (int it = 0; it < 128 * 32 / NTHREADS; ++it) { const int i = F.tid + it * NTHREADS, r = i >> 5, c4 = i & 31; *(LAS f32x4*)(sP + r * 132 + 4 * c4) = *(const f32x4*)(psrc + (size_t)r * 128 + 4 * c4); }
            __syncthreads();
            const int kq = F.tid & 15, nq = F.tid >> 4;
            f32x4 acc[4];
#pragma unroll
            for (int r = 0; r < 4; ++r) acc[r] = (f32x4){0.f, 0.f, 0.f, 0.f};
#pragma unroll 4
            for (int c = 0; c < 128; ++c) { const f32x4 pv = *(LAS const f32x4*)(sP + c * 132 + 4 * nq);
#pragma unroll
                for (int r = 0; r < 4; ++r) acc[r] = acc[r] + pv * sW[(4 * kq + r) * 132 + c]; }
            bf16_t* wt = WSP(bf16_t, WS_WIN + l * WIN_L) + (size_t)(g * 128 + 4 * nq) * DM + k0 + 4 * kq;
#pragma unroll
            for (int j = 0; j < 4; ++j) { u32x2 o; o.x = cvtpk(acc[0][j], acc[1][j]); o.y = cvtpk(acc[2][j], acc[3][j]); *(u32x2*)(wt + (size_t)j * DM) = o; }
            __syncthreads();
        }
    }
    if (jobs & 8) for (int idx = (F.G - 1 - F.bid) * NTHREADS + F.tid; idx < 2 * NINP; idx += NGT) {
        const int l = idx / NINP, n = idx - l * NINP; const float* bi = a->in[2] + (size_t)l * INW; float v = 0.f;
        if (n < 512) { const int g = n >> 7; const float* pw = a->in[3] + ((size_t)(l * 4 + g) * 128) * 128 + (n & 127);
#pragma unroll 32
            for (int c = 0; c < 128; ++c) v += bi[g * 128 + c] * pw[(size_t)c * 128]; }
        else if (n < 1792) v = bi[n];
        else if (n < 3328) v = bi[n + 24];
        else if (n < 6400) v = bi[n + 32];
        else if (n < 6424) v = bi[1792 + (n - 6400)];
        else if (n < 6432) v = bi[3352 + (n - 6424)];
        WSP(float, WS_BIAS)[l * 16384 + n] = v;
    }
    for (int idx = gt; idx < 2 * 224 * 128; idx += NGT) { const int l = idx / (224 * 128), r = idx - l * 224 * 128; *(u32x4*)(WSP(bf16_t, WS_WIN + l * WIN_L) + (size_t)6432 * DM + (size_t)r * 8) = (u32x4){0u, 0u, 0u, 0u}; }
    if ((jobs & 16) && !(F.bid & 1)) P0_XB_JOB();
#undef P0_XB_JOB
}

__device__ __forceinline__ void prep_thin(Frame& F, ArgsP a, int l) {
    if (F.bid < 128 || F.G <= 128) return;
    const int j = F.bid - 128, GJ = F.G - 128;
    LAS float* red = (LAS float*)F.lds;
    for (int seq = j; seq < 16; seq += GJ) {
        const int b = seq >> 3, h = seq & 7;
        const float* src = WSP(float, WS_S32) + ((size_t)b * SEQ + F.tid * 16) * 32 + 24 + h;
        float v[16]; float s = 0.f;
#pragma unroll
        for (int i = 0; i < 16; ++i) { v[i] = src[(size_t)i * 32]; }
#pragma unroll
        for (int i = 0; i < 16; ++i) { s += v[i]; v[i] = s; }
        float incl = s;
#pragma unroll
        for (int o = 1; o < 64; o <<= 1) { const float t = __shfl_up(incl, o); if (F.lane >= o) incl += t; }
        if (F.lane == 63) red[F.wave] = incl;
        __syncthreads();
        float base = incl - s;
        for (int w = 0; w < F.wave; ++w) base += red[w];
        float* dst = WSP(float, WS_CUM) + (size_t)seq * SEQ + F.tid * 16;
#pragma unroll
        for (int i4 = 0; i4 < 4; ++i4) *(f32x4*)(dst + 4 * i4) = (f32x4){(base + v[4 * i4]) * LOG2E, (base + v[4 * i4 + 1]) * LOG2E, (base + v[4 * i4 + 2]) * LOG2E, (base + v[4 * i4 + 3]) * LOG2E};
        __syncthreads();
    }
    {
        unsigned* KMAXU = (unsigned*)(WSP(float, WS_CUM) + 131072);
        const int b0 = (int)(((long)j * 2048) / GJ), b1 = (int)(((long)(j + 1) * 2048) / GJ);
        float mxs = 0.f; int curbh = b0 >> 7;
        for (int blk = b0; blk <= b1; ++blk) {
            const int bh = blk >> 7;
            if (blk == b1 || bh != curbh) {
                float m = mxs;
#pragma unroll
                for (int o = 1; o < 64; o <<= 1) m = fmaxf(m, __shfl_xor(m, o));
                if (F.lane == 0) red[F.wave] = m;
                __syncthreads();
                if (F.tid == 0 && blk > b0) { float mm = red[0]; for (int w = 1; w < 8; ++w) mm = fmaxf(mm, red[w]); atomicMax(KMAXU + 64 * curbh, __float_as_uint(sqrtf(mm))); }
                __syncthreads();
                mxs = 0.f; curbh = bh;
                if (blk == b1) break;
            }
            const int row = (blk & 127) * 64 + (F.tid >> 3);
            const int strm_ = (bh >> 3) * NSTREAM + 12 + (bh & 7);
            const bf16_t* kp_ = WSP(bf16_t, WS_KV) + ((size_t)strm_ * SEQ) * 64;
            const u32x4 w = *(const u32x4*)(kp_ + (size_t)row * 64 + (F.tid & 7) * 8);
            float s = bflo(w.x) * bflo(w.x) + bfhi(w.x) * bfhi(w.x) + bflo(w.y) * bflo(w.y) + bfhi(w.y) * bfhi(w.y) + bflo(w.z) * bflo(w.z) + bfhi(w.z) * bfhi(w.z) + bflo(w.w) * bflo(w.w) + bfhi(w.w) * bfhi(w.w);
            s += __shfl_xor(s, 1); s += __shfl_xor(s, 2); s += __shfl_xor(s, 4);
            mxs = fmaxf(mxs, s);
        }
    }
}

template <int WIN> __device__ __forceinline__ void pool_pair(const bf16_t* Z, bf16_t* YS, const float* pb, const float* ps, const int n0, const int n1, const bool two, int c8) {
    u32x4 w[2][WIN];
#pragma unroll
    for (int r = 0; r < 2; ++r) { const int n = r ? n1 : n0, t = n & (SEQ - 1);
#pragma unroll
        for (int q = 0; q < WIN; ++q) { const int qq = q <= t ? q : 0; w[r][q] = *(const u32x4*)(Z + (size_t)(n - qq) * ZP + c8); } }
    const f32x4 pb0 = *(const f32x4*)(pb + c8), pb1 = *(const f32x4*)(pb + c8 + 4), ps0 = *(const f32x4*)(ps + c8), ps1 = *(const f32x4*)(ps + c8 + 4);
    const float pbv[8] = {pb0[0], pb0[1], pb0[2], pb0[3], pb1[0], pb1[1], pb1[2], pb1[3]}, psv[8] = {ps0[0], ps0[1], ps0[2], ps0[3], ps1[0], ps1[1], ps1[2], ps1[3]};
#pragma unroll
    for (int r = 0; r < 2; ++r) { const int n = r ? n1 : n0, t = n & (SEQ - 1);
        float sum[8], self[8];
#pragma unroll
        for (int i = 0; i < 8; ++i) { sum[i] = 0.f; self[i] = 0.f; }
#pragma unroll
        for (int q = 0; q < WIN; ++q) { const float m = q <= t ? 1.f : 0.f;
            const float v[8] = {bflo(w[r][q].x), bfhi(w[r][q].x), bflo(w[r][q].y), bfhi(w[r][q].y), bflo(w[r][q].z), bfhi(w[r][q].z), bflo(w[r][q].w), bfhi(w[r][q].w)};
#pragma unroll
            for (int i = 0; i < 8; ++i) { sum[i] += m * v[i]; if (q == 0) self[i] = v[i]; } }
        const int cnt = (t + 1 < WIN) ? t + 1 : WIN; const float ic = 1.f / (float)cnt; float y[8];
#pragma unroll
        for (int i = 0; i < 8; ++i) y[i] = (sum[i] * ic - self[i] + pbv[i]) * psv[i];
        u32x4 o; o.x = cvtpk(y[0], y[1]); o.y = cvtpk(y[2], y[3]); o.z = cvtpk(y[4], y[5]); o.w = cvtpk(y[6], y[7]);
        if (r == 0 || two) *(u32x4*)(YS + (size_t)n * 1536 + c8) = o; }
}
__device__ __forceinline__ void pool_phase(Frame& F, ArgsP a, int l) {
    const bf16_t* Z = WSP(bf16_t, WS_Z); bf16_t* YS = WSP(bf16_t, WS_YS);
    const float* pb = a->in[4] + (size_t)l * 512; const float* ps = a->in[5] + (size_t)l * 512;
    const int gw = F.bid * NWAVES + F.wave, NGW = F.G * NWAVES;
    for (int g = 0; g < 4; ++g)
        for (int idx = gw; idx < NTOK / 4; idx += 2 * NGW) {
            const bool two = idx + NGW < NTOK / 4;
            const int n0 = idx * 4 + (F.lane >> 4), n1 = (two ? idx + NGW : idx) * 4 + (F.lane >> 4), c8 = g * 128 + (F.lane & 15) * 8;
            if (g == 0) pool_pair<2>(Z, YS, pb, ps, n0, n1, two, c8); else if (g == 1) pool_pair<4>(Z, YS, pb, ps, n0, n1, two, c8);
            else if (g == 2) pool_pair<8>(Z, YS, pb, ps, n0, n1, two, c8); else pool_pair<16>(Z, YS, pb, ps, n0, n1, two, c8);
        }
}

__device__ __forceinline__ void c2_phase(Frame& F, ArgsP a, int l) {
    const int gw = F.bid * NWAVES + F.wave, NGW = F.G * NWAVES;
    LAS float* hb = (LAS float*)F.lds + F.wave * 256;
    const float* PART = WSP(float, WS_MSCR); const float* b1p = WSP(float, WS_BIAS) + l * 16384 + 6656;
    const float* cb1 = a->in[8] + (size_t)l * 512;
    LAS float* w2l = (LAS float*)F.lds + 2048;
    { const f32x4* src = (const f32x4*)(a->in[9] + (size_t)l * 2 * 256 * 64);
      f32x4 t[16];
#pragma unroll
      for (int i = 0; i < 16; ++i) t[i] = src[F.tid + NTHREADS * i];
#pragma unroll
      for (int i = 0; i < 16; ++i) *(LAS f32x4*)(w2l + 4 * (F.tid + NTHREADS * i)) = t[i]; }
    __syncthreads();
    for (int task = gw; task < 4096; task += NGW) {
        const int kv = task >> 11, row = task & 2047;
        f32x4 hs = *(const f32x4*)(cb1 + kv * 256 + 4 * F.lane);
        f32x4 tb[8], tp[8];
#pragma unroll
        for (int sl = 0; sl < 8; ++sl) tb[sl] = *(const f32x4*)(b1p + (kv * 8 + sl) * 256 + 4 * F.lane);
#pragma unroll
        for (int sp = 0; sp < 8; ++sp) tp[sp] = *(const f32x4*)(PART + ((size_t)(sp * 2 + kv) * 2048 + row) * 256 + 4 * F.lane);
        __builtin_amdgcn_sched_barrier(0);
#pragma unroll
        for (int sl = 0; sl < 8; ++sl) hs = hs + tb[sl];
#pragma unroll
        for (int sp = 0; sp < 8; ++sp) hs = hs + tp[sp];
#pragma unroll
        for (int i = 0; i < 4; ++i) hs[i] = gelu_tanhf_(hs[i]);
        *(LAS f32x4*)(hb + 4 * F.lane) = hs;
        LAS const float* w2 = w2l + kv * 256 * 64 + F.lane;
        float s = a->in[10][(l * 2 + kv) * 64 + F.lane];
#pragma unroll 16
        for (int n = 0; n < 256; ++n) s += hb[n] * w2[n * 64];
        if ((row & 511) == 511) s = 0.f;
        WSP(bf16_t, WS_KC)[((size_t)kv * 2048 + row) * 64 + F.lane] = (bf16_t)(cvtpk(s, 0.f) & 0xffffu);
    }
}

constexpr int RW_PITCH = 1028;
__device__ __forceinline__ void ln_router_phase(Frame& F, ArgsP a, int l) {
    LAS float* rwT = (LAS float*)F.lds;
    LAS int* hist = (LAS int*)(F.lds + 32 * RW_PITCH * 4);
    const float* rw = a->in[15] + (size_t)l * DM * NEXP;
    {
        f32x4 t[16];
#pragma unroll
        for (int i = 0; i < 16; ++i) t[i] = ((const f32x4*)rw)[F.tid + NTHREADS * i];
#pragma unroll
        for (int i = 0; i < 16; ++i) { const int q = F.tid + NTHREADS * i, k = q >> 3, e0 = (q & 7) * 4;
            rwT[(e0 + 0) * RW_PITCH + k] = t[i][0]; rwT[(e0 + 1) * RW_PITCH + k] = t[i][1]; rwT[(e0 + 2) * RW_PITCH + k] = t[i][2]; rwT[(e0 + 3) * RW_PITCH + k] = t[i][3]; }
    }
    const float* g1 = a->in[13] + (size_t)l * DM; const float* b1 = a->in[14] + (size_t)l * DM; const float* rb = a->in[16] + (size_t)l * NEXP;
    const bf16_t* V1 = WSP(bf16_t, WS_V1); bf16_t* XB = WSP(bf16_t, WS_XB);
    int* TOPI = (int*)(F.ws + WS_MOE + MOE_TOPI); float* TOPG = (float*)(F.ws + WS_MOE + MOE_TOPG); int* HIST = (int*)(F.ws + WS_MOE + MOE_HIST);
    LAS float* lgbuf = (LAS float*)(F.lds + 32 * RW_PITCH * 4 + 256) + F.wave * 8 * 32;
    f32x4 ggv[4], bbv[4];
#pragma unroll
    for (int j = 0; j < 4; ++j) { ggv[j] = ((const f32x4*)g1)[F.lane + 64 * j]; bbv[j] = ((const f32x4*)b1)[F.lane + 64 * j]; }
    __syncthreads();
    for (int chunk = F.bid; chunk < 256; chunk += F.G) {
        if (F.tid < 32) hist[F.tid] = 0;
        __syncthreads();
        const size_t row0 = (size_t)chunk * 64 + F.wave * 8;
        u32x2 nx[2][4];
#pragma unroll
        for (int rr = 0; rr < 2; ++rr)
#pragma unroll
            for (int j = 0; j < 4; ++j) nx[rr][j] = ((const u32x2*)(V1 + (row0 + rr) * DM))[F.lane + 64 * j];
#pragma unroll 1
        for (int rp = 0; rp < 4; ++rp) {
            f32x4 v[2][4]; float s[2] = {0.f, 0.f};
#pragma unroll
            for (int rr = 0; rr < 2; ++rr)
#pragma unroll
                for (int j = 0; j < 4; ++j) { v[rr][j] = (f32x4){bflo(nx[rr][j].x), bfhi(nx[rr][j].x), bflo(nx[rr][j].y), bfhi(nx[rr][j].y)}; s[rr] += (v[rr][j][0] + v[rr][j][1]) + (v[rr][j][2] + v[rr][j][3]); }
            if (rp < 3) {
#pragma unroll
                for (int rr = 0; rr < 2; ++rr)
#pragma unroll
                    for (int j = 0; j < 4; ++j) nx[rr][j] = ((const u32x2*)(V1 + (row0 + 2 * rp + 2 + rr) * DM))[F.lane + 64 * j];
            }
#pragma unroll
            for (int o = 1; o < 64; o <<= 1) { s[0] += __shfl_xor(s[0], o); s[1] += __shfl_xor(s[1], o); }
            float s2[2] = {0.f, 0.f};
#pragma unroll
            for (int rr = 0; rr < 2; ++rr) { const float mean = s[rr] * (1.f / DM);
#pragma unroll
                for (int j = 0; j < 4; ++j) { v[rr][j] = v[rr][j] - mean; s2[rr] += (v[rr][j][0] * v[rr][j][0] + v[rr][j][1] * v[rr][j][1]) + (v[rr][j][2] * v[rr][j][2] + v[rr][j][3] * v[rr][j][3]); } }
#pragma unroll
            for (int o = 1; o < 64; o <<= 1) { s2[0] += __shfl_xor(s2[0], o); s2[1] += __shfl_xor(s2[1], o); }
#pragma unroll
            for (int rr = 0; rr < 2; ++rr) { const float rstd = 1.f / sqrtf(s2[rr] * (1.f / DM) + LN_EPS); const size_t row = row0 + 2 * rp + rr;
#pragma unroll
                for (int j = 0; j < 4; ++j) { const f32x4 gg = ggv[j], bb = bbv[j]; v[rr][j] = v[rr][j] * rstd * gg + bb;
                    u32x2 w; w.x = cvtpk(v[rr][j][0], v[rr][j][1]); w.y = cvtpk(v[rr][j][2], v[rr][j][3]); ((u32x2*)(XB + row * DM))[F.lane + 64 * j] = w; } }
            float acc[2][32];
            f32x4 wq[2][4];
#define RW_LOAD(buf, e) do { _Pragma("unroll") for (int j = 0; j < 4; ++j) wq[buf][j] = *(LAS const f32x4*)(rwT + (e) * RW_PITCH + 4 * (F.lane + 64 * j)); } while (0)
            f32x2_t vv[4][4];
#pragma unroll
            for (int j = 0; j < 4; ++j)
#pragma unroll
                for (int i = 0; i < 4; ++i) vv[j][i] = (f32x2_t){v[0][j][i], v[1][j][i]};
#define RW_DOT(buf, e) do { f32x2_t ta = {0.f, 0.f}, tb = {0.f, 0.f}; \
                _Pragma("unroll") for (int j = 0; j < 4; ++j) { const f32x4 w = wq[buf][j]; \
                    ta += vv[j][0] * (f32x2_t){w[0], w[0]}; tb += vv[j][1] * (f32x2_t){w[1], w[1]}; ta += vv[j][2] * (f32x2_t){w[2], w[2]}; tb += vv[j][3] * (f32x2_t){w[3], w[3]}; } \
                ta += tb; acc[0][e] = ta[0]; acc[1][e] = ta[1]; } while (0)
            RW_LOAD(0, 0);
#pragma unroll
            for (int e = 0; e < 32; e += 2) {
                RW_LOAD(1, e + 1); __builtin_amdgcn_sched_barrier(0);
                RW_DOT(0, e); __builtin_amdgcn_sched_barrier(0);
                if (e + 2 < 32) RW_LOAD(0, e + 2);
                __builtin_amdgcn_sched_barrier(0);
                RW_DOT(1, e + 1); __builtin_amdgcn_sched_barrier(0);
            }
#undef RW_LOAD
#undef RW_DOT
#define RS_STEP(CNT, BIT) _Pragma("unroll") for (int i = 0; i < CNT; ++i) { const bool up = (F.lane & BIT) != 0; \
                const float send0 = up ? acc[0][i] : acc[0][i + CNT], keep0 = up ? acc[0][i + CNT] : acc[0][i]; const float send1 = up ? acc[1][i] : acc[1][i + CNT], keep1 = up ? acc[1][i + CNT] : acc[1][i]; \
                acc[0][i] = keep0 + __shfl_xor(send0, BIT); acc[1][i] = keep1 + __shfl_xor(send1, BIT); }
            RS_STEP(16, 32) RS_STEP(8, 16) RS_STEP(4, 8) RS_STEP(2, 4) RS_STEP(1, 2)
#undef RS_STEP
            const float rbe = rb[F.lane >> 1];
            const float l0 = acc[0][0] + __shfl_xor(acc[0][0], 1) + rbe, l1 = acc[1][0] + __shfl_xor(acc[1][0], 1) + rbe;
            if ((F.lane & 1) == 0) { lgbuf[(2 * rp + 0) * 32 + (F.lane >> 1)] = l0; lgbuf[(2 * rp + 1) * 32 + (F.lane >> 1)] = l1; }
        }
        {
            const int e = F.lane >> 1;
            float lg[8], tv[8][4]; int ti[8][4];
#pragma unroll
            for (int r = 0; r < 8; ++r) lg[r] = lgbuf[r * 32 + e];
#pragma unroll
            for (int k = 0; k < 4; ++k) {
                float mx[8]; int cand[8];
#pragma unroll
                for (int r = 0; r < 8; ++r) mx[r] = lg[r];
#pragma unroll
                for (int o = 1; o < 64; o <<= 1)
#pragma unroll
                    for (int r = 0; r < 8; ++r) mx[r] = fmaxf(mx[r], __shfl_xor(mx[r], o));
#pragma unroll
                for (int r = 0; r < 8; ++r) cand[r] = (lg[r] == mx[r]) ? e : 99;
#pragma unroll
                for (int o = 1; o < 64; o <<= 1)
#pragma unroll
                    for (int r = 0; r < 8; ++r) { const int t = __shfl_xor(cand[r], o); cand[r] = t < cand[r] ? t : cand[r]; }
#pragma unroll
                for (int r = 0; r < 8; ++r) { tv[r][k] = mx[r]; ti[r][k] = cand[r]; if (e == cand[r]) lg[r] = -__builtin_inff(); }
            }
            if (F.lane == 0) {
#pragma unroll
                for (int r = 0; r < 8; ++r) {
                    const float e1 = __expf(tv[r][1] - tv[r][0]), e2 = __expf(tv[r][2] - tv[r][0]), e3 = __expf(tv[r][3] - tv[r][0]); const float inv = 1.f / (1.f + e1 + e2 + e3);
                    *(int4*)(TOPI + (row0 + r) * 4) = make_int4(ti[r][0], ti[r][1], ti[r][2], ti[r][3]);
                    *(f32x4*)(TOPG + (row0 + r) * 4) = (f32x4){inv, e1 * inv, e2 * inv, e3 * inv};
#pragma unroll
                    for (int k = 0; k < 4; ++k) __hip_atomic_fetch_add(&hist[ti[r][k]], 1, __ATOMIC_RELAXED, __HIP_MEMORY_SCOPE_WORKGROUP);
                }
            }
        }
        __syncthreads();
        if (F.tid < 32) HIST[chunk * 32 + F.tid] = hist[F.tid];
        __syncthreads();
    }
}

__device__ __forceinline__ void scatter_phase(Frame& F, ArgsP a) {
    LAS int* hl = (LAS int*)F.lds;
    LAS int* segsum = hl + 8192;
    LAS int* pstart = segsum + 512;
    LAS int* total = pstart + 32;
    LAS int* padded = total + 32;
    LAS int* ea = padded + 32;
    LAS int* slotl = ea + 256;
    const int* HIST = (const int*)(F.ws + WS_MOE + MOE_HIST); const int* TOPI = (const int*)(F.ws + WS_MOE + MOE_TOPI); const float* TOPG = (const float*)(F.ws + WS_MOE + MOE_TOPG);
    int* TOKSLOT = (int*)(F.ws + WS_MOE + MOE_TOKSLOT); int* BLK = (int*)(F.ws + WS_MOE + MOE_BLK); int* SLOTTOK = (int*)(F.ws + WS_MOE + MOE_SLOTTOK); float* SLOTG = (float*)(F.ws + WS_MOE + MOE_SLOTG);
    { u32x4 t[4];
#pragma unroll
      for (int i = 0; i < 4; ++i) t[i] = ((const u32x4*)HIST)[F.tid + NTHREADS * i];
#pragma unroll
      for (int i = 0; i < 4; ++i) *(LAS u32x4*)(hl + 4 * (F.tid + NTHREADS * i)) = t[i]; }
    __syncthreads();
    { const int e = F.tid & 31, seg = F.tid >> 5; int s = 0; for (int i = 0; i < 16; ++i) s += hl[(seg * 16 + i) * 32 + e]; segsum[seg * 32 + e] = s; }
    __syncthreads();
    if (F.tid < 32) { int run = 0; for (int seg = 0; seg < 16; ++seg) { const int t = segsum[seg * 32 + F.tid]; segsum[seg * 32 + F.tid] = run; run += t; } total[F.tid] = run; padded[F.tid] = (run + 255) & ~255; }
    __syncthreads();
    { const int e = F.tid & 31, seg = F.tid >> 5; int run = segsum[seg * 32 + e]; for (int i = 0; i < 16; ++i) { const int t = hl[(seg * 16 + i) * 32 + e]; hl[(seg * 16 + i) * 32 + e] = run; run += t; } }
    if (F.tid == 0) { int run = 0; for (int e = 0; e < 32; ++e) { pstart[e] = run; run += padded[e]; } }
    __syncthreads();
    if (F.bid == 0) {
        for (int b = F.tid; b < NBLK; b += NTHREADS) { int ex = -1; for (int e = 0; e < 32; ++e) if (b * 256 >= pstart[e] && b * 256 < pstart[e] + padded[e]) ex = e; BLK[b] = ex; }
        if (F.tid == 0) BLK[NBLK] = (pstart[31] + padded[31]) >> 8;
    }
    for (int e = F.bid; e < 32; e += F.G)
        for (int s = pstart[e] + total[e] + F.tid; s < pstart[e] + padded[e]; s += NTHREADS) { SLOTG[s] = 0.f; SLOTTOK[s] = -1; }
    const bf16_t* XB = WSP(bf16_t, WS_XB); bf16_t* XS = WSP(bf16_t, WS_XS);
    for (int chunk = F.bid; chunk < 256; chunk += F.G) {
        int e = 0, tok = 0;
        u32x4 r0[8], r1[8];
#pragma unroll
        for (int m = 0; m < 8; ++m) { const u32x4* src = (const u32x4*)(XB + (size_t)(chunk * 64 + F.wave * 8 + m) * DM); r0[m] = src[F.lane]; r1[m] = src[F.lane + 64]; }
        if (F.tid < 256) { tok = chunk * 64 + (F.tid >> 2); e = TOPI[tok * 4 + (F.tid & 3)]; ea[F.tid] = e; }
        __syncthreads();
        if (F.tid < 256) { int cnt = 0; for (int q = 0; q < F.tid; ++q) cnt += (ea[q] == e) ? 1 : 0;
            const int slot = pstart[e] + hl[chunk * 32 + e] + cnt; slotl[F.tid] = slot;
            TOKSLOT[tok * 4 + (F.tid & 3)] = slot; SLOTTOK[slot] = tok; SLOTG[slot] = TOPG[tok * 4 + (F.tid & 3)]; }
        __syncthreads();
#pragma unroll
        for (int m = 0; m < 8; ++m)
#pragma unroll
            for (int k = 0; k < 4; ++k) { const int slot = slotl[F.wave * 32 + 4 * m + k]; u32x4* dst = (u32x4*)(XS + (size_t)slot * DM); dst[F.lane] = r0[m]; dst[F.lane + 64] = r1[m]; }
        __syncthreads();
    }
}

__device__ __forceinline__ void combine_phase(Frame& F, ArgsP a, int l) {
    const int gw = F.bid * NWAVES + F.wave, NGW = F.G * NWAVES;
    const float* g2 = a->in[21] + (size_t)l * DM; const float* b2 = a->in[22] + (size_t)l * DM;
    const int* TOKSLOT = (const int*)(F.ws + WS_MOE + MOE_TOKSLOT); const bf16_t* YB = WSP(bf16_t, WS_YB);
    float* X = a->out; bf16_t* XB = WSP(bf16_t, WS_XB);
    f32x4 ggv[4], bbv[4];
#pragma unroll
    for (int j = 0; j < 4; ++j) { ggv[j] = ((const f32x4*)g2)[F.lane + 64 * j]; bbv[j] = ((const f32x4*)b2)[F.lane + 64 * j]; }
    for (int row0 = gw; row0 < NTOK; row0 += 2 * NGW) {
        int4 sl[2];
#pragma unroll
        for (int r = 0; r < 2; ++r) sl[r] = *(const int4*)(TOKSLOT + (size_t)(row0 + r * NGW < NTOK ? row0 + r * NGW : row0) * 4);
        u32x2 xw[2][4], yw[2][4][4];
#pragma unroll
        for (int r = 0; r < 2; ++r) { const int row = row0 + r * NGW < NTOK ? row0 + r * NGW : row0;
#pragma unroll
            for (int j = 0; j < 4; ++j) {
                xw[r][j] = ((const u32x2*)(XB + (size_t)row * DM))[F.lane + 64 * j];
                yw[r][0][j] = ((const u32x2*)(YB + (size_t)sl[r].x * DM))[F.lane + 64 * j]; yw[r][1][j] = ((const u32x2*)(YB + (size_t)sl[r].y * DM))[F.lane + 64 * j];
                yw[r][2][j] = ((const u32x2*)(YB + (size_t)sl[r].z * DM))[F.lane + 64 * j]; yw[r][3][j] = ((const u32x2*)(YB + (size_t)sl[r].w * DM))[F.lane + 64 * j]; } }
        __builtin_amdgcn_sched_barrier(0);
#pragma unroll
        for (int r = 0; r < 2; ++r) { const int row = row0 + r * NGW < NTOK ? row0 + r * NGW : row0;
            f32x4 v[4]; float s = 0.f;
#pragma unroll
            for (int j = 0; j < 4; ++j) {
                const u32x2 xw_ = xw[r][j]; const f32x4 x = (f32x4){bflo(xw_.x), bfhi(xw_.x), bflo(xw_.y), bfhi(xw_.y)};
                const u32x2 y0 = yw[r][0][j], y1 = yw[r][1][j], y2 = yw[r][2][j], y3 = yw[r][3][j];
                f32x4 y;
                y[0] = ((bflo(y0.x) + bflo(y1.x)) + bflo(y2.x)) + bflo(y3.x); y[1] = ((bfhi(y0.x) + bfhi(y1.x)) + bfhi(y2.x)) + bfhi(y3.x);
                y[2] = ((bflo(y0.y) + bflo(y1.y)) + bflo(y2.y)) + bflo(y3.y); y[3] = ((bfhi(y0.y) + bfhi(y1.y)) + bfhi(y2.y)) + bfhi(y3.y);
                v[j] = x * ALPHA + y; s += (v[j][0] + v[j][1]) + (v[j][2] + v[j][3]);
            }
            const float mean = wave_sum(s) * (1.f / DM); float s2 = 0.f;
#pragma unroll
            for (int j = 0; j < 4; ++j) { v[j] = v[j] - mean; s2 += (v[j][0] * v[j][0] + v[j][1] * v[j][1]) + (v[j][2] * v[j][2] + v[j][3] * v[j][3]); }
            const float rstd = 1.f / sqrtf(wave_sum(s2) * (1.f / DM) + LN_EPS);
#pragma unroll
            for (int j = 0; j < 4; ++j) { const f32x4 gg = ggv[j], bb = bbv[j]; v[j] = v[j] * rstd * gg + bb;
                if (l + 1 == NLAYER) ((f32x4*)(X + (size_t)row * DM))[F.lane + 64 * j] = v[j];
                if (l + 1 < NLAYER) { u32x2 w; w.x = cvtpk(v[j][0], v[j][1]); w.y = cvtpk(v[j][2], v[j][3]); ((u32x2*)(XB + (size_t)row * DM))[F.lane + 64 * j] = w; } }
        }
    }
}
constexpr int PH_PER_LAYER = 14, N_PHASES = 1 + NLAYER * PH_PER_LAYER;

template <int MODE> __device__ __forceinline__ void attn_phase_nsa(Frame& F, const att::P& AP) {
    for (int u0 = F.bid; u0 < 256; u0 += F.G) {
        const int u = (F.G == 256) ? ((u0 & 7) * 32 + (u0 >> 3)) : u0;
        const int bg = u >> 6, s = u & 63;
        att::attn_unit<MODE>(F.lds, AP, bg >> 1, bg & 1, s);
        att::attn_unit<MODE>(F.lds, AP, bg >> 1, bg & 1, 127 - s);
    }
}

template <int SP> __device__ __forceinline__ void run_phase(LAS unsigned char* lds, const int l) {
    ArgsP args = opaque_args();
    Frame F; F.lds = lds; F.tid = opaque_tid(); F.lane = F.tid & 63; F.wave = __builtin_amdgcn_readfirstlane(F.tid >> 6); F.G = gridDim.x; F.bid = blockIdx.x; F.ws = args->ws;
    const float* BIASL = WSP(float, WS_BIAS) + l * 16384;
    att::P AP{WSP(bf16_t, WS_Z), WSP(bf16_t, WS_KV), WSP(float, WS_S32), WSP(float, WS_CUM), WSP(bf16_t, WS_KC), WSP(bf16_t, WS_KC) + 2048 * 64, WSP(unsigned, WS_SEL), WSP(float, WS_ONSA), WSP(bf16_t, WS_YS)};
    if constexpr (SP == 99) { p0_phase(F, args); }
    else if constexpr (SP == 0) {
        pg8::Gemm g{WSP(bf16_t, WS_XB), WSP(bf16_t, WS_WIN + l * WIN_L), DM, DM, DM, 128};
        if (F.bid == 0 && F.tid < 20) (WSP(float, WS_CUM) + 131072)[64 * F.tid] = 0.f;
        SchedInProj S; S.o.init(NTOK / 256, NINP / 256, F.G, F.bid);
        EpiInProj E{WSP(bf16_t, WS_Z), WSP(float, WS_S32), BIASL, WSP(bf16_t, WS_KV)};
        pg8::gemm_phase(F.lds, g, S, E);
    } else if constexpr (SP == 1) {
        pg8::Gemm g{WSP(bf16_t, WS_KV), WSP(bf16_t, WS_WC1 + l * WC1_L), 16 * 64, 2048, 256, 128};
        SchedC1 S{F.bid};
        EpiC1 E{WSP(float, WS_MSCR)};
        pg8::gemm_phase(F.lds, g, S, E);
        if (F.bid < 128 || F.G <= 128) { pool_phase(F, args, l); } else { pool_phase(F, args, l); __syncthreads(); prep_thin(F, args, l); }
    } else if constexpr (SP == 2) { c2_phase(F, args, l); }
    else if constexpr (SP == 4) {
        attc::P APC{WSP(bf16_t, WS_Z), WSP(bf16_t, WS_KV), WSP(float, WS_S32), WSP(float, WS_CUM), WSP(bf16_t, WS_KC), WSP(bf16_t, WS_KC) + 2048 * 64, WSP(unsigned, WS_SEL), WSP(float, WS_ONSA), WSP(bf16_t, WS_YS)};
        unsigned* ctr = (unsigned*)(F.ws + WS_CTL) + 8192 + l * 64;
        volatile LAS int* slot = (volatile LAS int*)(F.lds + LDS_BYTES - 512);
        const int ncv = (l == 0) ? CV_N0 : (l == 1) ? CV_N1 : 0;
        for (;;) {
            if (F.tid == 0) *slot = (int)atomicAdd(ctr, 1u);
            __syncthreads();
            const int e = __builtin_amdgcn_readfirstlane(*slot);
            __syncthreads();
            if (e >= 1024 + ncv) break;
            int u;
            if (e < 3 * ncv) { const int g3 = e / 3, r3 = e - 3 * g3;
                if (r3 == 2) { if (l == 0) conv_unit(F, args, g3 * CV_UNIT, CV_D1); else conv_unit(F, args, CV_D1 + g3 * CV_UNIT, CV_ND); continue; }
                u = 2 * g3 + r3; } else u = e - ncv;
            const int r = u >> 5, w = u & 31;
#ifdef PROBE_FOXONLY
            if (l >= 2 && w >= 16) continue;
#endif
            if (w < 16) {
                att::attn_unit<att::M_FOX>(F.lds, AP, w >> 3, w & 7, 31 - r);
            } else {
                const int w2 = w - 16, bg = w2 & 3, qb = 127 - 4 * r - (w2 >> 2);
                attc::cmp_unit(F.lds, APC, bg >> 1, bg & 1, qb);
                __syncthreads();
                att::attn_unit<att::M_SLC>(F.lds, AP, bg >> 1, bg & 1, qb);
                att::attn_unit<att::M_WIN>(F.lds, AP, bg >> 1, bg & 1, qb);
            }
        }
    } else if constexpr (SP == 7) {
        pg8::Gemm g{WSP(bf16_t, WS_YS), WSP(bf16_t, WS_WUP + l * WUP_L), 1536, 512, 512, 128};
        SchedUp S; S.o.init(NTOK / 256, DM / 256, F.G, F.bid);
        EpiUp E{WSP(bf16_t, WS_Z), WSP(float, WS_MSCR), WSP(bf16_t, WS_MRG)};
        pg8::gemm_phase(F.lds, g, S, E);
    } else if constexpr (SP == 8) {
        pg8::Gemm g{WSP(bf16_t, WS_MRG), WSP(bf16_t, WS_WO + l * WO_L), DM, DM, DM, 128};
        SchedWo S; S.o.init(NTOK / 256, DM / 256, F.G, F.bid);
        EpiWo E{l == 0 ? args->in[0] : (const float*)nullptr, WSP(bf16_t, WS_XB), WSP(bf16_t, WS_V1)};
        pg8::gemm_phase(F.lds, g, S, E);
    } else if constexpr (SP == 9) { ln_router_phase(F, args, l); }
    else if constexpr (SP == 10) { scatter_phase(F, args); }
    else if constexpr (SP == 11) {
        const int* BLK = (const int*)(F.ws + WS_MOE + MOE_BLK);
        pg8::Gemm g{(const bf16_t*)F.ws, (const bf16_t*)F.ws, DM, DM, DM, 128};
        const int nblk = BLK[NBLK];
        unsigned* arrive = (unsigned*)(F.ws + WS_CTL) + 9216 + l * 64;
        SchedMoeT S{BLK, nblk, F.G, F.bid, l, arrive};
        EpiMoeT E{EpiMoe1{WSP(bf16_t, WS_ACT), args->in[18] + (size_t)l * NEXP * 2048},
                  EpiMoe2{WSP(bf16_t, WS_YB), args->in[20] + (size_t)l * NEXP * DM, (const float*)(F.ws + WS_MOE + MOE_SLOTG)}, arrive, (nblk * 8) % F.G != 0};
        pg8::gemm_phase(F.lds, g, S, E);
    } else if constexpr (SP == 12) {
        const int* BLK = (const int*)(F.ws + WS_MOE + MOE_BLK);
        pg8::Gemm g{WSP(bf16_t, WS_ACT), WSP(bf16_t, WS_WM2 + l * WM2_L), DM, DM, DM, 128};
        const int nblk = BLK[NBLK], tail = (nblk * 8) % F.G;
        SchedMoe S{BLK, nblk, F.G, F.bid, 4, 1024, tail ? F.G - tail : 0};
        EpiMoe2 E{WSP(bf16_t, WS_YB), args->in[20] + (size_t)l * NEXP * DM, (const float*)(F.ws + WS_MOE + MOE_SLOTG)};
        pg8::gemm_phase(F.lds, g, S, E);
    } else if constexpr (SP == 13) { combine_phase(F, args, l); }
}

#define XB_TMO      128
#define XB_XCNT(j)  (256  + 64 * (j))
#define XB_XSUB(j)  (1280 + 64 * (j))
#define XB_XGEN(j)  (2304 + 64 * (j))
#define XB_TOP      3328
#define XB_TOPGEN   3392
#define XCD_BAR_WORDS 3456
#define XB_SPIN_CAP (1u << 22)
__device__ __forceinline__ unsigned xb_ld(unsigned* p)              { return __hip_atomic_load(p, __ATOMIC_RELAXED, __HIP_MEMORY_SCOPE_AGENT); }
__device__ __forceinline__ unsigned xb_add(unsigned* p, unsigned v) { return __hip_atomic_fetch_add(p, v, __ATOMIC_RELAXED, __HIP_MEMORY_SCOPE_AGENT); }
__device__ __forceinline__ unsigned xb_xcc_id() { return (unsigned)__builtin_amdgcn_s_getreg((3 << 11) | 20) & 0xFu; }
#define XB_SPIN(cond, bar) do { unsigned _sp = 0; while (cond) { __builtin_amdgcn_s_sleep(1); \
    if ((++_sp & 255u) == 0u) { if (xb_ld(&(bar)[XB_TMO])) break; if (_sp > XB_SPIN_CAP) { atomicAdd(&(bar)[XB_TMO], 1u); break; } } } } while (0)
struct XcdBarrier { unsigned* bar; unsigned x; volatile LAS unsigned* st; };
__device__ __forceinline__ XcdBarrier xcd_barrier_post(unsigned* bar, volatile LAS unsigned* st) {
    XcdBarrier b; b.bar = bar; b.x = xb_xcc_id(); b.st = st;
    if (threadIdx.x == 0) (void)xb_add(&bar[XB_XCNT(b.x)], 1u);
    return b;
}
__device__ __forceinline__ void xcd_barrier_complete(unsigned* bar, unsigned x, unsigned& nloc, unsigned& nx) {
    const unsigned G = gridDim.x * gridDim.y * gridDim.z;
    unsigned sum, cnt, mine, sp = 0u;
    for (;;) {
        sum = 0u; cnt = 0u; mine = 0u;
#pragma unroll
        for (unsigned j = 0; j < 16; ++j) { const unsigned c = xb_ld(&bar[XB_XCNT(j)]); sum += c; cnt += (c > 0u) ? 1u : 0u; mine = (j == x) ? c : mine; }
        if (sum == G) break;
        __builtin_amdgcn_s_sleep(1);
        if ((++sp & 255u) == 0u) { if (xb_ld(&bar[XB_TMO])) break; if (sp > XB_SPIN_CAP) { atomicAdd(&bar[XB_TMO], 1u); break; } }
    }
    nloc = mine > 0u ? mine : 1u; nx = cnt > 0u ? cnt : 1u;
}
__device__ __forceinline__ void xcd_barrier(const XcdBarrier& b) {
    asm volatile("s_waitcnt vmcnt(0)" ::: "memory");
    __syncthreads();
    if (threadIdx.x == 0) {
        unsigned* bar = b.bar;
        __builtin_amdgcn_s_waitcnt(0);
        unsigned nloc = b.st[0], nx = b.st[1];
        if (nloc == 0u) { xcd_barrier_complete(bar, b.x, nloc, nx); b.st[0] = nloc; b.st[1] = nx; }
        const unsigned old = xb_add(&bar[XB_XSUB(b.x)], 1u);
        const unsigned gen = old / nloc;
        if (old + 1u == (gen + 1u) * nloc) {
            __builtin_amdgcn_fence(__ATOMIC_RELEASE, "agent");
            asm volatile("s_waitcnt vmcnt(0)" ::: "memory");
            const unsigned og = xb_add(&bar[XB_TOP], 1u);
            const unsigned tg = og / nx;
            if (og + 1u == (tg + 1u) * nx) xb_add(&bar[XB_TOPGEN], 1u);
            else XB_SPIN(xb_ld(&bar[XB_TOPGEN]) == tg, bar);
            __builtin_amdgcn_fence(__ATOMIC_ACQUIRE, "agent");
            xb_add(&bar[XB_XGEN(b.x)], 1u);
            asm volatile("s_waitcnt vmcnt(0)" ::: "memory");
        } else {
            XB_SPIN(xb_ld(&bar[XB_XGEN(b.x)]) == gen, bar);
            __builtin_amdgcn_fence(__ATOMIC_ACQUIRE, "agent");
            asm volatile("s_waitcnt vmcnt(0)" ::: "memory");
        }
    }
    __syncthreads();
}
constexpr int LDS_BARST = LDS_BYTES - 256;

template <int SP> __global__ void __launch_bounds__(NTHREADS, 2) mk_phase(Args args) {
    extern __shared__ __attribute__((aligned(16))) unsigned char lds_raw[];
    run_phase<SP>((LAS unsigned char*)lds_raw, args.ph_lo);
}
#ifndef REP_0
#define REP_0 1
#endif
#ifndef REP_1
#define REP_1 1
#endif
#ifndef REP_2
#define REP_2 1
#endif
#ifndef REP_3
#define REP_3 1
#endif
#ifndef REP_4
#define REP_4 1
#endif
#ifndef REP_5
#define REP_5 1
#endif
#ifndef REP_6
#define REP_6 1
#endif
#ifndef REP_7
#define REP_7 1
#endif
#ifndef REP_8
#define REP_8 1
#endif
#ifndef REP_9
#define REP_9 1
#endif
#ifndef REP_10
#define REP_10 1
#endif
#ifndef REP_11
#define REP_11 1
#endif
#ifndef REP_12
#define REP_12 1
#endif
__global__ void __launch_bounds__(NTHREADS, 2) mk_fwd(Args args) {
    extern __shared__ __attribute__((aligned(16))) unsigned char lds_raw[];
    LAS unsigned char* lds = (LAS unsigned char*)lds_raw;
    cg::grid_group grid = cg::this_grid();
    volatile LAS unsigned* bst = (volatile LAS unsigned*)(lds + LDS_BARST);
    if (threadIdx.x < 2) bst[threadIdx.x] = 0u;
    __syncthreads();
    (void)xcd_barrier_post((unsigned*)(args.ws + WS_CTL) + 1024, bst);
#define SEAM() do { XcdBarrier bar_; bar_.bar = (unsigned*)(opaque_args()->ws + WS_CTL) + 1024; bar_.x = xb_xcc_id(); bar_.st = (volatile LAS unsigned*)(lds + LDS_BARST); xcd_barrier(bar_); } while (0)
#ifndef REP_34
#define REP_34 1
#endif
#ifndef REP_PRO
#define REP_PRO 1
#endif
#ifndef REP_BAR
#define REP_BAR 0
#endif
#define REPN(N, SPX) for (int rep_ = 0; rep_ < (N); ++rep_) { run_phase<SPX>(lds, l); SEAM(); }
#ifdef PRO_JOBS
    { Frame F; F.lds = lds; F.tid = opaque_tid(); F.lane = F.tid & 63; F.wave = __builtin_amdgcn_readfirstlane(F.tid >> 6); F.G = gridDim.x; F.bid = blockIdx.x; F.ws = args.ws; p0_phase(F, opaque_args(), PRO_JOBS); grid.sync(); }
#endif
    for (int rep_ = 0; rep_ < REP_PRO; ++rep_) { run_phase<99>(lds, 0); grid.sync(); }
    for (int l = 0; l < NLAYER; ++l) {
        REPN(REP_0, 0)
        REPN(REP_1, 1)
        REPN(REP_2, 2)
        for (int rep2_ = 0; rep2_ < REP_34; ++rep2_) {
        for (int rep_ = 0; rep_ < REP_4; ++rep_) { run_phase<4>(lds, l + 2 * rep_); SEAM(); }
        }
        REPN(REP_7, 7)
        REPN(REP_8, 8)
        REPN(REP_9, 9)
        REPN(REP_10, 10)
        REPN(REP_11, 11)
        REPN(REP_12, 12)
        run_phase<13>(lds, l); if (l + 1 < NLAYER) SEAM();
        for (int rep_ = 0; rep_ < REP_BAR; ++rep_) SEAM();
    }
#undef SEAM
}

#ifndef MK_ONE_LAUNCH
#define MK_ONE_LAUNCH 1
#endif
#define SET_ATTR1(SP) (void)hipFuncSetAttribute((const void*)mk_phase<SP>, hipFuncAttributeMaxDynamicSharedMemorySize, LDS_BYTES)
#define SET_ATTRS() do { SET_ATTR1(99); SET_ATTR1(0); SET_ATTR1(1); SET_ATTR1(2); SET_ATTR1(3); SET_ATTR1(4); SET_ATTR1(5); SET_ATTR1(6); SET_ATTR1(7); SET_ATTR1(8); SET_ATTR1(9); SET_ATTR1(10); SET_ATTR1(11); SET_ATTR1(12); SET_ATTR1(13); } while (0)
extern "C" void kernel_launch(void* const* d_in, const int* in_sizes, int n_in, void* d_out, int out_size, void* d_ws, size_t ws_size, hipStream_t stream) {
    static int grid = 0;
    if (grid == 0) {
        if (n_in != 23 || out_size != NTOK * DM || ws_size < WS_END) { fprintf(stderr, "kernel_launch: unexpected problem (n_in %d out %d ws %zu)\n", n_in, out_size, ws_size); grid = -1; return; }
        int dev = 0, cus = 0, per_cu = 0;
        (void)hipGetDevice(&dev); (void)hipDeviceGetAttribute(&cus, hipDeviceAttributeMultiprocessorCount, dev);
#if MK_ONE_LAUNCH
        (void)hipFuncSetAttribute((const void*)mk_fwd, hipFuncAttributeMaxDynamicSharedMemorySize, LDS_BYTES);
        (void)hipOccupancyMaxActiveBlocksPerMultiprocessor(&per_cu, (const void*)mk_fwd, NTHREADS, LDS_BYTES);
#else
        SET_ATTRS();
        (void)hipOccupancyMaxActiveBlocksPerMultiprocessor(&per_cu, (const void*)mk_phase<0>, NTHREADS, LDS_BYTES);
#endif
        (void)hipGetLastError();
        if (per_cu < 1) { fprintf(stderr, "kernel_launch: occupancy query reports %d blocks per CU\n", per_cu); per_cu = 1; }
        grid = cus;
    }
    if (grid < 0) return;
    Args a{};
    for (int i = 0; i < 23; ++i) a.in[i] = (const float*)d_in[i];
    a.out = (float*)d_out; a.ws = (unsigned char*)d_ws;
#if MK_ONE_LAUNCH
    a.ph_lo = 0; a.ph_hi = 0;
    (void)hipMemsetAsync((char*)d_ws + WS_CTL, 0, 64 * 1024, stream);
    void* kargs[] = {&a};
    hipError_t e = hipLaunchCooperativeKernel((const void*)mk_fwd, dim3(grid), dim3(NTHREADS), kargs, LDS_BYTES, stream);
    if (e != hipSuccess) fprintf(stderr, "cooperative launch failed: %s (grid %d)\n", hipGetErrorString(e), grid);
#else
#define LAUNCH_PH(SP, L) do { a.ph_lo = (L); a.ph_hi = 0; hipLaunchKernelGGL(mk_phase<SP>, dim3(grid), dim3(NTHREADS), LDS_BYTES, stream, a); } while (0)
    LAUNCH_PH(99, 0);
    for (int l = 0; l < NLAYER; ++l) {
        LAUNCH_PH(0, l); LAUNCH_PH(1, l); LAUNCH_PH(2, l); LAUNCH_PH(3, l); LAUNCH_PH(4, l); LAUNCH_PH(5, l); LAUNCH_PH(6, l);
        LAUNCH_PH(7, l); LAUNCH_PH(8, l); LAUNCH_PH(9, l); LAUNCH_PH(10, l); LAUNCH_PH(11, l); LAUNCH_PH(12, l); LAUNCH_PH(13, l);
    }
#endif
}
```
